# Optimizing an MI355X kernel written in HIP

```python
import math
import jax, jax.numpy as jnp
from jax import lax
import numpy as np

D_MODEL = 2048
BATCH = 4
SEQ = 4096
DEPTH = 2

F32 = jnp.float32
EPS = 1e-6
PLE_DIM = 256

GDN_HEADS = 4
GDN_HEAD_DIM = 128
GDN_WIDTH = GDN_HEADS * GDN_HEAD_DIM
GDN_CONV = 4
GDN_CHUNK = 64

SSD_HEADS = 16
SSD_HEAD_DIM = 64
SSD_WIDTH = SSD_HEADS * SSD_HEAD_DIM
SSD_GROUPS = 2
SSD_STATE = 128
SSD_CONV = 4
SSD_CHUNK = 256
SSD_CONV_DIM = SSD_WIDTH + 2 * SSD_GROUPS * SSD_STATE

MLA_HEADS = 4
MLA_Q_RANK = 384
MLA_KV_RANK = 256
MLA_NOPE_DIM = 128
MLA_ROPE_DIM = 64
MLA_QK_DIM = MLA_NOPE_DIM + MLA_ROPE_DIM
MLA_V_DIM = 128
MLA_WIDTH = MLA_HEADS * MLA_V_DIM
MLA_BLOCK = 128
ROPE_THETA = 10000.0

D_MIX = GDN_WIDTH + SSD_WIDTH + MLA_WIDTH

GDN_COLS = 4 * GDN_WIDTH + 2 * GDN_HEADS
SSD_COLS = SSD_WIDTH + SSD_CONV_DIM + SSD_HEADS
MLA_COLS = MLA_Q_RANK + MLA_KV_RANK + MLA_ROPE_DIM
D_IN = GDN_COLS + SSD_COLS + MLA_COLS

D_FF_DENSE = 5632
N_EXPERTS = 8
TOP_K = 2
D_FF_EXPERT = 7168
N_DENSE = (DEPTH + 1) // 2
N_MOE = DEPTH // 2

kernel_name = 'hybrid_gdn_ssd_mla_moe_block'


def rmsnorm(x, gain):
    xf = x.astype(F32)
    y = xf * lax.rsqrt(jnp.mean(xf * xf, axis=-1, keepdims=True) + EPS)
    return (y * gain.astype(F32)).astype(x.dtype)


def l2norm(x):
    xf = x.astype(F32)
    return xf * lax.rsqrt(jnp.sum(xf * xf, axis=-1, keepdims=True) + EPS)


def causal_conv(x, w):
    k_w = w.shape[-1]
    seq = x.shape[1]
    xp = jnp.pad(x, ((0, 0), (k_w - 1, 0), (0, 0)))
    return sum(xp[:, j:j + seq, :] * w[:, j] for j in range(k_w))


def rotate(x, cos, sin):
    x1, x2 = jnp.split(x, 2, axis=-1)
    return jnp.concatenate([x1 * cos - x2 * sin, x2 * cos + x1 * sin], axis=-1)


def gated_deltanet(cols, conv_w, a_log, dt_bias, norm_g):
    bsz, seq, _ = cols.shape
    H, Dh, C = GDN_HEADS, GDN_HEAD_DIM, GDN_CHUNK
    n_chunks = seq // C
    qkv, z, b, a = jnp.split(cols, [3 * GDN_WIDTH, 4 * GDN_WIDTH, 4 * GDN_WIDTH + H], axis=-1)
    qkv = jax.nn.silu(causal_conv(qkv, conv_w))
    q, k, v = jnp.split(qkv, 3, axis=-1)
    q = l2norm(q.reshape(bsz, seq, H, Dh)) * (Dh ** -0.5)
    k = l2norm(k.reshape(bsz, seq, H, Dh))
    v = v.reshape(bsz, seq, H, Dh).astype(F32)
    beta = jax.nn.sigmoid(b.astype(F32))
    g = -jnp.exp(a_log.astype(F32)) * jax.nn.softplus(a.astype(F32) + dt_bias.astype(F32))

    def to_chunks(t):
        t = t.reshape((bsz, n_chunks, C, H) + t.shape[3:])
        return jnp.moveaxis(t, 3, 1)

    q, k, v, beta, g = (to_chunks(t) for t in (q, k, v, beta, g))
    g = jnp.cumsum(g, axis=-1)
    causal = jnp.tril(jnp.ones((C, C), bool))
    strict = jnp.tril(jnp.ones((C, C), bool), -1)
    decay = jnp.exp(jnp.where(causal, g[..., :, None] - g[..., None, :], -jnp.inf))
    kb = k * beta[..., None]
    m = jnp.where(strict, jnp.einsum('bhncd,bhnsd->bhncs', kb, k) * decay, 0.0)
    rhs = jnp.concatenate([v * beta[..., None], kb * jnp.exp(g)[..., None]], axis=-1)
    sol = lax.linalg.triangular_solve(m + jnp.eye(C, dtype=F32), rhs, left_side=True,
                                      lower=True, unit_diagonal=True)
    u_c, w_c = jnp.split(sol, 2, axis=-1)
    intra = jnp.einsum('bhncd,bhnsd->bhncs', q, k) * decay
    q_dec = q * jnp.exp(g)[..., None]
    k_dec = k * jnp.exp(g[..., -1:] - g)[..., None]
    g_end = jnp.exp(g[..., -1])

    def step(state, xs):
        u_i, w_i, intra_i, qd_i, kd_i, ge_i = xs
        v_new = u_i - jnp.einsum('bhcd,bhde->bhce', w_i, state)
        o_i = jnp.einsum('bhcd,bhde->bhce', qd_i, state) + jnp.einsum('bhcs,bhse->bhce', intra_i, v_new)
        state = state * ge_i[..., None, None] + jnp.einsum('bhcd,bhce->bhde', kd_i, v_new)
        return state, o_i

    xs = tuple(jnp.moveaxis(t, 2, 0) for t in (u_c, w_c, intra, q_dec, k_dec, g_end))
    _, o = lax.scan(step, jnp.zeros((bsz, H, Dh, Dh), F32), xs)
    o = jnp.transpose(o, (1, 0, 3, 2, 4)).reshape(bsz, seq, H, Dh)
    o = rmsnorm(o, norm_g) * jax.nn.silu(z.reshape(bsz, seq, H, Dh).astype(F32))
    return o.reshape(bsz, seq, GDN_WIDTH)


def mamba2_ssd(cols, conv_w, conv_b, a_log, dt_bias, d_skip, norm_g):
    bsz, seq, _ = cols.shape
    H, P, G, N, C = SSD_HEADS, SSD_HEAD_DIM, SSD_GROUPS, SSD_STATE, SSD_CHUNK
    E = H // G
    n_chunks = seq // C
    z, xbc, dt = jnp.split(cols, [SSD_WIDTH, SSD_WIDTH + SSD_CONV_DIM], axis=-1)
    xbc = jax.nn.silu(causal_conv(xbc, conv_w) + conv_b)
    xs, bm, cm = jnp.split(xbc, [SSD_WIDTH, SSD_WIDTH + G * N], axis=-1)
    x = xs.astype(F32).reshape(bsz, n_chunks, C, G, E, P)
    bm = bm.astype(F32).reshape(bsz, n_chunks, C, G, N)
    cm = cm.astype(F32).reshape(bsz, n_chunks, C, G, N)
    dt = jax.nn.softplus(dt.astype(F32) + dt_bias.astype(F32)).reshape(bsz, n_chunks, C, G, E)
    x_dt = x * dt[..., None]
    da = jnp.transpose(dt * (-jnp.exp(a_log.astype(F32))).reshape(G, E), (0, 3, 4, 1, 2))
    a_cs = jnp.cumsum(da, axis=-1)
    causal = jnp.tril(jnp.ones((C, C), bool))
    seg_decay = jnp.exp(jnp.where(causal, a_cs[..., :, None] - a_cs[..., None, :], -jnp.inf))
    cb = jnp.einsum('bclgn,bcsgn->bgcls', cm, bm)
    y_diag = jnp.einsum('bgcls,bgecls,bcsgep->bclgep', cb, seg_decay, x_dt)
    states = jnp.einsum('bclgn,bgecl,bclgep->bcgepn', bm, jnp.exp(a_cs[..., -1:] - a_cs), x_dt)

    def step(h, inp):
        s_i, d_i = inp
        return h * d_i[..., None, None] + s_i, h

    _, prev = lax.scan(step, jnp.zeros((bsz, G, E, P, N), F32),
                       (jnp.moveaxis(states, 1, 0), jnp.moveaxis(jnp.exp(a_cs[..., -1]), 3, 0)))
    y_off = jnp.einsum('bclgn,cbgepn,bgecl->bclgep', cm, prev, jnp.exp(a_cs))
    y = (y_diag + y_off + x * d_skip.astype(F32).reshape(G, E, 1)).reshape(bsz, seq, SSD_WIDTH)
    y = y * jax.nn.silu(z.astype(F32))
    y = rmsnorm(y.reshape(bsz, seq, G, SSD_WIDTH // G), norm_g.reshape(G, SSD_WIDTH // G))
    return y.reshape(bsz, seq, SSD_WIDTH)


def mla(cols, cos, sin, q_a_g, w_q_b, kv_a_g, w_kv_b, q_norm_g, k_norm_g):
    bsz, seq, _ = cols.shape
    H = MLA_HEADS
    q_lat, kv_lat, k_pe = jnp.split(cols, [MLA_Q_RANK, MLA_Q_RANK + MLA_KV_RANK], axis=-1)
    q = (rmsnorm(q_lat, q_a_g) @ w_q_b).reshape(bsz, seq, H, MLA_QK_DIM)
    kv = (rmsnorm(kv_lat, kv_a_g) @ w_kv_b).reshape(bsz, seq, H, MLA_NOPE_DIM + MLA_V_DIM)
    k_nope, v = jnp.split(kv, [MLA_NOPE_DIM], axis=-1)
    k = jnp.concatenate([k_nope, jnp.broadcast_to(k_pe[:, :, None, :], (bsz, seq, H, MLA_ROPE_DIM))], axis=-1)
    q = rmsnorm(q, q_norm_g)
    k = rmsnorm(k, k_norm_g)
    q = jnp.concatenate([q[..., :MLA_NOPE_DIM], rotate(q[..., MLA_NOPE_DIM:], cos, sin)], axis=-1)
    k = jnp.concatenate([k[..., :MLA_NOPE_DIM], rotate(k[..., MLA_NOPE_DIM:], cos, sin)], axis=-1)
    n_blocks = seq // MLA_BLOCK
    qb = jnp.transpose(q.reshape(bsz, n_blocks, MLA_BLOCK, H, MLA_QK_DIM), (1, 0, 3, 2, 4))
    kt = jnp.transpose(k, (0, 2, 1, 3))
    vt = jnp.transpose(v, (0, 2, 1, 3))
    k_idx = jnp.arange(seq)
    scale = MLA_QK_DIM ** -0.5

    def attend(args):
        q_blk, blk = args
        q_idx = blk * MLA_BLOCK + jnp.arange(MLA_BLOCK)
        s = jnp.einsum('bhqd,bhkd->bhqk', q_blk, kt).astype(F32) * scale
        s = jnp.where(q_idx[:, None] >= k_idx[None, :], s, -jnp.inf)
        prob = jax.nn.softmax(s, axis=-1)
        return jnp.einsum('bhqk,bhkd->bhqd', prob.astype(vt.dtype), vt)

    o = lax.map(attend, (qb, jnp.arange(n_blocks)))
    return jnp.transpose(o, (1, 0, 3, 2, 4)).reshape(bsz, seq, MLA_WIDTH)


def swiglu(x, w_gate, w_up, w_down):
    return (jax.nn.silu(x @ w_gate) * (x @ w_up)) @ w_down


def moe(x, w_router, w_gate, w_up, w_down):
    bsz, seq, d = x.shape
    xf = x.reshape(-1, d)
    logits = (xf @ w_router).astype(F32)
    top_val, top_idx = lax.top_k(logits, TOP_K)
    top_w = jax.nn.softmax(top_val, axis=-1)
    gates = jnp.sum(jax.nn.one_hot(top_idx, N_EXPERTS, dtype=F32) * top_w[..., None], axis=1)
    out = jnp.zeros(xf.shape, F32)
    for e in range(N_EXPERTS):
        out = out + gates[:, e, None] * swiglu(xf, w_gate[e], w_up[e], w_down[e])
    return out.reshape(bsz, seq, d).astype(x.dtype)


def setup_inputs(seed: int = 0) -> dict:
    key = jax.random.key(seed)
    ks = iter(jax.random.split(key, 48))

    def nrm(shape, scale):
        return jax.random.normal(next(ks), shape, F32) * scale

    def gain(shape):
        return 1.0 + nrm(shape, 0.02)

    def a_log(shape):
        return jnp.log(jax.random.uniform(next(ks), shape, F32, 1.0, 16.0))

    def dt_bias(shape):
        dt = jnp.exp(jax.random.uniform(next(ks), shape, F32, math.log(1e-3), math.log(1e-1)))
        return dt + jnp.log(-jnp.expm1(-dt))

    x = nrm((BATCH, SEQ, D_MODEL), 1.0)
    p = nrm((DEPTH, BATCH, SEQ, PLE_DIM), 1.0)
    positions = jnp.arange(SEQ, dtype=jnp.int32)[None, :] + jax.random.randint(next(ks), (BATCH, 1), 0, 1024, jnp.int32)
    return {
        'x': x, 'p': p, 'positions': positions,
        'norm_mix_g': gain((DEPTH, D_MODEL)),
        'w_in': nrm((DEPTH, D_MODEL, D_IN), D_MODEL ** -0.5),
        'w_out': nrm((DEPTH, D_MIX, D_MODEL), D_MIX ** -0.5),
        'gdn_conv_w': nrm((DEPTH, 3 * GDN_WIDTH, GDN_CONV), GDN_CONV ** -0.5),
        'gdn_a_log': a_log((DEPTH, GDN_HEADS)),
        'gdn_dt_bias': dt_bias((DEPTH, GDN_HEADS)),
        'gdn_norm_g': gain((DEPTH, GDN_HEAD_DIM)),
        'ssd_conv_w': nrm((DEPTH, SSD_CONV_DIM, SSD_CONV), SSD_CONV ** -0.5),
        'ssd_conv_b': nrm((DEPTH, SSD_CONV_DIM), 0.02),
        'ssd_a_log': a_log((DEPTH, SSD_HEADS)),
        'ssd_dt_bias': dt_bias((DEPTH, SSD_HEADS)),
        'ssd_d': gain((DEPTH, SSD_HEADS)),
        'ssd_norm_g': gain((DEPTH, SSD_WIDTH)),
        'mla_q_a_g': gain((DEPTH, MLA_Q_RANK)),
        'mla_w_q_b': nrm((DEPTH, MLA_Q_RANK, MLA_HEADS * MLA_QK_DIM), MLA_Q_RANK ** -0.5),
        'mla_kv_a_g': gain((DEPTH, MLA_KV_RANK)),
        'mla_w_kv_b': nrm((DEPTH, MLA_KV_RANK, MLA_HEADS * (MLA_NOPE_DIM + MLA_V_DIM)), MLA_KV_RANK ** -0.5),
        'mla_q_norm_g': gain((DEPTH, MLA_QK_DIM)),
        'mla_k_norm_g': gain((DEPTH, MLA_QK_DIM)),
        'norm_ffn_g': gain((DEPTH, D_MODEL)),
        'ffn_w_gate': nrm((N_DENSE, D_MODEL, D_FF_DENSE), D_MODEL ** -0.5),
        'ffn_w_up': nrm((N_DENSE, D_MODEL, D_FF_DENSE), D_MODEL ** -0.5),
        'ffn_w_down': nrm((N_DENSE, D_FF_DENSE, D_MODEL), D_FF_DENSE ** -0.5),
        'router_w': nrm((N_MOE, D_MODEL, N_EXPERTS), D_MODEL ** -0.5),
        'moe_w_gate': nrm((N_MOE, N_EXPERTS, D_MODEL, D_FF_EXPERT), D_MODEL ** -0.5),
        'moe_w_up': nrm((N_MOE, N_EXPERTS, D_MODEL, D_FF_EXPERT), D_MODEL ** -0.5),
        'moe_w_down': nrm((N_MOE, N_EXPERTS, D_FF_EXPERT, D_MODEL), D_FF_EXPERT ** -0.5),
        'ple_w_proj': nrm((DEPTH, PLE_DIM, D_MODEL), PLE_DIM ** -0.5),
        'ple_w_gate': nrm((DEPTH, D_MODEL, D_MODEL), D_MODEL ** -0.5),
        'ple_norm_g': gain((DEPTH, D_MODEL)),
    }


def reference(x, p, positions, norm_mix_g, w_in, w_out, gdn_conv_w, gdn_a_log, gdn_dt_bias, gdn_norm_g,
              ssd_conv_w, ssd_conv_b, ssd_a_log, ssd_dt_bias, ssd_d, ssd_norm_g,
              mla_q_a_g, mla_w_q_b, mla_kv_a_g, mla_w_kv_b, mla_q_norm_g, mla_k_norm_g,
              norm_ffn_g, ffn_w_gate, ffn_w_up, ffn_w_down, router_w, moe_w_gate, moe_w_up, moe_w_down,
              ple_w_proj, ple_w_gate, ple_norm_g):
    half = MLA_ROPE_DIM // 2
    inv_freq = 1.0 / (ROPE_THETA ** (jnp.arange(half, dtype=F32) / half))
    ang = positions.astype(F32)[..., None] * inv_freq
    cos = jnp.cos(ang)[:, :, None, :]
    sin = jnp.sin(ang)[:, :, None, :]
    h = x
    for i in range(DEPTH):
        u = rmsnorm(h, norm_mix_g[i]) @ w_in[i]
        u_gdn, u_ssd, u_mla = jnp.split(u, [GDN_COLS, GDN_COLS + SSD_COLS], axis=-1)
        mix = jnp.concatenate([
            gated_deltanet(u_gdn, gdn_conv_w[i], gdn_a_log[i], gdn_dt_bias[i], gdn_norm_g[i]),
            mamba2_ssd(u_ssd, ssd_conv_w[i], ssd_conv_b[i], ssd_a_log[i], ssd_dt_bias[i], ssd_d[i], ssd_norm_g[i]),
            mla(u_mla, cos, sin, mla_q_a_g[i], mla_w_q_b[i], mla_kv_a_g[i], mla_w_kv_b[i],
                mla_q_norm_g[i], mla_k_norm_g[i]),
        ], axis=-1).astype(h.dtype)
        h = h + mix @ w_out[i]
        hn = rmsnorm(h, norm_ffn_g[i])
        if i % 2 == 0:
            j = i // 2
            h = h + swiglu(hn, ffn_w_gate[j], ffn_w_up[j], ffn_w_down[j])
        else:
            j = i // 2
            h = h + moe(hn, router_w[j], moe_w_gate[j], moe_w_up[j], moe_w_down[j])
        e = rmsnorm(p[i] @ ple_w_proj[i], ple_norm_g[i])
        h = h + (jax.nn.sigmoid(h @ ple_w_gate[i]) * e).astype(h.dtype)
    return h
```

```cpp
#include <hip/hip_runtime.h>
#include <cstdio>
#include <cstdint>

#define GAS __attribute__((address_space(1)))
#define LAS __attribute__((address_space(3)))
typedef unsigned short bf16;
typedef unsigned short bf16_t;
typedef unsigned v4u __attribute__((ext_vector_type(4)));
typedef unsigned v2u __attribute__((ext_vector_type(2)));
typedef float f32x4 __attribute__((ext_vector_type(4)));
typedef float f32x2 __attribute__((ext_vector_type(2)));
typedef short bf16x8 __attribute__((ext_vector_type(8)));
typedef short s16x4 __attribute__((ext_vector_type(4)));
typedef unsigned u32x4 __attribute__((ext_vector_type(4)));
typedef GAS unsigned gu32;
#define RLX_AGENT __ATOMIC_RELAXED, __HIP_MEMORY_SCOPE_AGENT
#define LDS_WAIT() asm volatile("s_waitcnt lgkmcnt(0)" ::: "memory")
#define VM_WAIT() asm volatile("s_waitcnt vmcnt(0)" ::: "memory")

typedef __bf16 bf16x2_t __attribute__((ext_vector_type(2)));
__device__ __forceinline__ unsigned cvt_pk_bf16(float lo, float hi) { unsigned r; asm volatile("v_cvt_pk_bf16_f32 %0, %1, %2" : "=v"(r) : "v"(lo), "v"(hi)); return r; }
__device__ __forceinline__ unsigned cvt_pk_bf16_cv(float lo, float hi) { f32x2 v = {lo, hi}; bf16x2_t b = __builtin_convertvector(v, bf16x2_t); return __builtin_bit_cast(unsigned, b); }
__device__ __forceinline__ float bf2f(unsigned short b) { return __uint_as_float(((unsigned)b) << 16); }
__device__ __forceinline__ float bflo(unsigned w) { return __uint_as_float(w << 16); }
__device__ __forceinline__ float bfhi(unsigned w) { return __uint_as_float(w & 0xffff0000u); }
__device__ __forceinline__ unsigned short f2bf(float f) { return (unsigned short)(cvt_pk_bf16(f, 0.f) & 0xffffu); }
__device__ __forceinline__ float sigmoidf_(float x) { return __builtin_amdgcn_rcpf(1.0f + __expf(-x)); }
__device__ __forceinline__ float siluf_(float x) { return x * __builtin_amdgcn_rcpf(1.0f + __expf(-x)); }
__device__ __forceinline__ float softplusf_(float x) { return x > 20.f ? x : log1pf(__expf(x)); }
template <int X> __device__ __forceinline__ float shx(float v) {
    return __int_as_float(__builtin_amdgcn_ds_swizzle(__float_as_int(v), (X << 10) | 0x1f)); }
__device__ __forceinline__ float sum32(float v) { auto r = __builtin_amdgcn_permlane32_swap(__float_as_uint(v), __float_as_uint(v), false, false); return __uint_as_float(r[0]) + __uint_as_float(r[1]); }
__device__ __forceinline__ float max32(float v) { auto r = __builtin_amdgcn_permlane32_swap(__float_as_uint(v), __float_as_uint(v), false, false); return fmaxf(__uint_as_float(r[0]), __uint_as_float(r[1])); }
__device__ __forceinline__ float other32(float v, int lane) { auto r = __builtin_amdgcn_permlane32_swap(__float_as_uint(v), __float_as_uint(v), false, false); return __uint_as_float(lane < 32 ? r[1] : r[0]); }
__device__ __forceinline__ float wave_sum(float v) {
    v += shx<1>(v); v += shx<2>(v); v += shx<4>(v); v += shx<8>(v); v += shx<16>(v); return sum32(v); }
__device__ __forceinline__ float wave_scan(float v, int lane) {
    asm volatile("" : "+v"(lane));
#pragma unroll
    for (int o = 1; o < 64; o <<= 1) { const float t = __int_as_float(__builtin_amdgcn_ds_bpermute(((lane - o) & 63) << 2, __float_as_int(v))); if (lane >= o) v += t; }
    return v; }

namespace pg8 {
#define PG8_LAS __attribute__((address_space(3)))
constexpr int BM = 256, BK = 64, HALF = 128, HTB = HALF * BK * 2  , STAGE_BYTES = 8 * HTB, NXCD = 8, WGM = 4;

__host__ __device__ __forceinline__ int lds_byte(int r, int c) { const int st = (r >> 4) * 2 + (c >> 5), rr = r & 15, cc = c & 31, ob = rr * 64 + cc * 2; return st * 1024 + (ob ^ (((ob >> 9) & 1) << 5)); }
__host__ __device__ __forceinline__ void stage_rc(int b, int& R, int& C) { const int st = b / 1024, sb = b % 1024, swz = sb ^ (((sb >> 9) & 1) << 5); R = (st >> 1) * 16 + swz / 64; C = (st & 1) * 32 + (swz % 64) / 2; }
__host__ __device__ __forceinline__ int perm32(int rho) { const int n = rho >> 4, i = rho & 15; return 8 * (i >> 2) + 4 * n + (i & 3); }

struct Unit { int pm, pn, pb; };
struct Gemm { const void* A; const void* Bt; int M, N, K; int ldaB; };
typedef int i32x4 __attribute__((ext_vector_type(4)));
template <int ES> __device__ __forceinline__ f32x4 mma16(bf16x8 a, bf16x8 b, f32x4 c) {
    if constexpr (ES == 2) return __builtin_amdgcn_mfma_f32_16x16x32_bf16(a, b, c, 0, 0, 0);
    else return __builtin_bit_cast(f32x4, __builtin_amdgcn_mfma_i32_16x16x64_i8(__builtin_bit_cast(i32x4, a), __builtin_bit_cast(i32x4, b), __builtin_bit_cast(i32x4, c), 0, 0, 0)); }

struct StaticOrder {
    int nM, nN, nwg, G, c;
    __host__ __device__ void init(int M, int N, int G_, int c_) { nM = M / BM; nN = N / BM; nwg = nM * nN; G = G_; c = c_; }
    __host__ __device__ bool next(int i, Unit& u) const {
        const long L = (long)i * G + c; if (L >= nwg) return false;
        int wgid = (int)L; { const int q = nwg / NXCD, r = nwg % NXCD, xcd = wgid % NXCD, off = wgid / NXCD; wgid = (xcd < r ? xcd * (q + 1) : r * (q + 1) + (xcd - r) * q) + off; }
        const int nig = WGM * nN, gid = wgid / nig, fm = gid * WGM, gsz = (nM - fm) < WGM ? (nM - fm) : WGM;
        u.pm = fm + ((wgid % nig) % gsz); u.pn = (wgid % nig) / gsz; u.pb = u.pn; return true;
    }
    __device__ __forceinline__ void a_ready(const Unit&) const {}
    __device__ __forceinline__ void done(const Unit&) const {}
};
struct GroupOrder {
    int t1, t2, t3, t4, t5, t6, t7, t8;
    int nN, nwg, G, c;
    __device__ void init(const int* toff, int nN_, int G_, int c_) {
        t1 = toff[1]; t2 = toff[2]; t3 = toff[3]; t4 = toff[4]; t5 = toff[5]; t6 = toff[6]; t7 = toff[7]; t8 = toff[8];
        nN = nN_; G = G_; c = c_; nwg = t8 * nN; }
    __device__ bool next(int i, Unit& u) const {
        int wgid = (i * G) + (c % NXCD) * (G / NXCD) + c / NXCD;
        if (wgid >= nwg) return false;
        const int tt = wgid / nN;
        int e = 0, b0 = 0, b1 = t1;
        if (wgid >= t1 * nN) { e = 1; b0 = t1; b1 = t2; }
        if (wgid >= t2 * nN) { e = 2; b0 = t2; b1 = t3; }
        if (wgid >= t3 * nN) { e = 3; b0 = t3; b1 = t4; }
        if (wgid >= t4 * nN) { e = 4; b0 = t4; b1 = t5; }
        if (wgid >= t5 * nN) { e = 5; b0 = t5; b1 = t6; }
        if (wgid >= t6 * nN) { e = 6; b0 = t6; b1 = t7; }
        if (wgid >= t7 * nN) { e = 7; b0 = t7; b1 = t8; }
        (void)tt;
        const int loc = wgid - b0 * nN, nMe = b1 - b0;
        const int nig = WGM * nN, gid = loc / nig, fm = gid * WGM, gsz = (nMe - fm) < WGM ? (nMe - fm) : WGM;
        u.pm = b0 + fm + ((loc % nig) % gsz); u.pn = (loc % nig) / gsz; u.pb = e * nN + u.pn; return true;
    }
    __device__ __forceinline__ void a_ready(const Unit&) const {}
    __device__ __forceinline__ void done(const Unit&) const {}
};

struct EpiBf16Plain {
    static constexpr bool PERM = true;
    bf16_t* O; int ldc;
    __device__ __forceinline__ void operator()(const f32x4 (&acc)[2][2][4][2], const Unit& u, int wr, int wc, int fr, int fq) const {
        const int row0 = u.pm * BM + wr * 64 + fr, col0 = u.pn * BM + wc * 32 + 8 * fq;
#pragma unroll
        for (int ai = 0; ai < 2; ++ai)
#pragma unroll
            for (int m = 0; m < 4; ++m) { bf16_t* rowp = O + (size_t)(row0 + ai * HALF + m * 16) * ldc + col0;
#pragma unroll
                for (int bj = 0; bj < 2; ++bj) { const f32x4 v0 = acc[ai][bj][m][0], v1 = acc[ai][bj][m][1];
                    u32x4 w; w.x = cvt_pk_bf16(v0[0], v0[1]); w.y = cvt_pk_bf16(v0[2], v0[3]); w.z = cvt_pk_bf16(v1[0], v1[1]); w.w = cvt_pk_bf16(v1[2], v1[3]);
                    *(u32x4*)(rowp + bj * HALF) = w; } }
    }
};
struct EpiBf16Plain8 {
    static constexpr bool PERM = true;
    bf16_t* O; int ldc; const float* sa; const float* sw;
    __device__ __forceinline__ void operator()(const f32x4 (&acc)[2][2][4][2], const Unit& u, int wr, int wc, int fr, int fq) const {
        const int row0 = u.pm * BM + wr * 64 + fr, col0 = u.pn * BM + wc * 32 + 8 * fq, wrow0 = u.pb * BM + wc * 32 + 8 * fq;
        f32x4 s0[2], s1[2];
#pragma unroll
        for (int bj = 0; bj < 2; ++bj) { s0[bj] = *(const f32x4*)(sw + wrow0 + bj * HALF); s1[bj] = *(const f32x4*)(sw + wrow0 + bj * HALF + 4); }
#pragma unroll
        for (int ai = 0; ai < 2; ++ai)
#pragma unroll
            for (int m = 0; m < 4; ++m) { const int row = row0 + ai * HALF + m * 16; bf16_t* rowp = O + (size_t)row * ldc + col0; const float s = sa[row];
#pragma unroll
                for (int bj = 0; bj < 2; ++bj) { const i32x4 a = __builtin_bit_cast(i32x4, acc[ai][bj][m][0]), b = __builtin_bit_cast(i32x4, acc[ai][bj][m][1]);
                    u32x4 w; w.x = cvt_pk_bf16((float)a[0] * s * s0[bj][0], (float)a[1] * s * s0[bj][1]); w.y = cvt_pk_bf16((float)a[2] * s * s0[bj][2], (float)a[3] * s * s0[bj][3]);
                    w.z = cvt_pk_bf16((float)b[0] * s * s1[bj][0], (float)b[1] * s * s1[bj][1]); w.w = cvt_pk_bf16((float)b[2] * s * s1[bj][2], (float)b[3] * s * s1[bj][3]);
                    *(u32x4*)(rowp + bj * HALF) = w; } }
    }
};
struct EpiSwiGLU {
    static constexpr bool PERM = true;
    bf16_t* O; int ldc;
    __device__ __forceinline__ void operator()(const f32x4 (&acc)[2][2][4][2], const Unit& u, int wr, int wc, int fr, int fq) const {
        const int row0 = u.pm * BM + wr * 64 + fr, col0 = u.pn * HALF + wc * 32 + 8 * fq;
#pragma unroll
        for (int ai = 0; ai < 2; ++ai)
#pragma unroll
            for (int m = 0; m < 4; ++m) { bf16_t* rowp = O + (size_t)(row0 + ai * HALF + m * 16) * ldc + col0;
                float r[8];
#pragma unroll
                for (int n = 0; n < 2; ++n)
#pragma unroll
                    for (int j = 0; j < 4; ++j) { const float g = acc[ai][0][m][n][j], up = acc[ai][1][m][n][j]; r[n * 4 + j] = siluf_(g) * up; }
                u32x4 w; w.x = cvt_pk_bf16(r[0], r[1]); w.y = cvt_pk_bf16(r[2], r[3]); w.z = cvt_pk_bf16(r[4], r[5]); w.w = cvt_pk_bf16(r[6], r[7]);
                *(u32x4*)rowp = w; }
    }
};
struct EpiSwiGLU8 {
    static constexpr bool PERM = true;
    bf16_t* O; int ldc; const float* sa; const float* sw;
    __device__ __forceinline__ void operator()(const f32x4 (&acc)[2][2][4][2], const Unit& u, int wr, int wc, int fr, int fq) const {
        const int row0 = u.pm * BM + wr * 64 + fr, col0 = u.pn * HALF + wc * 32 + 8 * fq, wrow0 = u.pb * BM + wc * 32 + 8 * fq;
        const f32x4 g0 = *(const f32x4*)(sw + wrow0), g1 = *(const f32x4*)(sw + wrow0 + 4), u0 = *(const f32x4*)(sw + wrow0 + HALF), u1 = *(const f32x4*)(sw + wrow0 + HALF + 4);
#pragma unroll
        for (int ai = 0; ai < 2; ++ai)
#pragma unroll
            for (int m = 0; m < 4; ++m) { const int row = row0 + ai * HALF + m * 16; bf16_t* rowp = O + (size_t)row * ldc + col0; const float s = sa[row];
                float r[8];
#pragma unroll
                for (int n = 0; n < 2; ++n)
#pragma unroll
                    for (int j = 0; j < 4; ++j) { const i32x4 gi = __builtin_bit_cast(i32x4, acc[ai][0][m][n]), ui = __builtin_bit_cast(i32x4, acc[ai][1][m][n]);
                        const float g = (float)gi[j] * s * (n ? g1[j] : g0[j]), up = (float)ui[j] * s * (n ? u1[j] : u0[j]); r[n * 4 + j] = siluf_(g) * up; }
                u32x4 w; w.x = cvt_pk_bf16(r[0], r[1]); w.y = cvt_pk_bf16(r[2], r[3]); w.z = cvt_pk_bf16(r[4], r[5]); w.w = cvt_pk_bf16(r[6], r[7]);
                *(u32x4*)rowp = w; }
    }
};
struct EpiResid {
    static constexpr bool PERM = false;
    const float* base; float* out; bf16_t* ob; int ldc;
    __device__ __forceinline__ void operator()(const f32x4 (&acc)[2][2][4][2], const Unit& u, int wr, int wc, int fr, int fq) const {
        const int row0 = u.pm * BM + wr * 64 + fr, col0 = u.pn * BM + wc * 32 + 4 * fq;
#pragma unroll
        for (int ai = 0; ai < 2; ++ai)
#pragma unroll
            for (int m = 0; m < 4; ++m) { const size_t off = (size_t)(row0 + ai * HALF + m * 16) * ldc + col0;
#pragma unroll
                for (int bj = 0; bj < 2; ++bj)
#pragma unroll
                    for (int n = 0; n < 2; ++n) { const size_t o2 = off + bj * HALF + n * 16; const f32x4 r = *(const f32x4*)(base + o2) + acc[ai][bj][m][n];
                        *(f32x4*)(out + o2) = r;
                        if (ob) { v2u w; w.x = cvt_pk_bf16(r[0], r[1]); w.y = cvt_pk_bf16(r[2], r[3]); *(v2u*)(ob + o2) = w; } } }
    }
};
struct EpiResid8 {
    static constexpr bool PERM = false;
    const float* base; float* out; bf16_t* ob; int ldc; const float* sa; const float* sw;
    __device__ __forceinline__ void operator()(const f32x4 (&acc)[2][2][4][2], const Unit& u, int wr, int wc, int fr, int fq) const {
        const int row0 = u.pm * BM + wr * 64 + fr, col0 = u.pn * BM + wc * 32 + 4 * fq;
        f32x4 sc[2][2];
#pragma unroll
        for (int bj = 0; bj < 2; ++bj)
#pragma unroll
            for (int n = 0; n < 2; ++n) sc[bj][n] = *(const f32x4*)(sw + col0 + bj * HALF + n * 16);
#pragma unroll
        for (int ai = 0; ai < 2; ++ai)
#pragma unroll
            for (int m = 0; m < 4; ++m) { const int row = row0 + ai * HALF + m * 16; const size_t off = (size_t)row * ldc + col0; const float s = sa[row];
#pragma unroll
                for (int bj = 0; bj < 2; ++bj)
#pragma unroll
                    for (int n = 0; n < 2; ++n) { const size_t o2 = off + bj * HALF + n * 16; const i32x4 a = __builtin_bit_cast(i32x4, acc[ai][bj][m][n]); f32x4 r = *(const f32x4*)(base + o2);
                        r[0] += (float)a[0] * s * sc[bj][n][0]; r[1] += (float)a[1] * s * sc[bj][n][1]; r[2] += (float)a[2] * s * sc[bj][n][2]; r[3] += (float)a[3] * s * sc[bj][n][3];
                        *(f32x4*)(out + o2) = r;
                        if (ob) { v2u w; w.x = cvt_pk_bf16(r[0], r[1]); w.y = cvt_pk_bf16(r[2], r[3]); *(v2u*)(ob + o2) = w; } } }
    }
};
struct EpiPeSS {
    static constexpr bool PERM = true;
    bf16_t* O; int ldc; const float* g; float* ss;
    __device__ __forceinline__ void operator()(const f32x4 (&acc)[2][2][4][2], const Unit& u, int wr, int wc, int fr, int fq) const {
        const int row0 = u.pm * BM + wr * 64 + fr, col0 = u.pn * BM + wc * 32 + 8 * fq;
#pragma unroll
        for (int ai = 0; ai < 2; ++ai)
#pragma unroll
            for (int m = 0; m < 4; ++m) { const int row = row0 + ai * HALF + m * 16; bf16_t* rowp = O + (size_t)row * ldc + col0; float q = 0.f;
#pragma unroll
                for (int bj = 0; bj < 2; ++bj) { const f32x4 v0 = acc[ai][bj][m][0], v1 = acc[ai][bj][m][1];
                    const f32x4 ga = *(const f32x4*)(g + col0 + bj * HALF), gb = *(const f32x4*)(g + col0 + bj * HALF + 4);
                    q += (v0[0] * v0[0] + v0[1] * v0[1]) + (v0[2] * v0[2] + v0[3] * v0[3]) + (v1[0] * v1[0] + v1[1] * v1[1]) + (v1[2] * v1[2] + v1[3] * v1[3]);
                    u32x4 w; w.x = cvt_pk_bf16(v0[0] * ga[0], v0[1] * ga[1]); w.y = cvt_pk_bf16(v0[2] * ga[2], v0[3] * ga[3]);
                    w.z = cvt_pk_bf16(v1[0] * gb[0], v1[1] * gb[1]); w.w = cvt_pk_bf16(v1[2] * gb[2], v1[3] * gb[3]);
                    *(u32x4*)(rowp + bj * HALF) = w; }
                q += shx<16>(q); q = sum32(q);
                if (fq == 0) ss[(size_t)row * 32 + u.pn * 4 + wc] = q;
                asm volatile("" ::: "memory"); }
    }
};
struct EpiPle8 {
    static constexpr bool PERM = false;
    float* h; const bf16_t* e; int ldc; const float* sa; const float* sw; const float* ss;
    __device__ __forceinline__ void operator()(const f32x4 (&acc)[2][2][4][2], const Unit& u, int wr, int wc, int fr, int fq) const {
        const int row0 = u.pm * BM + wr * 64 + fr, col0 = u.pn * BM + wc * 32 + 4 * fq;
        f32x4 sc[2][2];
#pragma unroll
        for (int bj = 0; bj < 2; ++bj)
#pragma unroll
            for (int n = 0; n < 2; ++n) sc[bj][n] = *(const f32x4*)(sw + col0 + bj * HALF + n * 16);
#pragma unroll
        for (int ai = 0; ai < 2; ++ai)
#pragma unroll
            for (int m = 0; m < 4; ++m) { const int row = row0 + ai * HALF + m * 16; const size_t off = (size_t)row * ldc + col0; const float s = sa[row]; const float rse = ss[row];
#pragma unroll
                for (int bj = 0; bj < 2; ++bj)
#pragma unroll
                    for (int n = 0; n < 2; ++n) { const size_t o2 = off + bj * HALF + n * 16; const i32x4 a = __builtin_bit_cast(i32x4, acc[ai][bj][m][n]); const v2u ew = *(const v2u*)(e + o2);
                        f32x4 r = *(const f32x4*)(h + o2);
                        r[0] += sigmoidf_((float)a[0] * s * sc[bj][n][0]) * (bflo(ew.x) * rse); r[1] += sigmoidf_((float)a[1] * s * sc[bj][n][1]) * (bfhi(ew.x) * rse);
                        r[2] += sigmoidf_((float)a[2] * s * sc[bj][n][2]) * (bflo(ew.y) * rse); r[3] += sigmoidf_((float)a[3] * s * sc[bj][n][3]) * (bfhi(ew.y) * rse);
                        *(f32x4*)(h + o2) = r; } }
    }
};
struct EpiPle {
    static constexpr bool PERM = false;
    float* h; const bf16_t* e; int ldc;
    __device__ __forceinline__ void operator()(const f32x4 (&acc)[2][2][4][2], const Unit& u, int wr, int wc, int fr, int fq) const {
        const int row0 = u.pm * BM + wr * 64 + fr, col0 = u.pn * BM + wc * 32 + 4 * fq;
#pragma unroll
        for (int ai = 0; ai < 2; ++ai)
#pragma unroll
            for (int m = 0; m < 4; ++m) { const size_t off = (size_t)(row0 + ai * HALF + m * 16) * ldc + col0;
#pragma unroll
                for (int bj = 0; bj < 2; ++bj)
#pragma unroll
                    for (int n = 0; n < 2; ++n) { const size_t o2 = off + bj * HALF + n * 16; const f32x4 a = acc[ai][bj][m][n]; const v2u ew = *(const v2u*)(e + o2);
                        f32x4 r = *(const f32x4*)(h + o2);
                        r[0] += sigmoidf_(a[0]) * bflo(ew.x); r[1] += sigmoidf_(a[1]) * bfhi(ew.x); r[2] += sigmoidf_(a[2]) * bflo(ew.y); r[3] += sigmoidf_(a[3]) * bfhi(ew.y);
                        *(f32x4*)(h + o2) = r; } }
    }
};

template <class Epi, class Sched, bool ALIGN_EPI = false, bool SP2 = false, int ES = 2  >
__device__ __forceinline__ void gemm_phase(PG8_LAS unsigned char* lds, const Gemm g, const Sched& S, const Epi& E) {
    int tid_ = threadIdx.x; asm volatile("" : "+v"(tid_));
    const int tid = tid_, wid = __builtin_amdgcn_readfirstlane(tid >> 6), lane = tid & 63, wr = wid >> 2, wc = wid & 3, fr = lane & 15, fq = lane >> 4;
    const int K = g.K, nt = (K * ES) / (BK * 2), ldaB = g.ldaB ? g.ldaB : K * ES;
    unsigned voffA[2], voffB[2];
#pragma unroll
    for (int i = 0; i < 2; ++i) { int R, C; stage_rc(tid * 16 + i * 8192, R, C); const int Rb = Epi::PERM ? ((R & ~31) + perm32(R & 31)) : R;
        voffA[i] = (unsigned)(R * ldaB + C * 2); voffB[i] = (unsigned)(Rb * K * ES + C * 2); }
    const size_t kstep = (size_t)(BK * 2);
    const size_t hstep = (size_t)HALF * K * ES;
    const size_t tstep = 2 * hstep;
    const size_t hstepA = (size_t)HALF * ldaB, tstepA = 2 * hstepA;
    const unsigned ldsw = (unsigned)wid * 1024u;
    const int aoff = lds_byte(wr * 64 + fr, fq * 8), boff = lds_byte(wc * 32 + fr, fq * 8);
#define PG8_SA(b, h) (((b) * 2 + (h)) * HTB)
#define PG8_SB(b, h) ((4 + (b) * 2 + (h)) * HTB)
#define PG8_STAGE(bufoff, gbase, voff) do { _Pragma("unroll") for (int _i = 0; _i < 2; ++_i) \
        __builtin_amdgcn_global_load_lds((const unsigned*)((const char*)(gbase) + (voff)[_i]), (PG8_LAS unsigned*)(lds + (bufoff) + ldsw + _i * 8192), 16, 0, 0); } while (0)
#define PG8_LDA(dst, b, h) do { _Pragma("unroll") for (int m = 0; m < 4; ++m) _Pragma("unroll") for (int k = 0; k < 2; ++k) dst[m][k] = *(const PG8_LAS bf16x8*)(lds + PG8_SA(b, h) + aoff + m * 2048 + k * 1024); } while (0)
#define PG8_LDB(dst, b, h) do { _Pragma("unroll") for (int n = 0; n < 2; ++n) _Pragma("unroll") for (int k = 0; k < 2; ++k) dst[n][k] = *(const PG8_LAS bf16x8*)(lds + PG8_SB(b, h) + boff + n * 2048 + k * 1024); } while (0)
#define PG8_MMA(ai, bj, At, Bt) do { __builtin_amdgcn_s_setprio(1); _Pragma("unroll") for (int m = 0; m < 4; ++m) _Pragma("unroll") for (int n = 0; n < 2; ++n) _Pragma("unroll") for (int k = 0; k < 2; ++k) \
        acc[ai][bj][m][n] = mma16<ES>(Bt[n][k], At[m][k], acc[ai][bj][m][n]); __builtin_amdgcn_s_setprio(0); } while (0)
#define PG8_WAIT_V(n) asm volatile("s_waitcnt vmcnt(" #n ")" ::: "memory")
#define PG8_WAIT_L(n) asm volatile("s_waitcnt lgkmcnt(" #n ")" ::: "memory")
#define PG8_BAR __builtin_amdgcn_s_barrier()
#define PG8_SCHED __builtin_amdgcn_sched_barrier(0)
    Unit cur, nxt; int ui = 0;
    if (!S.next(0, cur)) return;
    f32x4 acc[2][2][4][2];
#pragma unroll
    for (int a = 0; a < 2; ++a)
#pragma unroll
        for (int b = 0; b < 2; ++b)
#pragma unroll
            for (int m = 0; m < 4; ++m)
#pragma unroll
                for (int n = 0; n < 2; ++n) acc[a][b][m][n] = (f32x4){0.f, 0.f, 0.f, 0.f};
    bf16x8 At[4][2], B0[2][2], B1[2][2];
    const char* cA = (const char*)g.A + (size_t)cur.pm * tstepA; const char* cB = (const char*)g.Bt + (size_t)cur.pb * tstep;
    S.a_ready(cur);
    if constexpr (SP2) {
        PG8_STAGE(PG8_SB(0, 0), cB, voffB); PG8_STAGE(PG8_SB(0, 1), cB + hstep, voffB); PG8_STAGE(PG8_SA(0, 0), cA, voffA); PG8_STAGE(PG8_SA(0, 1), cA + hstepA, voffA);
        if (wr == 1) PG8_BAR;
        PG8_WAIT_V(2); PG8_BAR;
        PG8_STAGE(PG8_SB(1, 0), cB + kstep, voffB); PG8_STAGE(PG8_SA(1, 0), cA + kstep, voffA); PG8_STAGE(PG8_SB(1, 1), cB + hstep + kstep, voffB);
        PG8_WAIT_V(6); PG8_BAR;
    } else {
        PG8_STAGE(PG8_SB(0, 0), cB, voffB); PG8_STAGE(PG8_SA(0, 0), cA, voffA); PG8_STAGE(PG8_SB(0, 1), cB + hstep, voffB); PG8_STAGE(PG8_SA(0, 1), cA + hstepA, voffA);
        if (wr == 1) PG8_BAR;
        PG8_WAIT_V(4); PG8_BAR;
        PG8_STAGE(PG8_SB(1, 0), cB + kstep, voffB); PG8_STAGE(PG8_SA(1, 0), cA + kstep, voffA); PG8_STAGE(PG8_SB(1, 1), cB + hstep + kstep, voffB);
        PG8_WAIT_V(6); PG8_BAR;
    }
    for (;;) {
        const bool has_next = S.next(ui + 1, nxt);
        const char* nA = has_next ? (const char*)g.A + (size_t)nxt.pm * tstepA : cA; const char* nB = has_next ? (const char*)g.Bt + (size_t)nxt.pb * tstep : cB;
        for (int t = 0; t < nt; t += 2) {
            const bool last = (t == nt - 2);
            const char* a1 = cA + (size_t)(t + 1) * kstep;
            const char* a2 = last ? nA : cA + (size_t)(t + 2) * kstep; const char* b2 = last ? nB : cB + (size_t)(t + 2) * kstep;
            const char* a3 = a2 + kstep; const char* b3 = b2 + kstep;
            if (last && has_next) S.a_ready(nxt);
            if constexpr (SP2) {
            PG8_LDB(B0, 0, 0); PG8_LDB(B1, 0, 1); PG8_SCHED; PG8_LDA(At, 0, 0); PG8_STAGE(PG8_SA(1, 1), a1 + hstepA, voffA);
            PG8_WAIT_V(8); PG8_WAIT_L(0); PG8_BAR; PG8_MMA(0, 0, At, B0); PG8_MMA(0, 1, At, B1); PG8_BAR; PG8_SCHED;
            PG8_LDA(At, 0, 1); PG8_STAGE(PG8_SB(0, 0), b2, voffB); PG8_STAGE(PG8_SB(0, 1), b2 + hstep, voffB); PG8_STAGE(PG8_SA(0, 0), a2, voffA);
            PG8_WAIT_V(8); PG8_WAIT_L(0); PG8_BAR; PG8_MMA(1, 0, At, B0); PG8_MMA(1, 1, At, B1); PG8_BAR; PG8_SCHED;
            PG8_LDB(B0, 1, 0); PG8_LDB(B1, 1, 1); PG8_SCHED; PG8_LDA(At, 1, 0); PG8_STAGE(PG8_SA(0, 1), a2 + hstepA, voffA);
            PG8_WAIT_V(8); PG8_WAIT_L(0); PG8_BAR; PG8_MMA(0, 0, At, B0); PG8_MMA(0, 1, At, B1); PG8_BAR; PG8_SCHED;
            PG8_LDA(At, 1, 1); PG8_STAGE(PG8_SB(1, 0), b3, voffB); PG8_STAGE(PG8_SB(1, 1), b3 + hstep, voffB); PG8_STAGE(PG8_SA(1, 0), a3, voffA);
            PG8_WAIT_V(8); PG8_WAIT_L(0); PG8_BAR; PG8_MMA(1, 0, At, B0); PG8_MMA(1, 1, At, B1); PG8_BAR; PG8_SCHED;
            } else {
            PG8_LDB(B0, 0, 0); PG8_SCHED; PG8_LDA(At, 0, 0); PG8_STAGE(PG8_SA(1, 1), a1 + hstepA, voffA);
            PG8_WAIT_L(8); PG8_BAR; PG8_WAIT_L(0); PG8_MMA(0, 0, At, B0); PG8_BAR; PG8_SCHED;
            PG8_LDB(B1, 0, 1); PG8_STAGE(PG8_SB(0, 0), b2, voffB);
            PG8_BAR; PG8_WAIT_L(0); PG8_MMA(0, 1, At, B1); PG8_BAR;
            PG8_LDA(At, 0, 1); PG8_STAGE(PG8_SA(0, 0), a2, voffA);
            PG8_BAR; PG8_WAIT_L(0); PG8_MMA(1, 0, At, B0); PG8_BAR; PG8_SCHED;
            PG8_STAGE(PG8_SB(0, 1), b2 + hstep, voffB);
            PG8_WAIT_V(6); PG8_BAR; PG8_MMA(1, 1, At, B1); PG8_BAR;
            PG8_LDB(B0, 1, 0); PG8_SCHED; PG8_LDA(At, 1, 0); PG8_STAGE(PG8_SA(0, 1), a2 + hstepA, voffA);
            PG8_WAIT_L(8); PG8_BAR; PG8_WAIT_L(0); PG8_MMA(0, 0, At, B0); PG8_BAR; PG8_SCHED;
            PG8_LDB(B1, 1, 1); PG8_STAGE(PG8_SB(1, 0), b3, voffB);
            PG8_BAR; PG8_WAIT_L(0); PG8_MMA(0, 1, At, B1); PG8_BAR;
            PG8_LDA(At, 1, 1); PG8_STAGE(PG8_SA(1, 0), a3, voffA);
            PG8_BAR; PG8_WAIT_L(0); PG8_MMA(1, 0, At, B0); PG8_BAR; PG8_SCHED;
            PG8_STAGE(PG8_SB(1, 1), b3 + hstep, voffB);
            PG8_WAIT_V(6); PG8_BAR; PG8_MMA(1, 1, At, B1); PG8_BAR;
            }
        }
        if constexpr (ALIGN_EPI) { if (wr == 0) PG8_BAR; }
        E(acc, cur, wr, wc, fr, fq); S.done(cur);
#ifdef DBG_EPI2
        if (ES == 1) { asm volatile("" ::: "memory"); E(acc, cur, wr, wc, fr, fq); }
#endif
        if (!has_next) break;
#pragma unroll
        for (int a = 0; a < 2; ++a)
#pragma unroll
            for (int b = 0; b < 2; ++b)
#pragma unroll
                for (int m = 0; m < 4; ++m)
#pragma unroll
                    for (int n = 0; n < 2; ++n) acc[a][b][m][n] = (f32x4){0.f, 0.f, 0.f, 0.f};
        cur = nxt; cA = nA; cB = nB; ++ui;
        if constexpr (ALIGN_EPI) { if (wr == 1) PG8_BAR; }
    }
    PG8_WAIT_V(0);
    if constexpr (!ALIGN_EPI) { if (wr == 0) PG8_BAR; }
    PG8_BAR;
#undef PG8_SA
#undef PG8_SB
#undef PG8_STAGE
#undef PG8_LDA
#undef PG8_LDB
#undef PG8_MMA
#undef PG8_WAIT_V
#undef PG8_WAIT_L
#undef PG8_BAR
#undef PG8_SCHED
}
}

constexpr int NWAVES = 8, NTHR = 512;
constexpr int BATCH = 4, SEQ = 4096, T = BATCH * SEQ, DM = 2048, DEPTH = 2;
constexpr float EPS = 1e-6f;
constexpr int PLE_DIM = 256;
constexpr int GH = 4, GD = 128, GW = 512, GCH = 64, GNC = SEQ / GCH;
constexpr int SH = 16, SP = 64, SWD = 1024, SG = 2, SN = 128, SCH = 256, SNC = SEQ / SCH, SCONV = 1536;
constexpr int MH = 4, MQR = 384, MKVR = 256, MNOPE = 128, MROPE = 64, MQK = 192, MV = 128;
constexpr int D_IN = 5336, D_INP = 5376;
constexpr int FF0 = 5632, NEXP = 8, FFE = 7168;
constexpr int U_GQ = 0, U_GK = 512, U_GV = 1024, U_GZ = 1536, U_SZ = 2048, U_SX = 3072, U_MQ = 4608, U_MKV = 4992, U_MPE = 5248, U_GB = 5312, U_GA = 5316, U_SDT = 5320;
constexpr int S_GDN = 0, S_GBA = 2048, S_SZ = 2056, S_SX = 3080, S_SDT = 4616, S_MQ = 4632, S_MKV = 5016, S_MPE = 5272;
constexpr int MAXSLOT_TILES = 136, MAXSLOTS = MAXSLOT_TILES * 256;

constexpr size_t MiB = 1u << 20;
constexpr size_t al256(size_t x) { return (x + 255) & ~(size_t)255; }
constexpr size_t WS_CTL = 0, CTL_ZERO_BYTES = 1 * MiB;
constexpr size_t SZ_WIN = (size_t)D_INP * DM * 2, SZ_WOUT = (size_t)DM * DM * 2, SZ_WQB = (size_t)768 * MQR * 2, SZ_WKVB = (size_t)1024 * MKVR * 2;
constexpr size_t SZ_WGU = (size_t)2 * FF0 * DM * 2, SZ_WDN = (size_t)DM * FF0 * 2, SZ_WMGU = (size_t)NEXP * 2 * FFE * DM * 2, SZ_WMDN = (size_t)NEXP * DM * FFE * 2;
constexpr size_t SZ_WPP = (size_t)DM * PLE_DIM * 2, SZ_WPG = (size_t)DM * DM * 2;
constexpr size_t WS_WIN = 1 * MiB;
constexpr size_t WS_WOUT = WS_WIN + 2 * SZ_WIN;
constexpr size_t WS_WQB = WS_WOUT + 2 * SZ_WOUT;
constexpr size_t WS_WKVB = WS_WQB + 2 * SZ_WQB;
constexpr size_t WS_WGU = WS_WKVB + 2 * SZ_WKVB;
constexpr size_t WS_WDN = WS_WGU + SZ_WGU;
constexpr size_t WS_WMGU = WS_WDN + SZ_WDN;
constexpr size_t WS_WMDN = WS_WMGU + SZ_WMGU;
constexpr size_t WS_SWIN = WS_WIN + 2 * SZ_WIN - 1 * MiB;
constexpr size_t WS_SDD = WS_WDN + 12 * MiB;
constexpr size_t WS_SDM = WS_WMDN + 120 * MiB;
constexpr size_t WS_SA2 = WS_WMDN + 121 * MiB;
static_assert(SZ_WDN / 2 <= 12 * MiB && SZ_WMDN / 2 <= 120 * MiB && WS_SA2 + (size_t)MAXSLOTS * 4 <= WS_WMDN + SZ_WMDN, "int8 down map");
constexpr size_t WS_WPG8 = WS_WGU + 26 * MiB;
constexpr size_t WS_SPG = WS_WGU + 35 * MiB;
static_assert(WS_WPG8 + 2 * (size_t)DM * DM <= WS_SPG && WS_SPG + 16384 <= WS_WDN, "ple int8 map");
constexpr size_t WS_SWD = WS_WGU + 24 * MiB;
constexpr size_t WS_SWM = WS_WMGU + 236 * MiB;
constexpr size_t WS_HN8 = WS_WMGU + 240 * MiB;
constexpr size_t WS_SA = WS_WMGU + 280 * MiB;
constexpr size_t WS_SSP = WS_WMGU + 284 * MiB;
constexpr size_t WS_RSE = WS_WMGU + 290 * MiB;
constexpr size_t WS_XSC = WS_WMGU + 281 * MiB;
static_assert(SZ_WGU / 2 <= 24 * MiB && SZ_WMGU / 2 <= 236 * MiB && WS_XSC + (size_t)MAXSLOTS * 4 <= WS_WMDN && WS_HN8 + (size_t)T * DM <= WS_SA, "int8 map");
constexpr size_t WS_WPP = WS_WMDN + SZ_WMDN;
constexpr size_t WS_WPG = WS_WPP + 2 * SZ_WPP;
constexpr size_t WS_PB = WS_WPG + 2 * SZ_WPG;
constexpr size_t WS_ROPE = WS_PB + (size_t)2 * T * PLE_DIM * 2;
constexpr size_t WS_HN = WS_ROPE + (size_t)T * 64 * 4;
constexpr size_t WS_MIX = WS_HN + (size_t)T * DM * 2;
constexpr size_t WS_E = WS_MIX + (size_t)T * DM * 2;
constexpr size_t WS_ROUTE = WS_E + (size_t)T * DM * 2;
constexpr size_t WS_R = WS_ROUTE + (size_t)T * 2 * 4 * 3;
constexpr size_t R_U = WS_R;
constexpr size_t R_GQKV = R_U + (size_t)T * D_INP * 2;
constexpr size_t R_GBG = R_GQKV + (size_t)T * 1536 * 2;
constexpr size_t R_XC = R_GBG + (size_t)T * 8 * 4;
constexpr size_t R_DT = R_XC + (size_t)T * 1536 * 2;
constexpr size_t R_QLN = R_DT + (size_t)T * 16 * 4;
constexpr size_t R_KVLN = R_QLN + (size_t)T * MQR * 2;
constexpr size_t R_QRAW = R_KVLN + (size_t)T * MKVR * 2;
constexpr size_t R_KVRAW = R_QRAW + (size_t)T * 768 * 2;
constexpr size_t R_Q = R_KVRAW + (size_t)T * 1024 * 2;
constexpr size_t R_K = R_Q + (size_t)T * 768 * 2;
constexpr int GNU = BATCH * GH * GNC;
constexpr size_t R_GUT = R_K + (size_t)T * 768 * 2;
constexpr size_t R_GW = R_GUT + (size_t)GNU * 8192 * 2;
constexpr size_t R_GQD = R_GW + (size_t)GNU * 8192 * 2;
constexpr size_t R_GKDT = R_GQD + (size_t)GNU * 8192 * 2;
constexpr size_t R_GIN = R_GKDT + (size_t)GNU * 8192 * 2;
constexpr size_t R_GEND = R_GIN + (size_t)GNU * 4096 * 2;
constexpr size_t R_SST = R_GEND + 4096;
constexpr size_t R_SPV = R_SST + (size_t)BATCH * SNC * SH * SP * SN * 4;
constexpr size_t R_SDA = R_SPV + (size_t)BATCH * SNC * SH * SP * SN * 2;
constexpr size_t R_MIXEND = R_SDA + 4096;
constexpr size_t R_ACT = WS_R;
constexpr size_t R_XP = WS_R;
constexpr size_t R_ACTP = R_XP + (size_t)MAXSLOTS * DM * 2;
constexpr size_t R_FFNEND = R_ACTP + (size_t)MAXSLOTS * FFE * 2;
constexpr size_t WS_END = (R_MIXEND > R_FFNEND ? R_MIXEND : R_FFNEND);
static_assert(WS_END < (size_t)1850 * MiB * 1ull && (WS_R % 256) == 0, "d_ws map");

constexpr int CW_TMO = 0;
constexpr int CW_CNT = 64;
constexpr int CW_CUR = 128;
constexpr int CW_TOFF = 192;
constexpr int CW_CMAX = 65536;

constexpr int CW_BAR = 4096;

constexpr int RING_BYTES = 131072;
constexpr int MISC_OFF = RING_BYTES;
constexpr int LDS_BYTES = 147456;

#define XB_TMO      128
#define XB_XCNT(j)  (256  + 64 * (j))
#define XB_XSUB(j)  (1280 + 64 * (j))
#define XB_XGEN(j)  (2304 + 64 * (j))
#define XB_TOP      3328
#define XB_TOPGEN   3392
#define XCD_BAR_WORDS 3456
#define XB_SPIN_CAP (1u << 18)

__device__ __forceinline__ unsigned xb_ld(unsigned* p)              { return __hip_atomic_load(p, __ATOMIC_RELAXED, __HIP_MEMORY_SCOPE_AGENT); }
__device__ __forceinline__ unsigned xb_add(unsigned* p, unsigned v) { return __hip_atomic_fetch_add(p, v, __ATOMIC_RELAXED, __HIP_MEMORY_SCOPE_AGENT); }
__device__ __forceinline__ unsigned xb_xcc_id() { return (unsigned)__builtin_amdgcn_s_getreg((3 << 11) | 20) & 0xFu; }
#define XB_SPIN(cond, bar) do { unsigned _sp = 0; while (cond) { __builtin_amdgcn_s_sleep(1); \
    if ((++_sp & 255u) == 0u) { if (xb_ld(&(bar)[XB_TMO])) break; if (_sp > XB_SPIN_CAP) { atomicAdd(&(bar)[XB_TMO], 1u); break; } } } } while (0)

struct XcdBarrier {
    unsigned* bar; unsigned x;
    volatile LAS unsigned* st;
};
__device__ __forceinline__ XcdBarrier xcd_barrier_post(unsigned* bar, volatile LAS unsigned* st) {
    XcdBarrier b; b.bar = bar; b.x = xb_xcc_id(); b.st = st;
    if (threadIdx.x == 0) (void)xb_add(&bar[XB_XCNT(b.x)], 1u);
    return b;
}
__device__ __forceinline__ void xcd_barrier_complete(unsigned* bar, unsigned x, unsigned& nloc, unsigned& nx) {
    const unsigned G = gridDim.x * gridDim.y * gridDim.z;
    unsigned sum, cnt, mine, sp = 0u;
    for (;;) {
        sum = 0u; cnt = 0u; mine = 0u;
#pragma unroll
        for (unsigned j = 0; j < 16; ++j) { const unsigned c = xb_ld(&bar[XB_XCNT(j)]); sum += c; cnt += (c > 0u) ? 1u : 0u; mine = (j == x) ? c : mine; }
        if (sum == G) break;
        __builtin_amdgcn_s_sleep(1);
        if ((++sp & 255u) == 0u) { if (xb_ld(&bar[XB_TMO])) break; if (sp > XB_SPIN_CAP) { atomicAdd(&bar[XB_TMO], 1u); break; } }
    }
    nloc = mine > 0u ? mine : 1u; nx = cnt > 0u ? cnt : 1u;
}
__device__ __forceinline__ void xcd_barrier(const XcdBarrier& b) {
    asm volatile("s_waitcnt vmcnt(0)" ::: "memory");
    __syncthreads();
    if (threadIdx.x == 0) {
        unsigned* bar = b.bar;
        __builtin_amdgcn_s_waitcnt(0);
        unsigned nloc = b.st[0], nx = b.st[1];
        if (nloc == 0u) { xcd_barrier_complete(bar, b.x, nloc, nx); b.st[0] = nloc; b.st[1] = nx; }
        const unsigned old = xb_add(&bar[XB_XSUB(b.x)], 1u);
        const unsigned gen = old / nloc;
        if (old + 1u == (gen + 1u) * nloc) {
            __builtin_amdgcn_fence(__ATOMIC_RELEASE, "agent");
            asm volatile("s_waitcnt vmcnt(0)" ::: "memory");
            const unsigned og = xb_add(&bar[XB_TOP], 1u);
            const unsigned tg = og / nx;
            if (og + 1u == (tg + 1u) * nx) xb_add(&bar[XB_TOPGEN], 1u);
            else XB_SPIN(xb_ld(&bar[XB_TOPGEN]) == tg, bar);
            __builtin_amdgcn_fence(__ATOMIC_ACQUIRE, "agent");
            xb_add(&bar[XB_XGEN(b.x)], 1u);
            asm volatile("s_waitcnt vmcnt(0)" ::: "memory");
        } else {
            XB_SPIN(xb_ld(&bar[XB_XGEN(b.x)]) == gen, bar);
            __builtin_amdgcn_fence(__ATOMIC_ACQUIRE, "agent");
            asm volatile("s_waitcnt vmcnt(0)" ::: "memory");
        }
    }
    __syncthreads();
}

#define MFMA16(a, b, c) __builtin_amdgcn_mfma_f32_16x16x32_bf16((a), (b), (c), 0, 0, 0)
__device__ __forceinline__ bf16x8 lds_frag(const LAS unsigned char* base, int ldb, int row0, int k0, int lane) {
    return *(const LAS bf16x8*)(base + (row0 + (lane & 15)) * ldb + (k0 + 8 * (lane >> 4)) * 2);
}
__device__ __forceinline__ bf16x8 glb_frag(const bf16* base, int ld, int row0, int k0, int lane) {
    return *(const bf16x8*)(base + (size_t)(row0 + (lane & 15)) * ld + k0 + 8 * (lane >> 4));
}
__device__ __forceinline__ s16x4 tr_rd(const LAS unsigned char* p) { return __builtin_amdgcn_ds_read_tr16_b64_v4i16((LAS s16x4*)p); }
__device__ __forceinline__ bf16x8 lds_frag_tr(const LAS unsigned char* base, int ldb, int k0, int n0, int lane) {
    const int g = lane >> 4, q = (lane & 15) >> 2, p = lane & 3;
    const LAS unsigned char* a = base + (k0 + 8 * g + q) * ldb + (n0 + 4 * p) * 2;
    const s16x4 lo = tr_rd(a), hi = tr_rd(a + 4 * ldb);
    return (bf16x8){lo[0], lo[1], lo[2], lo[3], hi[0], hi[1], hi[2], hi[3]};
}
__device__ __forceinline__ bf16x8 lds_frag_trp(const LAS unsigned char* base, int ldb, int k0, int n0, int lane) {
    const int g = lane >> 4, q = (lane & 15) >> 2, p = lane & 3;
    const LAS unsigned char* a = base + (k0 + 4 * g + q) * ldb + (n0 + 4 * p) * 2;
    const s16x4 lo = tr_rd(a), hi = tr_rd(a + 16 * ldb);
    return (bf16x8){lo[0], lo[1], lo[2], lo[3], hi[0], hi[1], hi[2], hi[3]};
}
__device__ __forceinline__ bf16x8 pack_frag(const f32x4 a, const f32x4 b) {
    u32x4 w; w.x = cvt_pk_bf16(a[0], a[1]); w.y = cvt_pk_bf16(a[2], a[3]); w.z = cvt_pk_bf16(b[0], b[1]); w.w = cvt_pk_bf16(b[2], b[3]);
    return __builtin_bit_cast(bf16x8, w);
}
__device__ __forceinline__ v2u pack4(const f32x4 a) { v2u w; w.x = cvt_pk_bf16(a[0], a[1]); w.y = cvt_pk_bf16(a[2], a[3]); return w; }
__device__ __forceinline__ v2u pack4_mfma(const f32x4 a) { v2u w; w.x = cvt_pk_bf16_cv(a[0], a[1]); w.y = cvt_pk_bf16_cv(a[2], a[3]); return w; }

__device__ __forceinline__ void tr_item(const float* __restrict__ W, int ld, int sc, int k0, bf16* __restrict__ WT, int K, int drow0, LAS float* scr, int lane) {
#pragma unroll 8
    for (int i = 0; i < 32; ++i) { const int kk = 2 * i + (lane >> 5); scr[kk * 33 + (lane & 31)] = sc >= 0 ? W[(size_t)(k0 + kk) * ld + sc] : 0.f; }
    LDS_WAIT(); asm volatile("" ::: "memory");
    const int c = lane & 7;
#pragma unroll
    for (int j = 0; j < 4; ++j) { const int n = (lane >> 3) + 8 * j; const LAS float* s = scr + (8 * c) * 33 + n;
        v4u o; o.x = cvt_pk_bf16(s[0 * 33], s[1 * 33]); o.y = cvt_pk_bf16(s[2 * 33], s[3 * 33]); o.z = cvt_pk_bf16(s[4 * 33], s[5 * 33]); o.w = cvt_pk_bf16(s[6 * 33], s[7 * 33]);
        *(v4u*)(WT + (size_t)(drow0 + n) * K + k0 + 8 * c) = o; }
    LDS_WAIT(); asm volatile("" ::: "memory");
}
__device__ __forceinline__ int win_src(int d) {
    if (d < 2048) return d;
    if (d < 4608) return d + 8;
    if (d < 5312) return d + 24;
    if (d < 5320) return S_GBA + (d - 5312);
    if (d < 5336) return S_SDT + (d - 5320);
    return -1;
}
__device__ __forceinline__ void conv_plain(const float* W, int ld, int K, int ncb, bf16* WT, int it, LAS float* scr, int lane) {
    const int kb = it / ncb, nb = it % ncb; tr_item(W, ld, 32 * nb + (lane & 31), 64 * kb, WT, K, 32 * nb, scr, lane);
}
__device__ __forceinline__ void conv_gu(const float* W, int ld, int K, int ncb, bf16* WT, int s, int it, LAS float* scr, int lane) {
    const int kb = it / ncb, nb = it % ncb; tr_item(W, ld, 32 * nb + (lane & 31), 64 * kb, WT, K, 256 * (nb >> 2) + 128 * s + 32 * (nb & 3), scr, lane);
}
__device__ __forceinline__ void q8_strip(const float* __restrict__ W, int ld, int sc  , signed char* __restrict__ W8, float* __restrict__ sw, int drow0, LAS unsigned char* lds, int lane, int wave) {
    const float* wp = W + (size_t)(256 * wave + (lane >> 5)) * ld + (sc < 0 ? 0 : sc);
    LAS float* scr = (LAS float*)(lds + wave * 16384); LAS float* cm = (LAS float*)(lds + 8448);
    float v[128];
#pragma unroll
    for (int i = 0; i < 128; ++i) v[i] = sc < 0 ? 0.f : wp[(size_t)(2 * i) * ld];
    __builtin_amdgcn_sched_barrier(0);
    float mx = 0.f;
#pragma unroll
    for (int i = 0; i < 128; ++i) mx = fmaxf(mx, fabsf(v[i]));
    mx = max32(mx);
    if (lane < 32) cm[wave * 32 + lane] = mx;
    __syncthreads();
#pragma unroll
    for (int w = 0; w < 8; ++w) mx = fmaxf(mx, cm[w * 32 + (lane & 31)]);
    const float inv = mx > 0.f ? 127.0f / mx : 0.f;
    if (wave == 0 && lane < 32) sw[drow0 + lane] = mx > 0.f ? mx * (1.0f / 127.0f) : 1.0f;
#pragma unroll
    for (int c = 0; c < 4; ++c) {
#pragma unroll
        for (int i = 0; i < 32; ++i) scr[(2 * i + (lane >> 5)) * 33 + (lane & 31)] = v[32 * c + i] * inv;
        LDS_WAIT(); asm volatile("" ::: "memory");
        const int n = lane & 31, kh = lane >> 5; unsigned w[8];
#pragma unroll
        for (int q = 0; q < 8; ++q) { unsigned pk = 0u;
#pragma unroll
            for (int b = 0; b < 4; ++b) { int x = (int)rintf(scr[(32 * kh + 4 * q + b) * 33 + n]); x = x > 127 ? 127 : (x < -127 ? -127 : x); pk |= ((unsigned)x & 0xffu) << (8 * b); }
            w[q] = pk; }
        v4u* dst = (v4u*)(W8 + (size_t)(drow0 + n) * DM + 256 * wave + 64 * c + 32 * kh);
        dst[0] = (v4u){w[0], w[1], w[2], w[3]}; dst[1] = (v4u){w[4], w[5], w[6], w[7]};
        LDS_WAIT(); asm volatile("" ::: "memory");
    }
    __syncthreads();
}
__device__ __forceinline__ void down_colmax_item(const float* __restrict__ W, int r0, int c0, unsigned* __restrict__ cmax, int lane) {
    const f32x4* wp = (const f32x4*)(W + (size_t)r0 * DM + c0) + lane;
    f32x4 mx = {0.f, 0.f, 0.f, 0.f};
#pragma unroll 16
    for (int i = 0; i < 256; ++i) { const f32x4 v = wp[(size_t)i * (DM / 4)]; mx[0] = fmaxf(mx[0], fabsf(v[0])); mx[1] = fmaxf(mx[1], fabsf(v[1])); mx[2] = fmaxf(mx[2], fabsf(v[2])); mx[3] = fmaxf(mx[3], fabsf(v[3])); }
#pragma unroll
    for (int i = 0; i < 4; ++i) __hip_atomic_fetch_max(cmax + c0 + 4 * lane + i, __float_as_uint(mx[i]), RLX_AGENT);
}
__device__ __forceinline__ void down_quant_item(const float* __restrict__ W, int K, int ch, int n0, const unsigned* __restrict__ cmax, signed char* __restrict__ W8, float* __restrict__ sw, int drow0,
                                                LAS unsigned char* lds, int lane, int wave) {
    const int r0 = 2048 * ch + 256 * wave;
    LAS float* scr = (LAS float*)(lds + wave * 16384);
    const float mx = __uint_as_float(__hip_atomic_load(cmax + n0 + (lane & 31), RLX_AGENT));
    const float inv = mx > 0.f ? 127.0f / mx : 0.f;
    if (ch == 0 && wave == 0 && lane < 32) sw[drow0 + lane] = mx > 0.f ? mx * (1.0f / 127.0f) : 1.0f;
    if (r0 < K) {
        const float* wp = W + (size_t)(r0 + (lane >> 5)) * DM + n0 + (lane & 31);
        float v[128];
#pragma unroll
        for (int i = 0; i < 128; ++i) v[i] = wp[(size_t)(2 * i) * DM];
#pragma unroll
        for (int c = 0; c < 4; ++c) {
#pragma unroll
            for (int i = 0; i < 32; ++i) scr[(2 * i + (lane >> 5)) * 33 + (lane & 31)] = v[32 * c + i] * inv;
            LDS_WAIT(); asm volatile("" ::: "memory");
            const int n = lane & 31, kh = lane >> 5; unsigned w[8];
#pragma unroll
            for (int q = 0; q < 8; ++q) { unsigned pk = 0u;
#pragma unroll
                for (int b = 0; b < 4; ++b) { int x = (int)rintf(scr[(32 * kh + 4 * q + b) * 33 + n]); x = x > 127 ? 127 : (x < -127 ? -127 : x); pk |= ((unsigned)x & 0xffu) << (8 * b); }
                w[q] = pk; }
            v4u* dst = (v4u*)(W8 + (size_t)(drow0 + n) * K + r0 + 64 * c + 32 * kh);
            dst[0] = (v4u){w[0], w[1], w[2], w[3]}; dst[1] = (v4u){w[4], w[5], w[6], w[7]};
            LDS_WAIT(); asm volatile("" ::: "memory");
        }
    }
}
__device__ __forceinline__ void down_rowq_item(const float* __restrict__ W, int K, int k0, signed char* __restrict__ W8, float* __restrict__ sk, LAS unsigned char* lds, int tid, int lane, int wave) {
    const float MG = 12582912.0f;
#pragma unroll 1
    for (int grp = 0; grp < 2; ++grp) {
        const int r0 = 8 * wave + 4 * grp;
        f32x4 x[4][8];
#pragma unroll
        for (int r = 0; r < 4; ++r)
#pragma unroll
            for (int j = 0; j < 8; ++j) x[r][j] = *(const f32x4*)(W + (size_t)(k0 + r0 + r) * DM + 4 * (lane + 64 * j));
#pragma unroll
        for (int r = 0; r < 4; ++r) { float mx = 0.f;
#pragma unroll
            for (int j = 0; j < 8; ++j) mx = fmaxf(fmaxf(mx, fmaxf(fabsf(x[r][j][0]), fabsf(x[r][j][1]))), fmaxf(fabsf(x[r][j][2]), fabsf(x[r][j][3])));
            mx = fmaxf(mx, shx<1>(mx)); mx = fmaxf(mx, shx<2>(mx)); mx = fmaxf(mx, shx<4>(mx)); mx = fmaxf(mx, shx<8>(mx)); mx = fmaxf(mx, shx<16>(mx)); mx = max32(mx);
            const float inv = mx > 0.f ? 127.0f / mx : 0.f;
            if (lane == 0) sk[k0 + r0 + r] = mx > 0.f ? mx * (1.0f / 127.0f) : 1.0f;
            LAS unsigned* row = (LAS unsigned*)(lds + (r0 + r) * 2048) + lane;
#pragma unroll
            for (int j = 0; j < 8; ++j) {
                const unsigned y0 = __float_as_uint(fmaf(x[r][j][0], inv, MG)), y1 = __float_as_uint(fmaf(x[r][j][1], inv, MG)), y2 = __float_as_uint(fmaf(x[r][j][2], inv, MG)), y3 = __float_as_uint(fmaf(x[r][j][3], inv, MG));
                const unsigned lo = __builtin_amdgcn_perm(y1, y0, 0x0c0c0400u), hi = __builtin_amdgcn_perm(y3, y2, 0x0c0c0400u);
                row[64 * j] = __builtin_amdgcn_perm(hi, lo, 0x05040100u); } }
    }
    __syncthreads();
    const LAS unsigned* col = (const LAS unsigned*)lds + tid;
    signed char* o = W8 + (size_t)(4 * tid) * K + k0;
#pragma unroll
    for (int kq = 0; kq < 4; ++kq) { unsigned oc[4][4];
#pragma unroll
        for (int b = 0; b < 4; ++b) { const int kr = 16 * kq + 4 * b;
            const unsigned d0 = col[(kr + 0) * 512], d1 = col[(kr + 1) * 512], d2 = col[(kr + 2) * 512], d3 = col[(kr + 3) * 512];
            const unsigned t01l = __builtin_amdgcn_perm(d1, d0, 0x05010400u), t01h = __builtin_amdgcn_perm(d1, d0, 0x07030602u);
            const unsigned t23l = __builtin_amdgcn_perm(d3, d2, 0x05010400u), t23h = __builtin_amdgcn_perm(d3, d2, 0x07030602u);
            oc[0][b] = __builtin_amdgcn_perm(t23l, t01l, 0x05040100u); oc[1][b] = __builtin_amdgcn_perm(t23l, t01l, 0x07060302u);
            oc[2][b] = __builtin_amdgcn_perm(t23h, t01h, 0x05040100u); oc[3][b] = __builtin_amdgcn_perm(t23h, t01h, 0x07060302u); }
#pragma unroll
        for (int c = 0; c < 4; ++c) *(v4u*)(o + (size_t)c * K + 16 * kq) = (v4u){oc[c][0], oc[c][1], oc[c][2], oc[c][3]}; }
    __syncthreads();
}
constexpr size_t WS_SKD = WS_WDN + 13 * MiB;
constexpr size_t WS_SKM = WS_WMDN + 122 * MiB;
constexpr int DQ_DENSE = FF0 / 64, DQ_EXP = FFE / 64, DQ_TOTAL = DQ_DENSE + NEXP * DQ_EXP;
__device__ __forceinline__ void down_quant_phase(const float* wd, const float* wmd, unsigned char* ws, LAS unsigned char* lds, int first, int stride, int lane, int wave) {
    const int tid = wave * 64 + lane;
    for (int it = first; it < DQ_TOTAL; it += stride) {
        if (it < DQ_DENSE) down_rowq_item(wd, FF0, 64 * it, (signed char*)(ws + WS_WDN), (float*)(ws + WS_SKD), lds, tid, lane, wave);
        else { const int r = it - DQ_DENSE, e = r / DQ_EXP, q = r % DQ_EXP;
            down_rowq_item(wmd + (size_t)e * FFE * DM, FFE, 64 * q, (signed char*)(ws + WS_WMDN) + (size_t)e * DM * FFE, (float*)(ws + WS_SKM) + (size_t)e * FFE, lds, tid, lane, wave); }
    }
}
__device__ __forceinline__ void scale_fold(int L, unsigned char* ws, int gtid, int NGT) {
    if (L == 0) { float* sw = (float*)(ws + WS_SWD); const float* sk = (const float*)(ws + WS_SKD); float* sd = (float*)(ws + WS_SDD);
        for (int k = gtid; k < FF0; k += NGT) sw[256 * (k >> 7) + 128 + (k & 127)] *= sk[k];
        for (int n = gtid; n < DM; n += NGT) sd[n] = 1.0f; }
    else { float* swm = (float*)(ws + WS_SWM); const float* sk = (const float*)(ws + WS_SKM); float* sd = (float*)(ws + WS_SDM);
        for (int i = gtid; i < NEXP * FFE; i += NGT) { const int e = i / FFE, k = i - e * FFE; swm[(size_t)e * 2 * FFE + 256 * (k >> 7) + 128 + (k & 127)] *= sk[i]; }
        for (int n = gtid; n < NEXP * DM; n += NGT) sd[n] = 1.0f; }
}
struct In { const float* p[33]; };
typedef const In __attribute__((address_space(4)))* InP;
constexpr int IT_WIN = 0, IT_WOUT = 32 * 64, IT_WQB = 6 * 24, IT_WKVB = 4 * 32, IT_WPP = 4 * 64, IT_WPG = 32 * 64;
constexpr int IT_LAYER = IT_WIN + IT_WOUT + IT_WQB + IT_WKVB + IT_WPP + IT_WPG;
constexpr int IT_FD = 0, IT_DENSE = 0;
constexpr int IT_MD = 0, IT_EXP = 0;
constexpr int ST_WIN = 2 * 168, ST_DENSE = 2 * 176, ST_EXP = 2 * 224, ST_TOTAL = ST_WIN + ST_DENSE + NEXP * ST_EXP;
constexpr int IT_TOTAL = 2 * IT_LAYER + IT_DENSE + NEXP * IT_EXP;
__device__ __forceinline__ void moe_gu_quant_phase(InP in, unsigned char* ws, LAS unsigned char* lds, int lo, int hi, int first, int stride, int lane, int wave) {
    for (int st = lo + first; st < hi; st += stride) { int r = st;
        if (r >= NEXP * ST_EXP) { const int q = r - NEXP * ST_EXP, Lg = q >> 6, nb = q & 63;
            q8_strip(in->p[31] + (size_t)Lg * DM * DM, DM, 32 * nb + (lane & 31), (signed char*)(ws + WS_WPG8) + (size_t)Lg * DM * DM, (float*)(ws + WS_SPG) + Lg * DM, 32 * nb, lds, lane, wave); continue; }
        { const int e = r / ST_EXP; r -= e * ST_EXP; const int s = r / 224, nb = r % 224;
          q8_strip(in->p[27 + s] + (size_t)e * DM * FFE, FFE, 32 * nb + (lane & 31), (signed char*)(ws + WS_WMGU) + (size_t)e * 2 * FFE * DM, (float*)(ws + WS_SWM) + (size_t)e * 2 * FFE,
                   256 * (nb >> 2) + 128 * s + 32 * (nb & 3), lds, lane, wave); }
    }
}
__device__ __forceinline__ void prologue_phase(InP in, unsigned char* ws, LAS unsigned char* lds, int gw, int NGW, int wave, int lane, int gtid, int NGT, int bid, int G) {
    LAS float* scr = (LAS float*)(lds + wave * 16384);
    for (int it = gw; it < IT_TOTAL; it += NGW) {
        int r = it;
        if (r < 2 * IT_LAYER) {
            const int L = r / IT_LAYER; r -= L * IT_LAYER;
            if (r < IT_WOUT) { conv_plain(in->p[5] + (size_t)L * DM * DM, DM, DM, 64, (bf16*)(ws + WS_WOUT + L * SZ_WOUT), r, scr, lane); continue; }
            r -= IT_WOUT;
            if (r < IT_WQB) { conv_plain(in->p[17] + (size_t)L * MQR * 768, 768, MQR, 24, (bf16*)(ws + WS_WQB + L * SZ_WQB), r, scr, lane); continue; }
            r -= IT_WQB;
            if (r < IT_WKVB) { conv_plain(in->p[19] + (size_t)L * MKVR * 1024, 1024, MKVR, 32, (bf16*)(ws + WS_WKVB + L * SZ_WKVB), r, scr, lane); continue; }
            r -= IT_WKVB;
            if (r < IT_WPP) { conv_plain(in->p[30] + (size_t)L * PLE_DIM * DM, DM, PLE_DIM, 64, (bf16*)(ws + WS_WPP + L * SZ_WPP), r, scr, lane); continue; }
            r -= IT_WPP;
            continue;
        }
        r -= 2 * IT_LAYER;
        if (r < IT_DENSE) {
            continue;
        }
        r -= IT_DENSE;
        { }
    }
    for (int st = bid; st < ST_WIN + ST_DENSE; st += G) {
        int r = st;
        if (r < ST_WIN) { const int L = r / 168, nb = r % 168;
            q8_strip(in->p[4] + (size_t)L * DM * D_IN, D_IN, win_src(32 * nb + (lane & 31)), (signed char*)(ws + WS_WIN) + (size_t)L * (SZ_WIN / 2), (float*)(ws + WS_SWIN) + L * D_INP, 32 * nb, lds, lane, wave); continue; }
        r -= ST_WIN;
        if (r < ST_DENSE) { const int s = r / 176, nb = r % 176;
            q8_strip(in->p[23 + s], FF0, 32 * nb + (lane & 31), (signed char*)(ws + WS_WGU), (float*)(ws + WS_SWD), 256 * (nb >> 2) + 128 * s + 32 * (nb & 3), lds, lane, wave); continue; }
    }
    { const float* p = in->p[1]; bf16* pb = (bf16*)(ws + WS_PB);
      for (size_t i = (size_t)gtid * 8; i < (size_t)2 * T * PLE_DIM; i += (size_t)NGT * 8) {
          const f32x4 a = *(const f32x4*)(p + i), b = *(const f32x4*)(p + i + 4);
          v4u o; o.x = cvt_pk_bf16(a[0], a[1]); o.y = cvt_pk_bf16(a[2], a[3]); o.z = cvt_pk_bf16(b[0], b[1]); o.w = cvt_pk_bf16(b[2], b[3]);
          *(v4u*)(pb + i) = o; } }
    { const int* pos = (const int*)in->p[2]; float* rt = (float*)(ws + WS_ROPE);
      for (int i = gtid; i < T * 32; i += NGT) { const int m = i >> 5, k = i & 31;
          const float inv = 1.0f / powf(10000.0f, (float)k * (1.0f / 32.0f)); const float ang = (float)pos[m] * inv;
          float s, c; sincosf(ang, &s, &c); rt[m * 64 + k] = c; rt[m * 64 + 32 + k] = s; } }
}

template <bool ROUTE, bool OUT8>
__device__ __forceinline__ void rms_phase(const float* __restrict__ h, const float* __restrict__ g, bf16* __restrict__ hn, signed char* __restrict__ hn8, float* __restrict__ sa, const float* __restrict__ Wr,
                                          int* tok_e, float* tok_w, unsigned* cnt, LAS unsigned char* lds, int gw, int NGW, int lane, int tid) {
    LAS float* wr = (LAS float*)lds;
    LAS unsigned* lcnt = (LAS unsigned*)(lds + 65536);
    if (ROUTE) {
        for (int i = tid; i < DM * 8 / 4; i += NTHR) ((LAS f32x4*)wr)[i] = ((const f32x4*)Wr)[i];
        if (tid < 8) lcnt[tid] = 0u;
        __syncthreads();
    }
    f32x4 gv[8];
#pragma unroll
    for (int j = 0; j < 8; ++j) gv[j] = ((const f32x4*)g)[lane + 64 * j];
    for (int m = gw; m < T; m += NGW) {
        const f32x4* xr = (const f32x4*)(h + (size_t)m * DM) + lane;
        f32x4 v[8]; float s = 0.f;
#pragma unroll
        for (int j = 0; j < 8; ++j) { v[j] = xr[64 * j]; s += (v[j].x * v[j].x + v[j].y * v[j].y) + (v[j].z * v[j].z + v[j].w * v[j].w); }
        const float rs = rsqrtf(wave_sum(s) * (1.0f / DM) + EPS);
#pragma unroll
        for (int j = 0; j < 8; ++j) v[j] = v[j] * rs * gv[j];
        if (OUT8) {
            float mx = 0.f;
#pragma unroll
            for (int j = 0; j < 8; ++j) mx = fmaxf(fmaxf(mx, fmaxf(fabsf(v[j].x), fabsf(v[j].y))), fmaxf(fabsf(v[j].z), fabsf(v[j].w)));
            mx = fmaxf(mx, shx<1>(mx)); mx = fmaxf(mx, shx<2>(mx)); mx = fmaxf(mx, shx<4>(mx)); mx = fmaxf(mx, shx<8>(mx)); mx = fmaxf(mx, shx<16>(mx)); mx = max32(mx);
            const float inv = mx > 0.f ? 127.0f / mx : 0.f;
            unsigned* o4 = (unsigned*)(hn8 + (size_t)m * DM) + lane;
#pragma unroll
            for (int j = 0; j < 8; ++j) { const int a = (int)rintf(v[j].x * inv), b = (int)rintf(v[j].y * inv), c = (int)rintf(v[j].z * inv), d = (int)rintf(v[j].w * inv);
                o4[64 * j] = ((unsigned)a & 0xffu) | (((unsigned)b & 0xffu) << 8) | (((unsigned)c & 0xffu) << 16) | (((unsigned)d & 0xffu) << 24); }
            if (lane == 0) sa[m] = mx > 0.f ? mx * (1.0f / 127.0f) : 1.0f;
        } else {
            v2u* o8 = (v2u*)(hn + (size_t)m * DM) + lane;
#pragma unroll
            for (int j = 0; j < 8; ++j) o8[64 * j] = pack4(v[j]);
        }
        if (ROUTE) {
            float lg[8];
#pragma unroll
            for (int e = 0; e < 8; ++e) lg[e] = 0.f;
#pragma unroll
            for (int j = 0; j < 8; ++j)
#pragma unroll
                for (int i = 0; i < 4; ++i) { const int k = 256 * j + 4 * lane + i; const f32x4 w0 = *(const LAS f32x4*)(wr + k * 8), w1 = *(const LAS f32x4*)(wr + k * 8 + 4); const float x = v[j][i];
                    lg[0] += x * w0[0]; lg[1] += x * w0[1]; lg[2] += x * w0[2]; lg[3] += x * w0[3]; lg[4] += x * w1[0]; lg[5] += x * w1[1]; lg[6] += x * w1[2]; lg[7] += x * w1[3]; }
#pragma unroll
            for (int e = 0; e < 8; ++e) lg[e] = wave_sum(lg[e]);
            if (lane == 0) {
                int e1 = 0; float v1 = lg[0];
#pragma unroll
                for (int e = 1; e < 8; ++e) if (lg[e] > v1) { v1 = lg[e]; e1 = e; }
                int e2 = -1; float v2 = -3.0e38f;
#pragma unroll
                for (int e = 0; e < 8; ++e) if (e != e1 && lg[e] > v2) { v2 = lg[e]; e2 = e; }
                const float w1 = 1.0f / (1.0f + __expf(v2 - v1));
                tok_e[2 * m] = e1; tok_e[2 * m + 1] = e2; tok_w[2 * m] = w1; tok_w[2 * m + 1] = 1.0f - w1;
                __hip_atomic_fetch_add(&lcnt[e1], 1u, __ATOMIC_RELAXED, __HIP_MEMORY_SCOPE_WORKGROUP); __hip_atomic_fetch_add(&lcnt[e2], 1u, __ATOMIC_RELAXED, __HIP_MEMORY_SCOPE_WORKGROUP);
            }
        }
    }
    if (ROUTE) { __syncthreads(); if (tid < 8) { const unsigned c = lcnt[tid]; if (c) __hip_atomic_fetch_add(cnt + tid, c, RLX_AGENT); } }
}

__device__ __forceinline__ void conv_phase(InP in, int L, unsigned char* ws, int gw, int NGW, int lane) {
    const bf16* u = (const bf16*)(ws + R_U);
    bf16* gqkv = (bf16*)(ws + R_GQKV); float* gbg = (float*)(ws + R_GBG); bf16* xc = (bf16*)(ws + R_XC); float* dtb = (float*)(ws + R_DT);
    bf16* qln = (bf16*)(ws + R_QLN); bf16* kvln = (bf16*)(ws + R_KVLN);
    const int per = (T + NGW - 1) / NGW, ma = gw * per, mb = (ma + per < T) ? ma + per : T;
    if (ma >= T) return;
    const float* cw = in->p[6] + (size_t)L * 1536 * 4;
    for (int hd = 0; hd < GH; ++hd) {
        f32x4 w[3][2];
#pragma unroll
        for (int t3 = 0; t3 < 3; ++t3)
#pragma unroll
            for (int i = 0; i < 2; ++i) w[t3][i] = *(const f32x4*)(cw + (size_t)(t3 * 512 + hd * 128 + 2 * lane + i) * 4);
        unsigned x0[3], x1[3], x2[3];
#pragma unroll
        for (int t3 = 0; t3 < 3; ++t3) {
            const int col = t3 * 512 + hd * 128 + 2 * lane;
            const int s0 = (ma % SEQ);
            x0[t3] = (s0 >= 3) ? *(const unsigned*)(u + (size_t)(ma - 3) * D_INP + col) : 0u;
            x1[t3] = (s0 >= 2) ? *(const unsigned*)(u + (size_t)(ma - 2) * D_INP + col) : 0u;
            x2[t3] = (s0 >= 1) ? *(const unsigned*)(u + (size_t)(ma - 1) * D_INP + col) : 0u;
        }
        for (int m = ma; m < mb; ++m) {
            if ((m % SEQ) == 0) {
#pragma unroll
                for (int t3 = 0; t3 < 3; ++t3) { x0[t3] = 0u; x1[t3] = 0u; x2[t3] = 0u; }
            }
            float y[3][2];
#pragma unroll
            for (int t3 = 0; t3 < 3; ++t3) {
                const unsigned x3 = *(const unsigned*)(u + (size_t)m * D_INP + t3 * 512 + hd * 128 + 2 * lane);
                const float a = w[t3][0][0] * bflo(x0[t3]) + w[t3][0][1] * bflo(x1[t3]) + w[t3][0][2] * bflo(x2[t3]) + w[t3][0][3] * bflo(x3);
                const float b = w[t3][1][0] * bfhi(x0[t3]) + w[t3][1][1] * bfhi(x1[t3]) + w[t3][1][2] * bfhi(x2[t3]) + w[t3][1][3] * bfhi(x3);
                y[t3][0] = siluf_(a); y[t3][1] = siluf_(b);
                x0[t3] = x1[t3]; x1[t3] = x2[t3]; x2[t3] = x3;
            }
            const float sq = wave_sum(y[0][0] * y[0][0] + y[0][1] * y[0][1]), sk = wave_sum(y[1][0] * y[1][0] + y[1][1] * y[1][1]);
            const float rq = rsqrtf(sq + EPS) * 0.08838834764831845f, rk = rsqrtf(sk + EPS);
            bf16* o = gqkv + (size_t)m * 1536 + hd * 128 + 2 * lane;
            *(unsigned*)(o) = cvt_pk_bf16(y[0][0] * rq, y[0][1] * rq);
            *(unsigned*)(o + 512) = cvt_pk_bf16(y[1][0] * rk, y[1][1] * rk);
            *(unsigned*)(o + 1024) = cvt_pk_bf16(y[2][0], y[2][1]);
        }
    }
    {
        const float alog = (lane < 4) ? in->p[7][L * GH + lane] : 0.f, dtbias = (lane < 4) ? in->p[8][L * GH + lane] : 0.f;
        const float sdtb = (lane < 16) ? in->p[13][L * SH + lane] : 0.f;
        for (int m = ma; m < mb; ++m) {
            if (lane < 4) {
                const float bb = bf2f(u[(size_t)m * D_INP + U_GB + lane]), aa = bf2f(u[(size_t)m * D_INP + U_GA + lane]);
                gbg[(size_t)m * 8 + lane] = sigmoidf_(bb);
                gbg[(size_t)m * 8 + 4 + lane] = -__expf(alog) * softplusf_(aa + dtbias);
            }
            if (lane < 16) dtb[(size_t)m * 16 + lane] = softplusf_(bf2f(u[(size_t)m * D_INP + U_SDT + lane]) + sdtb);
        }
    }
    {
        const float* sw = in->p[10] + (size_t)L * SCONV * 4; const float* sb = in->p[11] + (size_t)L * SCONV;
        for (int ch = 0; ch < 3; ++ch) {
            const int c0 = ch * 512 + 8 * lane;
            f32x4 w[8]; float bias[8];
#pragma unroll
            for (int i = 0; i < 8; ++i) { w[i] = *(const f32x4*)(sw + (size_t)(c0 + i) * 4); bias[i] = sb[c0 + i]; }
            v4u x0, x1, x2; const v4u z4 = {0u, 0u, 0u, 0u};
            { const int s0 = (ma % SEQ);
              x0 = (s0 >= 3) ? *(const v4u*)(u + (size_t)(ma - 3) * D_INP + U_SX + c0) : z4;
              x1 = (s0 >= 2) ? *(const v4u*)(u + (size_t)(ma - 2) * D_INP + U_SX + c0) : z4;
              x2 = (s0 >= 1) ? *(const v4u*)(u + (size_t)(ma - 1) * D_INP + U_SX + c0) : z4; }
            for (int m = ma; m < mb; ++m) {
                if ((m % SEQ) == 0) { x0 = z4; x1 = z4; x2 = z4; }
                const v4u x3 = *(const v4u*)(u + (size_t)m * D_INP + U_SX + c0);
                float y[8];
#pragma unroll
                for (int i = 0; i < 4; ++i) {
                    const float a = w[2 * i][0] * bflo(x0[i]) + w[2 * i][1] * bflo(x1[i]) + w[2 * i][2] * bflo(x2[i]) + w[2 * i][3] * bflo(x3[i]) + bias[2 * i];
                    const float b = w[2 * i + 1][0] * bfhi(x0[i]) + w[2 * i + 1][1] * bfhi(x1[i]) + w[2 * i + 1][2] * bfhi(x2[i]) + w[2 * i + 1][3] * bfhi(x3[i]) + bias[2 * i + 1];
                    y[2 * i] = siluf_(a); y[2 * i + 1] = siluf_(b);
                }
                v4u o; o.x = cvt_pk_bf16(y[0], y[1]); o.y = cvt_pk_bf16(y[2], y[3]); o.z = cvt_pk_bf16(y[4], y[5]); o.w = cvt_pk_bf16(y[6], y[7]);
                *(v4u*)(xc + (size_t)m * SCONV + c0) = o;
                x0 = x1; x1 = x2; x2 = x3;
            }
        }
    }
    {
        const float* qg = in->p[16] + (size_t)L * MQR; const float* kg = in->p[18] + (size_t)L * MKVR;
        float gq[8], gk[4];
#pragma unroll
        for (int i = 0; i < 8; ++i) gq[i] = (lane < 48) ? qg[8 * lane + i] : 0.f;
#pragma unroll
        for (int i = 0; i < 4; ++i) gk[i] = kg[4 * lane + i];
        const v4u z4 = {0u, 0u, 0u, 0u};
        for (int m = ma; m < mb; ++m) {
            const v4u qv = (lane < 48) ? *(const v4u*)(u + (size_t)m * D_INP + U_MQ + 8 * lane) : z4;
            const v2u kv = *(const v2u*)(u + (size_t)m * D_INP + U_MKV + 4 * lane);
            float q[8], k[4];
#pragma unroll
            for (int i = 0; i < 4; ++i) { q[2 * i] = bflo(qv[i]); q[2 * i + 1] = bfhi(qv[i]); }
            k[0] = bflo(kv.x); k[1] = bfhi(kv.x); k[2] = bflo(kv.y); k[3] = bfhi(kv.y);
            float sq = 0.f, sk = 0.f;
#pragma unroll
            for (int i = 0; i < 8; ++i) sq += q[i] * q[i];
#pragma unroll
            for (int i = 0; i < 4; ++i) sk += k[i] * k[i];
            const float rq = rsqrtf(wave_sum(sq) * (1.0f / MQR) + EPS), rk = rsqrtf(wave_sum(sk) * (1.0f / MKVR) + EPS);
            if (lane < 48) { v4u o; o.x = cvt_pk_bf16(q[0] * rq * gq[0], q[1] * rq * gq[1]); o.y = cvt_pk_bf16(q[2] * rq * gq[2], q[3] * rq * gq[3]);
                o.z = cvt_pk_bf16(q[4] * rq * gq[4], q[5] * rq * gq[5]); o.w = cvt_pk_bf16(q[6] * rq * gq[6], q[7] * rq * gq[7]);
                *(v4u*)(qln + (size_t)m * MQR + 8 * lane) = o; }
            { v2u o; o.x = cvt_pk_bf16(k[0] * rk * gk[0], k[1] * rk * gk[1]); o.y = cvt_pk_bf16(k[2] * rk * gk[2], k[3] * rk * gk[3]);
              *(v2u*)(kvln + (size_t)m * MKVR + 4 * lane) = o; }
        }
    }
}

__device__ __forceinline__ void mlaprep_phase(InP in, int L, unsigned char* ws, int gw, int NGW, int lane) {
    const bf16* qraw = (const bf16*)(ws + R_QRAW); const bf16* kvraw = (const bf16*)(ws + R_KVRAW); const bf16* u = (const bf16*)(ws + R_U);
    bf16* Q = (bf16*)(ws + R_Q); bf16* K = (bf16*)(ws + R_K); const float* rope = (const float*)(ws + WS_ROPE);
    const float* qg = in->p[20] + (size_t)L * MQK; const float* kg = in->p[21] + (size_t)L * MQK;
    const float qg0 = qg[lane], qg1 = qg[64 + lane], qg2 = qg[128 + lane], kg0 = kg[lane], kg1 = kg[64 + lane], kg2 = kg[128 + lane];
    constexpr float QS = 0.07216878364870323f * 1.4426950408889634f;
    for (int m = gw; m < T; m += NGW) {
        const float cs = rope[(size_t)m * 64 + (lane & 31)], sn = rope[(size_t)m * 64 + 32 + (lane & 31)];
        const float kpe = bf2f(u[(size_t)m * D_INP + U_MPE + lane]);
        for (int hd = 0; hd < MH; ++hd) {
            {   const bf16* qr = qraw + (size_t)m * 768 + hd * MQK;
                float a = bf2f(qr[lane]), b = bf2f(qr[64 + lane]), c = bf2f(qr[128 + lane]);
                const float rs = rsqrtf(wave_sum(a * a + b * b + c * c) * (1.0f / MQK) + EPS);
                a *= rs * qg0; b *= rs * qg1; c *= rs * qg2;
                const float pc = other32(c, lane);
                const float cr = (lane < 32) ? (c * cs - pc * sn) : (c * cs + pc * sn);
                bf16* o = Q + (size_t)m * 768 + hd * MQK;
                o[lane] = f2bf(a * QS); o[64 + lane] = f2bf(b * QS); o[128 + lane] = f2bf(cr * QS); }
            {   const bf16* kr = kvraw + (size_t)m * 1024 + hd * 256;
                float a = bf2f(kr[lane]), b = bf2f(kr[64 + lane]), c = kpe;
                const float rs = rsqrtf(wave_sum(a * a + b * b + c * c) * (1.0f / MQK) + EPS);
                a *= rs * kg0; b *= rs * kg1; c *= rs * kg2;
                const float pc = other32(c, lane);
                const float cr = (lane < 32) ? (c * cs - pc * sn) : (c * cs + pc * sn);
                bf16* o = K + (size_t)m * 768 + hd * MQK;
                o[lane] = f2bf(a); o[64 + lane] = f2bf(b); o[128 + lane] = f2bf(cr); }
        }
    }
}

__device__ __forceinline__ void moe_tile_prefix(const unsigned* cnt, int (&toff)[9]) {
    int acc = 0; toff[0] = 0;
#pragma unroll
    for (int e = 0; e < 8; ++e) { const int c = __builtin_amdgcn_readfirstlane((int)__hip_atomic_load(cnt + e, RLX_AGENT)); acc += (c + 255) >> 8; toff[e + 1] = acc; }
}
__device__ __forceinline__ void moe_permute_phase(unsigned char* ws, unsigned* ctl, LAS unsigned char* lds, int bid, int G, int tid, int lane, int wave) {
    const int* tok_e = (const int*)(ws + WS_ROUTE); int* slot = (int*)(ws + WS_ROUTE + (size_t)T * 16);
    const signed char* hn8 = (const signed char*)(ws + WS_HN8); signed char* xp8 = (signed char*)(ws + R_XP); const float* sa = (const float*)(ws + WS_SA); float* xsc = (float*)(ws + WS_XSC);
    LAS int* sl = (LAS int*)lds;
    int toff[9]; moe_tile_prefix(ctl + CW_CNT, toff);
    for (int blk = bid; blk < T / 64; blk += G) {
        if (wave == 0) {
            const int t = 64 * blk + lane; const int e1 = tok_e[2 * t], e2 = tok_e[2 * t + 1]; int s1 = 0, s2 = 0;
#pragma unroll
            for (int e = 0; e < 8; ++e) {
                const bool is1 = (e1 == e), is2 = (e2 == e);
                const unsigned long long mask = __ballot(is1 || is2);
                const int n = __popcll(mask);
                unsigned base = 0u;
                if (lane == 0 && n) base = __hip_atomic_fetch_add(ctl + CW_CUR + e, (unsigned)n, RLX_AGENT);
                base = (unsigned)__builtin_amdgcn_readfirstlane((int)base);
                const int rank = __popcll(mask & ((1ull << lane) - 1ull));
                const int s = toff[e] * 256 + (int)base + rank;
                if (is1) s1 = s; if (is2) s2 = s;
            }
            slot[2 * t] = s1; slot[2 * t + 1] = s2; sl[2 * lane] = s1; sl[2 * lane + 1] = s2;
        }
        __syncthreads();
#pragma unroll 4
        for (int i = 0; i < 16; ++i) { const int r = wave * 16 + i; const int t = 64 * blk + (r >> 1); const int s = sl[r];
            const v4u* src = (const v4u*)(hn8 + (size_t)t * DM) + lane; v4u* dst = (v4u*)(xp8 + (size_t)s * DM) + lane;
#pragma unroll
            for (int j = 0; j < 2; ++j) dst[64 * j] = src[64 * j];
            if (lane == 0) xsc[s] = sa[t]; }
        __syncthreads();
    }
}
__device__ __forceinline__ void moe_combine_phase(unsigned char* ws, float* h, int gw, int NGW, int lane) {
    const float* tok_w = (const float*)(ws + WS_ROUTE + (size_t)T * 8); const int* slot = (const int*)(ws + WS_ROUTE + (size_t)T * 16);
    const bf16* yp = (const bf16*)(ws + R_XP); signed char* h8 = (signed char*)(ws + WS_HN8); float* sa8 = (float*)(ws + WS_SA);
    for (int m = gw; m < T; m += NGW) {
        const int s0 = __hip_atomic_load(slot + 2 * m, RLX_AGENT), s1 = __hip_atomic_load(slot + 2 * m + 1, RLX_AGENT);
        const float w0 = __hip_atomic_load(tok_w + 2 * m, RLX_AGENT), w1 = __hip_atomic_load(tok_w + 2 * m + 1, RLX_AGENT);
        f32x4* hr = (f32x4*)(h + (size_t)m * DM) + lane; const v2u* y0 = (const v2u*)(yp + (size_t)s0 * DM) + lane; const v2u* y1 = (const v2u*)(yp + (size_t)s1 * DM) + lane;
        f32x4 v[8]; float mx = 0.f;
#pragma unroll
        for (int j = 0; j < 8; ++j) { v[j] = hr[64 * j]; const v2u a = y0[64 * j], b = y1[64 * j];
            v[j][0] += w0 * bflo(a.x) + w1 * bflo(b.x); v[j][1] += w0 * bfhi(a.x) + w1 * bfhi(b.x); v[j][2] += w0 * bflo(a.y) + w1 * bflo(b.y); v[j][3] += w0 * bfhi(a.y) + w1 * bfhi(b.y);
            hr[64 * j] = v[j]; mx = fmaxf(fmaxf(mx, fmaxf(fabsf(v[j][0]), fabsf(v[j][1]))), fmaxf(fabsf(v[j][2]), fabsf(v[j][3]))); }
        mx = fmaxf(mx, shx<1>(mx)); mx = fmaxf(mx, shx<2>(mx)); mx = fmaxf(mx, shx<4>(mx)); mx = fmaxf(mx, shx<8>(mx)); mx = fmaxf(mx, shx<16>(mx)); mx = max32(mx);
        const float inv = mx > 0.f ? 127.0f / mx : 0.f;
        unsigned* o4 = (unsigned*)(h8 + (size_t)m * DM) + lane;
#pragma unroll
        for (int j = 0; j < 8; ++j) { const int a = (int)rintf(v[j][0] * inv), b = (int)rintf(v[j][1] * inv), c = (int)rintf(v[j][2] * inv), d = (int)rintf(v[j][3] * inv);
            o4[64 * j] = ((unsigned)a & 0xffu) | (((unsigned)b & 0xffu) << 8) | (((unsigned)c & 0xffu) << 16) | (((unsigned)d & 0xffu) << 24); }
        if (lane == 0) sa8[m] = mx > 0.f ? mx * (1.0f / 127.0f) : 1.0f;
    }
}
__device__ __forceinline__ void ssd_scan_phase(unsigned char* ws, int gtid, int NGT) {
    const float* st = (const float*)(ws + R_SST); bf16* pv = (bf16*)(ws + R_SPV); const float* dA = (const float*)(ws + R_SDA);
    for (int i = gtid; i < BATCH * SH * SP * SN; i += NGT) {
        const int pn = i % (SP * SN), bh = i / (SP * SN), hd = bh % SH, b = bh / SH;
        float hs = 0.f;
#pragma unroll 4
        for (int c = 0; c < SNC; ++c) { const size_t idx = ((size_t)((b * SNC + c) * SH + hd)) * (SP * SN) + pn;
            pv[idx] = f2bf(hs); hs = hs * dA[(b * SNC + c) * SH + hd] + st[idx]; }
    }
}

template <int F> __device__ __forceinline__ void act_quant_phase(unsigned char* act, float* sa, int nrows, int gw, int NGW, int lane) {
    constexpr int NV = F / 8 / 64;
    static_assert(F % 512 == 0, "row chunks");
    for (int r = gw; r < nrows; r += NGW) {
        v4u* row = (v4u*)(act + (size_t)r * F * 2);
        v4u x[NV]; float mx = 0.f;
#pragma unroll
        for (int j = 0; j < NV; ++j) { x[j] = row[lane + 64 * j];
#pragma unroll
            for (int i = 0; i < 4; ++i) mx = fmaxf(mx, fmaxf(fabsf(bflo(x[j][i])), fabsf(bfhi(x[j][i])))); }
        mx = fmaxf(mx, shx<1>(mx)); mx = fmaxf(mx, shx<2>(mx)); mx = fmaxf(mx, shx<4>(mx)); mx = fmaxf(mx, shx<8>(mx)); mx = fmaxf(mx, shx<16>(mx)); mx = max32(mx);
        const float inv = (mx > 0.f && mx < 3.0e38f) ? 127.0f / mx : 0.f;
        asm volatile("s_waitcnt vmcnt(0)" ::: "memory");
        v2u* orow = (v2u*)(act + (size_t)r * F * 2);
#pragma unroll
        for (int j = 0; j < NV; ++j) { unsigned w0 = 0u, w1 = 0u;
#pragma unroll
            for (int i = 0; i < 2; ++i) { const int a = (int)rintf(bflo(x[j][i]) * inv), b = (int)rintf(bfhi(x[j][i]) * inv); w0 |= (((unsigned)a & 0xffu) | (((unsigned)b & 0xffu) << 8)) << (16 * i); }
#pragma unroll
            for (int i = 0; i < 2; ++i) { const int a = (int)rintf(bflo(x[j][2 + i]) * inv), b = (int)rintf(bfhi(x[j][2 + i]) * inv); w1 |= (((unsigned)a & 0xffu) | (((unsigned)b & 0xffu) << 8)) << (16 * i); }
            orow[lane + 64 * j] = (v2u){w0, w1}; }
        if (lane == 0) sa[r] = (mx > 0.f && mx < 3.0e38f) ? mx * (1.0f / 127.0f) : 1.0f;
    }
}

__device__ __forceinline__ void h_quant_phase(const float* __restrict__ h, signed char* __restrict__ h8, float* __restrict__ sa8, int gw, int NGW, int lane) {
    for (int m = gw; m < T; m += NGW) {
        const f32x4* hr = (const f32x4*)(h + (size_t)m * DM) + lane; f32x4 v[8]; float mx = 0.f;
#pragma unroll
        for (int j = 0; j < 8; ++j) { v[j] = hr[64 * j]; mx = fmaxf(fmaxf(mx, fmaxf(fabsf(v[j][0]), fabsf(v[j][1]))), fmaxf(fabsf(v[j][2]), fabsf(v[j][3]))); }
        mx = fmaxf(mx, shx<1>(mx)); mx = fmaxf(mx, shx<2>(mx)); mx = fmaxf(mx, shx<4>(mx)); mx = fmaxf(mx, shx<8>(mx)); mx = fmaxf(mx, shx<16>(mx)); mx = max32(mx);
        const float inv = mx > 0.f ? 127.0f / mx : 0.f;
        unsigned* o4 = (unsigned*)(h8 + (size_t)m * DM) + lane;
#pragma unroll
        for (int j = 0; j < 8; ++j) { const int a = (int)rintf(v[j][0] * inv), b = (int)rintf(v[j][1] * inv), c = (int)rintf(v[j][2] * inv), d = (int)rintf(v[j][3] * inv);
            o4[64 * j] = ((unsigned)a & 0xffu) | (((unsigned)b & 0xffu) << 8) | (((unsigned)c & 0xffu) << 16) | (((unsigned)d & 0xffu) << 24); }
        if (lane == 0) sa8[m] = mx > 0.f ? mx * (1.0f / 127.0f) : 1.0f;
    }
}

struct GdnPre { v4u pf[6]; float g, be; };
__device__ __forceinline__ void gdn_prep_fetch(int unit, GdnPre& P, unsigned char* ws, int tid, int lane, int wave) {
    const int n = unit % GNC, bh = unit / GNC, hd = bh % GH, b = bh / GH; const int m0 = b * SEQ + n * GCH;
    const bf16* gqkv = (const bf16*)(ws + R_GQKV); const float* gbg = (const float*)(ws + R_GBG);
#pragma unroll
    for (int i = 0; i < 6; ++i) { const int idx = tid + NTHR * i, tn = idx >> 10, r = (idx & 1023) >> 4, ch = idx & 15;
        P.pf[i] = *(const GAS v4u*)(gqkv + (size_t)(m0 + r) * 1536 + tn * 512 + hd * 128 + ch * 8); }
    if (wave == 0) { P.g = gbg[(size_t)(m0 + lane) * 8 + 4 + hd]; P.be = gbg[(size_t)(m0 + lane) * 8 + hd]; }
}
__device__ __forceinline__ void gdn_prep_unit(int unit, int next_unit, GdnPre& P, unsigned char* ws, LAS unsigned char* lds, int tid, int lane, int wave) {
    const int n = unit % GNC, bh = unit / GNC, hd = bh % GH, b = bh / GH; const int m0 = b * SEQ + n * GCH; (void)m0; (void)hd;
    bf16* UT = (bf16*)(ws + R_GUT) + (size_t)unit * 8192; bf16* Wc = (bf16*)(ws + R_GW) + (size_t)unit * 8192; bf16* Qd = (bf16*)(ws + R_GQD) + (size_t)unit * 8192;
    bf16* KdT = (bf16*)(ws + R_GKDT) + (size_t)unit * 8192; bf16* Intra = (bf16*)(ws + R_GIN) + (size_t)unit * 4096; float* Gend = (float*)(ws + R_GEND);
    constexpr int LDB = 272;
    LAS unsigned char* Ks = lds; LAS unsigned char* Qs = lds + 17408; LAS unsigned char* Vs = lds + 34816;
    LAS float* MT = (LAS float*)(lds + 52224);
    LAS float* gcs = (LAS float*)(lds + 69632); LAS float* rsc = (LAS float*)(lds + 69888);
    LAS float* Xl = (LAS float*)(lds + 70400);
#pragma unroll
    for (int i = 0; i < 6; ++i) { const int idx = tid + NTHR * i, tn = idx >> 10, r = (idx & 1023) >> 4, ch = idx & 15;
        LAS unsigned char* dst = (tn == 0 ? Qs : (tn == 1 ? Ks : Vs)) + r * LDB + ch * 16;
        *(LAS v4u*)dst = P.pf[i]; }
    if (wave == 0) { float g = P.g; const float be = P.be;
        g = wave_scan(g, lane);
        gcs[lane] = g; rsc[lane] = be; rsc[64 + lane] = be * __expf(g); }
    __syncthreads();
    if (next_unit >= 0) gdn_prep_fetch(next_unit, P, ws, tid, lane, wave);
    {
        const int ct = wave >> 1, st0 = 2 * (wave & 1), g4 = lane >> 4, r16 = lane & 15;
        f32x4 ak[2] = {{0.f, 0.f, 0.f, 0.f}, {0.f, 0.f, 0.f, 0.f}}, aq[2] = {{0.f, 0.f, 0.f, 0.f}, {0.f, 0.f, 0.f, 0.f}};
#pragma unroll
        for (int ks = 0; ks < 4; ++ks) { const bf16x8 fk = lds_frag(Ks, LDB, 16 * ct, 32 * ks, lane), fq = lds_frag(Qs, LDB, 16 * ct, 32 * ks, lane);
#pragma unroll
            for (int j = 0; j < 2; ++j) { const bf16x8 fb = lds_frag(Ks, LDB, 16 * (st0 + j), 32 * ks, lane); ak[j] = MFMA16(fk, fb, ak[j]); aq[j] = MFMA16(fq, fb, aq[j]); } }
#pragma unroll
        for (int j = 0; j < 2; ++j) { const int s = 16 * (st0 + j) + r16; const float gs = gcs[s]; f32x4 mv;
#pragma unroll
            for (int i = 0; i < 4; ++i) { const int c = 16 * ct + 4 * g4 + i; const float dec = __expf(fminf(gcs[c] - gs, 0.f));
                mv[i] = (s < c) ? rsc[c] * ak[j][i] * dec : 0.f;
                Intra[c * 64 + s] = f2bf((s <= c) ? aq[j][i] * dec : 0.f); }
            *(LAS f32x4*)(MT + s * 68 + 16 * ct + 4 * g4) = mv; }
    }
    __syncthreads();
    {
#pragma unroll
        for (int i = 0; i < 2; ++i) { const int id = tid + NTHR * i, c = id >> 4, ch = id & 15; const float eg = __expf(gcs[c]);
            const v4u v = *(const LAS v4u*)(Qs + c * LDB + ch * 16);
            v4u o; o.x = cvt_pk_bf16(bflo(v.x) * eg, bfhi(v.x) * eg); o.y = cvt_pk_bf16(bflo(v.y) * eg, bfhi(v.y) * eg); o.z = cvt_pk_bf16(bflo(v.z) * eg, bfhi(v.z) * eg); o.w = cvt_pk_bf16(bflo(v.w) * eg, bfhi(v.w) * eg);
            *(v4u*)(Qd + c * 128 + ch * 8) = o; }
        const float gl = gcs[63];
#pragma unroll
        for (int i = 0; i < 2; ++i) { const int id = tid + NTHR * i, d = id >> 3, cb = id & 7; float y[8];
#pragma unroll
            for (int j = 0; j < 8; ++j) { const int c = 8 * cb + j; y[j] = bf2f(((const LAS unsigned short*)Ks)[c * 136 + d]) * __expf(gl - gcs[c]); }
            v4u o; o.x = cvt_pk_bf16(y[0], y[1]); o.y = cvt_pk_bf16(y[2], y[3]); o.z = cvt_pk_bf16(y[4], y[5]); o.w = cvt_pk_bf16(y[6], y[7]);
            *(v4u*)(KdT + d * 64 + 8 * cb) = o; }
        if (tid == 0) Gend[unit] = __expf(gl);
    }
    if (tid < 256) {
        const int col = tid, sec = __builtin_amdgcn_readfirstlane(tid >> 7);
        const LAS unsigned short* sp = (const LAS unsigned short*)(sec ? Ks : Vs) + (col & 127);
        const LAS float* rs = rsc + sec * 64;
        LAS float* Xc = Xl + col;
#pragma unroll
        for (int blk = 0; blk < 4; ++blk) {
            float acc[16];
#pragma unroll
            for (int i = 0; i < 16; ++i) acc[i] = bf2f(sp[(16 * blk + i) * 136]) * rs[16 * blk + i];
            for (int s = 0; s < 16 * blk; ++s) {
                const float xs = Xc[s * 256];
                const LAS f32x4* mt = (const LAS f32x4*)(MT + s * 68 + 16 * blk);
#pragma unroll
                for (int q = 0; q < 4; ++q) { const f32x4 m4 = mt[q]; acc[4 * q] -= m4[0] * xs; acc[4 * q + 1] -= m4[1] * xs; acc[4 * q + 2] -= m4[2] * xs; acc[4 * q + 3] -= m4[3] * xs; }
            }
#pragma unroll
            for (int j = 0; j < 16; ++j) { const float xj = acc[j]; const LAS float* mt = MT + (16 * blk + j) * 68 + 16 * blk;
#pragma unroll
                for (int i = j + 1; i < 16; ++i) acc[i] -= mt[i] * xj; }
            if (blk < 3) {
#pragma unroll
                for (int i = 0; i < 16; ++i) Xc[(16 * blk + i) * 256] = acc[i]; }
            if (!sec) { v4u o0, o1;
                o0.x = cvt_pk_bf16(acc[0], acc[1]); o0.y = cvt_pk_bf16(acc[2], acc[3]); o0.z = cvt_pk_bf16(acc[4], acc[5]); o0.w = cvt_pk_bf16(acc[6], acc[7]);
                o1.x = cvt_pk_bf16(acc[8], acc[9]); o1.y = cvt_pk_bf16(acc[10], acc[11]); o1.z = cvt_pk_bf16(acc[12], acc[13]); o1.w = cvt_pk_bf16(acc[14], acc[15]);
                *(v4u*)(UT + col * 64 + 16 * blk) = o0; *(v4u*)(UT + col * 64 + 16 * blk + 8) = o1;
            } else {
#pragma unroll
                for (int i = 0; i < 16; ++i) Wc[(16 * blk + i) * 128 + (col - 128)] = f2bf(acc[i]); }
        }
    }
    __syncthreads();
}

__device__ __forceinline__ bf16x8 gfrag(const bf16* base, int ld, int row0, int k0, int lane) {
    return *(const GAS bf16x8*)(base + (size_t)(row0 + (lane & 15)) * ld + k0 + 8 * (lane >> 4));
}
__device__ __forceinline__ void gdn_scan_unit(int bh, const float* __restrict__ norm_g, unsigned char* ws, LAS unsigned char* lds, int tid, int lane, int wave) {
    const int hd = bh % GH, b = bh / GH;
    const bf16* UTb = (const bf16*)(ws + R_GUT); const bf16* Wb = (const bf16*)(ws + R_GW); const bf16* Qdb = (const bf16*)(ws + R_GQD);
    const bf16* KdTb = (const bf16*)(ws + R_GKDT); const bf16* Inb = (const bf16*)(ws + R_GIN); const float* Gend = (const float*)(ws + R_GEND);
    const bf16* u = (const bf16*)(ws + R_U); bf16* mix = (bf16*)(ws + WS_MIX);
    constexpr int STB = 272, VTB = 144;
    LAS unsigned char* ST0 = lds; LAS unsigned char* VT = lds + 69632; LAS float* ssq = (LAS float*)(lds + 88064); LAS float* NG = (LAS float*)(lds + 88576);
    LAS unsigned char* OT = lds + 89088; constexpr int OTB = 528;
    const int ct = wave & 3, eh = wave >> 2, g4 = lane >> 4, r16 = lane & 15;
    f32x4 S[8];
#pragma unroll
    for (int i = 0; i < 8; ++i) S[i] = (f32x4){0.f, 0.f, 0.f, 0.f};
    for (int i = tid; i < 2 * 34816 / 16; i += NTHR) ((LAS v4u*)ST0)[i] = (v4u){0u, 0u, 0u, 0u};
    if (tid < GD) NG[tid] = norm_g[tid];
    bf16x8 aW[4], aQ[4], aI[2], aK[2]; v2u ut[4]; v4u zz[2];
    const float gall = *(const GAS float*)(Gend + (size_t)bh * GNC + lane);
    const size_t u0 = (size_t)bh * GNC;
#define GS_EARLY(W_, Q_, U_, un) do { _Pragma("unroll") for (int ks = 0; ks < 4; ++ks) { W_[ks] = gfrag(Wb + (un) * 8192, 128, 16 * ct, 32 * ks, lane); Q_[ks] = gfrag(Qdb + (un) * 8192, 128, 16 * ct, 32 * ks, lane); } \
        _Pragma("unroll") for (int j = 0; j < 4; ++j) U_[j] = *(const GAS v2u*)(UTb + (un) * 8192 + (16 * (4 * eh + j) + r16) * 64 + 16 * ct + 4 * g4); } while (0)
#define GS_LATE(un) do { _Pragma("unroll") for (int ks = 0; ks < 2; ++ks) { aI[ks] = gfrag(Inb + (un) * 4096, 64, 16 * ct, 32 * ks, lane); aK[ks] = gfrag(KdTb + (un) * 8192, 64, 16 * wave, 32 * ks, lane); } \
        } while (0)
#define GS_Z(n_) do { _Pragma("unroll") for (int p = 0; p < 2; ++p) zz[p] = *(const GAS v4u*)(u + (size_t)(b * SEQ + (n_) * GCH + 8 * wave + 4 * p + g4) * D_INP + U_GZ + hd * 128 + 8 * r16); } while (0)
    GS_EARLY(aW, aQ, ut, u0); GS_LATE(u0);
    __syncthreads();
    for (int n = 0; n < GNC; ++n) {
        const int cur = n & 1;
        LAS unsigned char* STc = ST0 + cur * 34816; LAS unsigned char* STn = ST0 + (cur ^ 1) * 34816;
        GS_Z(n);
        f32x4 o[4];
        {
            bf16x8 stf[4][4];
#pragma unroll
            for (int j = 0; j < 4; ++j)
#pragma unroll
                for (int ks = 0; ks < 4; ++ks) stf[j][ks] = lds_frag(STc, STB, 16 * (4 * eh + j), 32 * ks, lane);
            __builtin_amdgcn_sched_barrier(0);
#pragma unroll
            for (int j = 0; j < 4; ++j) { f32x4 av = {0.f, 0.f, 0.f, 0.f}, ao = {0.f, 0.f, 0.f, 0.f};
#pragma unroll
                for (int ks = 0; ks < 4; ++ks) { av = MFMA16(aW[ks], stf[j][ks], av); ao = MFMA16(stf[j][ks], aQ[ks], ao); }
                o[j] = ao;
                f32x4 vn; vn[0] = bflo(ut[j].x) - av[0]; vn[1] = bfhi(ut[j].x) - av[1]; vn[2] = bflo(ut[j].y) - av[2]; vn[3] = bfhi(ut[j].y) - av[3];
                *(LAS v2u*)(VT + (16 * (4 * eh + j) + r16) * VTB + (16 * ct + 4 * g4) * 2) = pack4(vn); }
        }
        __builtin_amdgcn_sched_barrier(0);
        if (n + 1 < GNC) GS_EARLY(aW, aQ, ut, u0 + n + 1);
        __syncthreads();
        float ss = 0.f;
        {
            bf16x8 vtf[8][2];
#pragma unroll
            for (int et = 0; et < 8; ++et)
#pragma unroll
                for (int ks = 0; ks < 2; ++ks) vtf[et][ks] = lds_frag(VT, VTB, 16 * et, 32 * ks, lane);
            __builtin_amdgcn_sched_barrier(0);
            if (eh == 0) {
#pragma unroll
                for (int j = 0; j < 4; ++j) { o[j] = MFMA16(vtf[j][0], aI[0], o[j]); o[j] = MFMA16(vtf[j][1], aI[1], o[j]); }
            } else {
#pragma unroll
                for (int j = 0; j < 4; ++j) { o[j] = MFMA16(vtf[4 + j][0], aI[0], o[j]); o[j] = MFMA16(vtf[4 + j][1], aI[1], o[j]); }
            }
            const float ge = __builtin_bit_cast(float, __builtin_amdgcn_readlane(__builtin_bit_cast(int, gall), n));
#pragma unroll
            for (int et = 0; et < 8; ++et) { f32x4 acc = S[et] * ge;
                acc = MFMA16(aK[0], vtf[et][0], acc); acc = MFMA16(aK[1], vtf[et][1], acc);
                S[et] = acc;
                *(LAS v2u*)(STn + (16 * et + r16) * STB + (16 * wave + 4 * g4) * 2) = pack4_mfma(acc); }
        }
        __builtin_amdgcn_sched_barrier(0);
        if (n + 1 < GNC) GS_LATE(u0 + n + 1);
#pragma unroll
        for (int j = 0; j < 4; ++j) { ss += (o[j][0] * o[j][0] + o[j][1] * o[j][1]) + (o[j][2] * o[j][2] + o[j][3] * o[j][3]);
            *(LAS f32x4*)(OT + (16 * ct + r16) * OTB + (16 * (4 * eh + j) + 4 * g4) * 4) = o[j]; }
        ss += shx<16>(ss); ss = sum32(ss);
        if (g4 == 0) ssq[eh * 64 + 16 * ct + r16] = ss;
        __syncthreads();
#pragma unroll
        for (int p = 0; p < 2; ++p) { const int row = 8 * wave + 4 * p + g4, e0 = 8 * r16;
            const float tot = ssq[row] + ssq[64 + row]; const float rs = rsqrtf(tot * (1.0f / GD) + EPS);
            const f32x4 oa = *(const LAS f32x4*)(OT + row * OTB + e0 * 4), ob = *(const LAS f32x4*)(OT + row * OTB + e0 * 4 + 16);
            const f32x4 na = *(const LAS f32x4*)(NG + e0), nb = *(const LAS f32x4*)(NG + e0 + 4); const v4u zv = zz[p];
            u32x4 w;
            w.x = cvt_pk_bf16(oa[0] * rs * na[0] * siluf_(bflo(zv.x)), oa[1] * rs * na[1] * siluf_(bfhi(zv.x))); w.y = cvt_pk_bf16(oa[2] * rs * na[2] * siluf_(bflo(zv.y)), oa[3] * rs * na[3] * siluf_(bfhi(zv.y)));
            w.z = cvt_pk_bf16(ob[0] * rs * nb[0] * siluf_(bflo(zv.z)), ob[1] * rs * nb[1] * siluf_(bfhi(zv.z))); w.w = cvt_pk_bf16(ob[2] * rs * nb[2] * siluf_(bflo(zv.w)), ob[3] * rs * nb[3] * siluf_(bfhi(zv.w)));
            *(GAS u32x4*)(mix + (size_t)(b * SEQ + n * GCH + row) * DM + hd * 128 + e0) = w; }
    }
#undef GS_EARLY
#undef GS_LATE
#undef GS_Z
    __syncthreads();
}

__device__ __forceinline__ void attn_unit(int b, int hd, int qb, unsigned char* ws, LAS unsigned char* lds, int tid, int lane, int wave) {
    const bf16* Q = (const bf16*)(ws + R_Q); const bf16* K = (const bf16*)(ws + R_K); const bf16* KV = (const bf16*)(ws + R_KVRAW); bf16* mix = (bf16*)(ws + WS_MIX);
    constexpr int VLB = 288, KBUF = 64 * 384, VBUF = 64 * VLB;
    LAS unsigned char* Ks0 = lds; LAS unsigned char* Vs0 = lds + 2 * KBUF;
    const int g4 = lane >> 4, r16 = lane & 15;
    const size_t mb = (size_t)b * SEQ;
    bf16x8 qf[6];
#pragma unroll
    for (int ks = 0; ks < 6; ++ks) qf[ks] = glb_frag(Q + mb * 768 + hd * MQK, 768, 128 * qb + 16 * wave, 32 * ks, lane);
    const int nkt = 2 * (qb + 1);
    v4u kst[3], vst[2];
#define ATT_KMAP const int id = tid + NTHR * i, rest = id >> 3, r = 2 * (rest / 6) + ((id >> 2) & 1), ch = (rest % 6) * 4 + (id & 3)
#define ATT_LOAD(kt) do { _Pragma("unroll") for (int i = 0; i < 3; ++i) { ATT_KMAP; \
            kst[i] = *(const v4u*)(K + (mb + 64 * (kt) + r) * 768 + hd * MQK + 8 * ch); } \
        _Pragma("unroll") for (int i = 0; i < 2; ++i) { const int id = tid + NTHR * i, r = id >> 4, ch = id & 15; \
            vst[i] = *(const v4u*)(KV + (mb + 64 * (kt) + r) * 1024 + hd * 256 + 128 + 8 * ch); } } while (0)
#define ATT_STORE(buf) do { _Pragma("unroll") for (int i = 0; i < 3; ++i) { ATT_KMAP; \
            *(LAS v4u*)(Ks0 + (buf) * KBUF + ((r >> 4) * 6 + (ch >> 2)) * 1024 + ((((r & 15) * 64) + (ch & 3) * 16) ^ (((r >> 3) & 1) << 5))) = kst[i]; } \
        _Pragma("unroll") for (int i = 0; i < 2; ++i) { const int id = tid + NTHR * i, r = id >> 4, ch = id & 15; \
            *(LAS v4u*)(Vs0 + (buf) * VBUF + r * VLB + ch * 16) = vst[i]; } } while (0)
    ATT_LOAD(0); ATT_STORE(0); ATT_LOAD(1);
    __syncthreads();
    const int klane = ((r16 * 64) + g4 * 16) ^ ((r16 >> 3) << 5);
    f32x4 O[8];
#pragma unroll
    for (int i = 0; i < 8; ++i) O[i] = (f32x4){0.f, 0.f, 0.f, 0.f};
    float mrun = -1.0e30f, lrun = 0.f;
    const int qpos = 128 * qb + 16 * wave + r16;
    for (int kt = 0; kt < nkt; ++kt) {
        const int cur = kt & 1;
        if (kt + 1 < nkt) ATT_STORE(cur ^ 1);
        if (kt + 2 < nkt) ATT_LOAD(kt + 2);
        const LAS unsigned char* Kc = Ks0 + cur * KBUF + klane; const LAS unsigned char* Vc = Vs0 + cur * VBUF;
        f32x4 s[4];
#pragma unroll
        for (int nt = 0; nt < 4; ++nt) { f32x4 acc = {0.f, 0.f, 0.f, 0.f};
#pragma unroll
            for (int ks = 0; ks < 6; ++ks) acc = MFMA16(*(const LAS bf16x8*)(Kc + (nt * 6 + ks) * 1024), qf[ks], acc);
            s[nt] = acc; }
        if (kt >= 2 * qb) {
#pragma unroll
            for (int nt = 0; nt < 4; ++nt)
#pragma unroll
                for (int i = 0; i < 4; ++i) { const int key = 64 * kt + 16 * nt + 4 * g4 + i; if (key > qpos) s[nt][i] = -__builtin_inff(); }
        }
        float mx = s[0][0];
#pragma unroll
        for (int nt = 0; nt < 4; ++nt)
#pragma unroll
            for (int i = 0; i < 4; ++i) mx = fmaxf(mx, s[nt][i]);
        mx = fmaxf(mx, shx<16>(mx)); mx = max32(mx);
        const float mnew = fmaxf(mrun, mx), alpha = __builtin_amdgcn_exp2f(mrun - mnew); mrun = mnew;
        float ps = 0.f;
#pragma unroll
        for (int nt = 0; nt < 4; ++nt)
#pragma unroll
            for (int i = 0; i < 4; ++i) { const float p = __builtin_amdgcn_exp2f(s[nt][i] - mnew); s[nt][i] = p; ps += p; }
        lrun = lrun * alpha + ps;
        const bf16x8 pf0 = pack_frag(s[0], s[1]), pf1 = pack_frag(s[2], s[3]);
        if (!__all(alpha == 1.0f)) {
#pragma unroll
            for (int dt = 0; dt < 8; ++dt) O[dt] = O[dt] * alpha; }
#pragma unroll
        for (int dt = 0; dt < 8; ++dt) { f32x4 acc = O[dt];
            acc = MFMA16(lds_frag_trp(Vc, VLB, 0, 16 * dt, lane), pf0, acc);
            acc = MFMA16(lds_frag_trp(Vc, VLB, 32, 16 * dt, lane), pf1, acc);
            O[dt] = acc; }
        __syncthreads();
    }
#undef ATT_KMAP
#undef ATT_LOAD
#undef ATT_STORE
    lrun += shx<16>(lrun); lrun = sum32(lrun);
    const float inv = 1.0f / lrun;
    bf16* orow = mix + (mb + qpos) * DM + 1536 + hd * MV;
#pragma unroll
    for (int dt = 0; dt < 8; ++dt) *(v2u*)(orow + 16 * dt + 4 * g4) = pack4(O[dt] * inv);
}

__device__ __forceinline__ void ssd_state_unit(int unit, const float* __restrict__ a_log, unsigned char* ws, LAS unsigned char* lds, int tid, int lane, int wave) {
    const int hd = unit % SH, bc = unit / SH; const int m0 = bc * SCH;
    const bf16* xc = (const bf16*)(ws + R_XC); const float* dtb = (const float*)(ws + R_DT);
    float* st = (float*)(ws + R_SST) + (size_t)unit * (SP * SN); float* dA = (float*)(ws + R_SDA);
    constexpr int XLB = 144, BLB = 272;
    LAS unsigned char* Xs = lds; LAS unsigned char* Bs = lds + 36864; LAS float* acs = (LAS float*)(lds + 106496);
    const int grp = hd >> 3;
#pragma unroll
    for (int i = 0; i < 8; ++i) { const int id = tid + NTHR * i, r = id >> 4, ch = id & 15;
        *(LAS v4u*)(Bs + r * BLB + ch * 16) = *(const v4u*)(xc + (size_t)(m0 + r) * SCONV + 1024 + grp * 128 + 8 * ch); }
    if (wave == 0) { const float A = -__expf(a_log[hd]); float d[4]; float run = 0.f;
#pragma unroll
        for (int i = 0; i < 4; ++i) { run += dtb[(size_t)(m0 + 4 * lane + i) * 16 + hd] * A; d[i] = run; }
        const float ex = wave_scan(run, lane) - run;
#pragma unroll
        for (int i = 0; i < 4; ++i) acs[4 * lane + i] = d[i] + ex; }
    __syncthreads();
    const float alast = acs[255];
#pragma unroll
    for (int i = 0; i < 4; ++i) { const int id = tid + NTHR * i, r = id >> 3, ch = id & 7;
        const v4u v = *(const v4u*)(xc + (size_t)(m0 + r) * SCONV + hd * 64 + 8 * ch);
        const float sc = dtb[(size_t)(m0 + r) * 16 + hd] * __expf(alast - acs[r]);
        v4u o; o.x = cvt_pk_bf16(bflo(v.x) * sc, bfhi(v.x) * sc); o.y = cvt_pk_bf16(bflo(v.y) * sc, bfhi(v.y) * sc); o.z = cvt_pk_bf16(bflo(v.z) * sc, bfhi(v.z) * sc); o.w = cvt_pk_bf16(bflo(v.w) * sc, bfhi(v.w) * sc);
        *(LAS v4u*)(Xs + r * XLB + ch * 16) = o; }
    if (tid == 0) dA[unit] = __expf(alast);
    __syncthreads();
    { const int pt = wave & 3, nh = wave >> 2, g4 = lane >> 4, r16 = lane & 15;
      f32x4 acc[4] = {{0.f, 0.f, 0.f, 0.f}, {0.f, 0.f, 0.f, 0.f}, {0.f, 0.f, 0.f, 0.f}, {0.f, 0.f, 0.f, 0.f}};
#pragma unroll
      for (int ks = 0; ks < 8; ++ks) { const bf16x8 a = lds_frag_tr(Xs, XLB, 32 * ks, 16 * pt, lane);
#pragma unroll
          for (int j = 0; j < 4; ++j) acc[j] = MFMA16(a, lds_frag_tr(Bs, BLB, 32 * ks, 16 * (4 * nh + j), lane), acc[j]); }
#pragma unroll
      for (int j = 0; j < 4; ++j)
#pragma unroll
          for (int i = 0; i < 4; ++i) st[(16 * pt + 4 * g4 + i) * SN + 16 * (4 * nh + j) + r16] = acc[j][i]; }
    __syncthreads();
}

__device__ __forceinline__ void ssd_out_unit(int unit, InP in, int L, unsigned char* ws, LAS unsigned char* lds, int tid, int lane, int wave) {
    asm volatile("" : "+v"(tid), "+v"(lane));
    const int hf = unit & 1, grp = (unit >> 1) & 1, bc = unit >> 2; const int m0 = bc * SCH;
    const bf16* xc = (const bf16*)(ws + R_XC); const float* dtb = (const float*)(ws + R_DT); const bf16* pv = (const bf16*)(ws + R_SPV);
    const bf16* u = (const bf16*)(ws + R_U); bf16* mix = (bf16*)(ws + WS_MIX);
    const float* a_log = in->p[12] + L * SH; const float* dsk = in->p[14] + L * SH; const float* ng = in->p[15] + (size_t)L * SWD;
    constexpr int CLB = 272, XLB = 144;
    LAS unsigned char* Cs = lds; LAS unsigned char* Bs = lds + 34816;
    LAS float* acs8 = (LAS float*)(lds + 104448); LAS float* dt8 = (LAS float*)(lds + 112640);
    const int nS = 128 * (hf + 1);
    const int g4 = lane >> 4, r16 = lane & 15;
#pragma unroll
    for (int i = 0; i < 4; ++i) { const int id = tid + NTHR * i, r = id >> 4, ch = id & 15;
        *(LAS v4u*)(Cs + r * CLB + ch * 16) = *(const v4u*)(xc + (size_t)(m0 + 128 * hf + r) * SCONV + 1280 + grp * 128 + 8 * ch); }
    for (int i = 0; i < 4 * (hf + 1); ++i) { const int id = tid + NTHR * i, r = id >> 4, ch = id & 15;
        *(LAS v4u*)(Bs + r * CLB + ch * 16) = *(const v4u*)(xc + (size_t)(m0 + r) * SCONV + 1024 + grp * 128 + 8 * ch); }
    { const int hd = 8 * grp + wave; const float A = -__expf(a_log[hd]); float d[4], dv[4]; float run = 0.f;
#pragma unroll
      for (int i = 0; i < 4; ++i) { dv[i] = dtb[(size_t)(m0 + 4 * lane + i) * 16 + hd]; run += dv[i] * A; d[i] = run; }
      const float ex = wave_scan(run, lane) - run;
#pragma unroll
      for (int i = 0; i < 4; ++i) { acs8[wave * 256 + 4 * lane + i] = d[i] + ex; dt8[wave * 256 + 4 * lane + i] = dv[i]; } }
    __syncthreads();
    const int lim = 8 * hf + wave;
    const int lloc = 128 * hf + 16 * wave + r16;
    bf16x8 bC[4];
#pragma unroll
    for (int ks = 0; ks < 4; ++ks) bC[ks] = lds_frag(Cs, CLB, 16 * wave, 32 * ks, lane);
    v2u cb[16];
#pragma unroll
    for (int stt = 0; stt < 16; ++stt) { f32x4 acc = {0.f, 0.f, 0.f, 0.f};
        if (stt <= lim) {
#pragma unroll
            for (int ks = 0; ks < 4; ++ks) acc = MFMA16(lds_frag(Bs, CLB, 16 * stt, 32 * ks, lane), bC[ks], acc); }
        cb[stt] = pack4_mfma(acc); }
    __syncthreads();
    float ssq = 0.f;
    constexpr int XB2 = 136;
    LAS unsigned char* Xb0 = lds + 34816; LAS unsigned char* Xb1 = lds + 69632;
    LAS unsigned char* Pb0 = lds; LAS unsigned char* Pb1 = lds + 17408;
    v4u xr[4], pr[2];
#define SO_PLOAD(hd_) do { const bf16* ph_ = pv + ((size_t)bc * SH + (hd_)) * (SP * SN); _Pragma("unroll") for (int i = 0; i < 2; ++i) { const int id = tid + NTHR * i; pr[i] = *(const GAS v4u*)(ph_ + (size_t)id * 8); } } while (0)
#define SO_PSTORE(buf) do { _Pragma("unroll") for (int i = 0; i < 2; ++i) { const int id = tid + NTHR * i, r = id >> 4, ch = id & 15; *(LAS v4u*)((buf) + r * CLB + ch * 16) = pr[i]; } } while (0)
#define SO_XLOAD(hd_) do { _Pragma("unroll") for (int i = 0; i < 4; ++i) if (i < 2 * (hf + 1)) { const int id = tid + NTHR * i, r = id >> 3, ch = id & 7; \
            xr[i] = *(const GAS v4u*)(xc + (size_t)(m0 + r) * SCONV + (hd_) * 64 + 8 * ch); } } while (0)
#define SO_XSTORE(buf) do { _Pragma("unroll") for (int i = 0; i < 4; ++i) if (i < 2 * (hf + 1)) { const int id = tid + NTHR * i, r = id >> 3, ch = id & 7; \
            LAS v2u* d_ = (LAS v2u*)((buf) + r * XB2 + ch * 16); d_[0] = (v2u){xr[i].x, xr[i].y}; d_[1] = (v2u){xr[i].z, xr[i].w}; } } while (0)
    SO_XLOAD(8 * grp); SO_PLOAD(8 * grp); SO_XSTORE(Xb0); SO_PSTORE(Pb0);
    __syncthreads();
    for (int e = 0; e < 8; ++e) {
        const int hd = 8 * grp + e;
        LAS unsigned char* Xs = (e & 1) ? Xb1 : Xb0; LAS unsigned char* Xn = (e & 1) ? Xb0 : Xb1;
        LAS unsigned char* Ps = (e & 1) ? Pb1 : Pb0; LAS unsigned char* Pn = (e & 1) ? Pb0 : Pb1;
        if (e + 1 < 8) { SO_XLOAD(hd + 1); SO_PLOAD(hd + 1); }

        const LAS float* ac = acs8 + e * 256; const LAS float* dd = dt8 + e * 256;
        const float al = ac[lloc];
        f32x4 y[4] = {{0.f, 0.f, 0.f, 0.f}, {0.f, 0.f, 0.f, 0.f}, {0.f, 0.f, 0.f, 0.f}, {0.f, 0.f, 0.f, 0.f}};
#pragma unroll
        for (int kb = 0; kb < 8; ++kb) {
            if (2 * kb <= lim) {
                f32x4 m0v, m1v;
                const f32x4 c0 = {bflo(cb[2 * kb].x), bfhi(cb[2 * kb].x), bflo(cb[2 * kb].y), bfhi(cb[2 * kb].y)}, c1 = {bflo(cb[2 * kb + 1].x), bfhi(cb[2 * kb + 1].x), bflo(cb[2 * kb + 1].y), bfhi(cb[2 * kb + 1].y)};
#pragma unroll
                for (int i = 0; i < 4; ++i) { const int s0 = 32 * kb + 4 * g4 + i, s1 = s0 + 16;
                    m0v[i] = (s0 <= lloc) ? c0[i] * __expf(al - ac[s0]) * dd[s0] : 0.f;
                    m1v[i] = (s1 <= lloc) ? c1[i] * __expf(al - ac[s1]) * dd[s1] : 0.f; }
                const bf16x8 mf = pack_frag(m0v, m1v);
#pragma unroll
                for (int pt = 0; pt < 4; ++pt) y[pt] = MFMA16(lds_frag_trp(Xs, XB2, 32 * kb, 16 * pt, lane), mf, y[pt]);
            }
            __builtin_amdgcn_sched_barrier(0);
        }
        const float eal = __expf(al), dk = dsk[hd];
#pragma unroll
        for (int pt = 0; pt < 4; ++pt) { f32x4 acc = {0.f, 0.f, 0.f, 0.f};
#pragma unroll
            for (int ks = 0; ks < 4; ++ks) acc = MFMA16(lds_frag(Ps, CLB, 16 * pt, 32 * ks, lane), bC[ks], acc);
            const v2u xv = *(const LAS v2u*)(Xs + lloc * XB2 + (16 * pt + 4 * g4) * 2);
            const v2u zq = *(const GAS v2u*)(u + (size_t)(m0 + lloc) * D_INP + U_SZ + hd * 64 + 16 * pt + 4 * g4);
            f32x4 r;
            r[0] = (y[pt][0] + eal * acc[0] + dk * bflo(xv.x)) * siluf_(bflo(zq.x)); r[1] = (y[pt][1] + eal * acc[1] + dk * bfhi(xv.x)) * siluf_(bfhi(zq.x));
            r[2] = (y[pt][2] + eal * acc[2] + dk * bflo(xv.y)) * siluf_(bflo(zq.y)); r[3] = (y[pt][3] + eal * acc[3] + dk * bfhi(xv.y)) * siluf_(bfhi(zq.y));
            const v2u pk = pack4(r);
            const float q0 = bflo(pk.x), q1 = bfhi(pk.x), q2 = bflo(pk.y), q3 = bfhi(pk.y);
            ssq += (q0 * q0 + q1 * q1) + (q2 * q2 + q3 * q3);
            *(v2u*)(mix + (size_t)(m0 + lloc) * DM + 512 + hd * 64 + 16 * pt + 4 * g4) = pk; }
        if (e + 1 < 8) { SO_XSTORE(Xn); SO_PSTORE(Pn); }
        __syncthreads();
    }
#undef SO_XLOAD
#undef SO_XSTORE
#undef SO_PLOAD
#undef SO_PSTORE
    ssq += shx<16>(ssq); ssq = sum32(ssq);
    const float rs = rsqrtf(ssq * (1.0f / 512.0f) + EPS);
    VM_WAIT();
    for (int e = 0; e < 8; ++e) { const int hd = 8 * grp + e;
#pragma unroll
        for (int pt = 0; pt < 4; ++pt) { bf16* p = mix + (size_t)(m0 + lloc) * DM + 512 + hd * 64 + 16 * pt + 4 * g4; const v2u pk = *(const v2u*)p;
            const f32x4 gg = *(const f32x4*)(ng + hd * 64 + 16 * pt + 4 * g4);
            f32x4 r; r[0] = bflo(pk.x) * rs * gg[0]; r[1] = bfhi(pk.x) * rs * gg[1]; r[2] = bflo(pk.y) * rs * gg[2]; r[3] = bfhi(pk.y) * rs * gg[3];
            *(v2u*)p = pack4(r); } }
}

#ifndef MK_PER_PHASE
#define MK_PER_PHASE 0
#endif
#define PHASE_FN __device__ __forceinline__
#define LND(p) asm volatile("" : "+s"(p))
#define PH_IDS int tid_ = threadIdx.x; asm volatile("" : "+v"(tid_)); int G_ = gridDim.x, bid_ = blockIdx.x; LND(G_); LND(bid_); const int tid = tid_, G = G_, bid = bid_; const int lane = tid & 63, wave = __builtin_amdgcn_readfirstlane(tid >> 6); \
    const int gw = bid * NWAVES + wave, NGW = G * NWAVES, gtid = bid * NTHR + tid, NGT = G * NTHR; (void)lane; (void)gw; (void)NGW; (void)gtid; (void)NGT
constexpr int PH_PER_LAYER = 14, N_PHASES = 1 + 2 * PH_PER_LAYER;
struct Args { In in; float* out; unsigned char* ws; int ph_lo, ph_hi; };

PHASE_FN void ph_prologue(InP in, unsigned char* ws, LAS unsigned char* lds) { LND(in); LND(ws); LND(lds); PH_IDS; prologue_phase(in, ws, lds, gw, NGW, wave, lane, gtid, NGT, bid, G); }
template <int WHICH> PHASE_FN void ph_rms(InP in, int L, float* hbuf, unsigned char* ws, LAS unsigned char* lds) { LND(in); LND(hbuf); LND(ws); LND(lds); PH_IDS;
    const float* h = (WHICH == 0 && L == 0) ? in->p[0] : hbuf; const float* g = (WHICH == 0 ? in->p[3] : in->p[22]) + (size_t)L * DM;
    if (WHICH == 2) rms_phase<true, true>(h, g, nullptr, (signed char*)(ws + WS_HN8), (float*)(ws + WS_SA), in->p[26], (int*)(ws + WS_ROUTE), (float*)(ws + WS_ROUTE + (size_t)T * 8), (unsigned*)(ws + WS_CTL) + CW_CNT, lds, gw, NGW, lane, tid);
    else rms_phase<false, true>(h, g, nullptr, (signed char*)(ws + WS_HN8), (float*)(ws + WS_SA), nullptr, nullptr, nullptr, nullptr, lds, gw, NGW, lane, tid);
    if (WHICH == 1) scale_fold(0, ws, gtid, NGT);
    if (WHICH == 2) scale_fold(1, ws, gtid, NGT); }
PHASE_FN void ph_gemm_win(int L, unsigned char* ws, LAS unsigned char* lds) { LND(ws); LND(lds); PH_IDS;
    pg8::Gemm g{ws + WS_HN8, ws + WS_WIN + (size_t)L * (SZ_WIN / 2), T, D_INP, DM, 0}; pg8::StaticOrder S; S.init(T, D_INP, G, bid);
    pg8::EpiBf16Plain8 E{(bf16*)(ws + R_U), D_INP, (const float*)(ws + WS_SA), (const float*)(ws + WS_SWIN) + L * D_INP}; pg8::gemm_phase<pg8::EpiBf16Plain8, pg8::StaticOrder, true, true, 1>(lds, g, S, E); }
PHASE_FN void ph_conv(InP in, int L, unsigned char* ws) { LND(in); LND(ws); PH_IDS; conv_phase(in, L, ws, gw, NGW, lane); }
template <int WHICH> PHASE_FN void ph_gemm_plain(int L, unsigned char* ws, LAS unsigned char* lds, int first = -1, int nblk = 0) { LND(ws); LND(lds); PH_IDS;
    const bf16* A = WHICH == 0 ? (const bf16*)(ws + R_QLN) : WHICH == 1 ? (const bf16*)(ws + R_KVLN) : (const bf16*)(ws + WS_PB) + (size_t)L * T * PLE_DIM;
    const bf16* Bt = WHICH == 0 ? (const bf16*)(ws + WS_WQB + L * SZ_WQB) : WHICH == 1 ? (const bf16*)(ws + WS_WKVB + L * SZ_WKVB) : (const bf16*)(ws + WS_WPP + L * SZ_WPP);
    bf16* O = WHICH == 0 ? (bf16*)(ws + R_QRAW) : WHICH == 1 ? (bf16*)(ws + R_KVRAW) : (bf16*)(ws + WS_E);
    constexpr int N = WHICH == 0 ? 768 : WHICH == 1 ? 1024 : DM, K = WHICH == 0 ? MQR : WHICH == 1 ? MKVR : PLE_DIM;
    pg8::Gemm g{A, Bt, T, N, K, 0}; pg8::StaticOrder S;
    if (first < 0) S.init(T, N, G, bid); else { if (bid < first) return; S.init(T, N, nblk, bid - first); }
    pg8::EpiBf16Plain E{O, N}; pg8::gemm_phase<pg8::EpiBf16Plain, pg8::StaticOrder, true, true>(lds, g, S, E); }
constexpr int WIN_ND = 16;
PHASE_FN void ph_down_quant(InP in, unsigned char* ws, LAS unsigned char* lds) { LND(in); LND(ws); LND(lds); PH_IDS;
    const int NS = BATCH * GH + (G == 256 ? WIN_ND : 0); if (G > 2 * NS) { if (bid < NS) return; down_quant_phase(in->p[25], in->p[29], ws, lds, bid - NS, G - NS, lane, wave); }
    else down_quant_phase(in->p[25], in->p[29], ws, lds, bid, G, lane, wave); }
constexpr int MOE_GU_L0 = 768;
PHASE_FN void ph_moe_gu_quant(InP in, unsigned char* ws, LAS unsigned char* lds, int lo, int hi) { LND(in); LND(ws); LND(lds); PH_IDS;
    const int NS = BATCH * GH + (G == 256 ? WIN_ND : 0); if (G > 2 * NS) { if (bid < NS) return; moe_gu_quant_phase(in, ws, lds, lo, hi, bid - NS, G - NS, lane, wave); }
    else moe_gu_quant_phase(in, ws, lds, lo, hi, bid, G, lane, wave); }
PHASE_FN void ph_gemm_pe(InP in, int L, unsigned char* ws, LAS unsigned char* lds, int first, int nblk) { LND(in); LND(ws); LND(lds); PH_IDS;
    pg8::Gemm g{(const bf16*)(ws + WS_PB) + (size_t)L * T * PLE_DIM, ws + WS_WPP + L * SZ_WPP, T, DM, PLE_DIM, 0}; pg8::StaticOrder S;
    if (first < 0) S.init(T, DM, G, bid); else { if (bid < first) return; S.init(T, DM, nblk, bid - first); }
    pg8::EpiPeSS E{(bf16*)(ws + WS_E), DM, in->p[32] + (size_t)L * DM, (float*)(ws + WS_SSP) + (size_t)L * T * 32}; pg8::gemm_phase<pg8::EpiPeSS, pg8::StaticOrder, true, true>(lds, g, S, E); }
PHASE_FN void ph_gdn_prep(unsigned char* ws, LAS unsigned char* lds) { LND(ws); LND(lds); PH_IDS; GdnPre P; if (bid < GNU) gdn_prep_fetch(bid, P, ws, tid, lane, wave);
    for (int un = bid; un < GNU; un += G) gdn_prep_unit(un, un + G < GNU ? un + G : -1, P, ws, lds, tid, lane, wave); }
PHASE_FN void ph_ssd_state(InP in, int L, unsigned char* ws, LAS unsigned char* lds) { LND(in); LND(ws); LND(lds); PH_IDS; const float* a_log = in->p[12] + L * SH; for (int un = bid; un < BATCH * SNC * SH; un += G) ssd_state_unit(un, a_log, ws, lds, tid, lane, wave); }
PHASE_FN void ph_mlaprep(InP in, int L, unsigned char* ws) { LND(in); LND(ws); PH_IDS; mlaprep_phase(in, L, ws, gw, NGW, lane); ssd_scan_phase(ws, gtid, NGT);
    { const f32x4* sp = (const f32x4*)((const float*)(ws + WS_SSP) + (size_t)L * T * 32); float* rs = (float*)(ws + WS_RSE) + (size_t)L * T;
      for (int r = gtid; r < T; r += NGT) { float q = 0.f;
#pragma unroll
          for (int j = 0; j < 8; ++j) { const f32x4 x = sp[(size_t)r * 8 + j]; q += (x[0] + x[1]) + (x[2] + x[3]); }
          rs[r] = rsqrtf(q * (1.0f / DM) + EPS); } }
#ifdef MK_ZERO_MIX
    for (size_t i = gtid; i < (size_t)T * DM / 8; i += NGT) ((v4u*)(ws + WS_MIX))[i] = (v4u){0u, 0u, 0u, 0u};
#endif
}
PHASE_FN void ph_gdn_scan(InP in, int L, unsigned char* ws, LAS unsigned char* lds) { LND(in); LND(ws); LND(lds); PH_IDS; if (bid < BATCH * GH) gdn_scan_unit(bid, in->p[9] + L * GD, ws, lds, tid, lane, wave); }
PHASE_FN void ph_attn(unsigned char* ws, LAS unsigned char* lds) { LND(ws); LND(lds); PH_IDS;
    const int NS = BATCH * GH, GA = G - NS; if (bid < NS || GA <= 0) return;
    const int k = bid - NS;
    if (G == 256) {
        for (int r = 0; r < 3; ++r) { int it;
            if (r == 0) it = k;
            else if (k < WIN_ND) break;
            else { const int j = k - WIN_ND; if (r == 1) it = 240 + (223 - j);
                   else { if (j < 176) break; it = 464 + (223 - j); } }
            const int qb = 31 - (it >> 4), bh = it & 15;
            attn_unit(bh >> 2, bh & 3, qb, ws, lds, tid, lane, wave); __syncthreads(); }
        return; }
    for (int r = 0; r * GA < 512; ++r) { const int it = r * GA + ((r & 1) ? GA - 1 - k : k); if (it >= 512) continue;
        const int qb = 31 - (it >> 4), bh = it & 15;
        attn_unit(bh >> 2, bh & 3, qb, ws, lds, tid, lane, wave); __syncthreads(); } }
PHASE_FN void ph_ssd_out(InP in, int L, unsigned char* ws, LAS unsigned char* lds) { LND(in); LND(ws); LND(lds); PH_IDS;
    const int NU = BATCH * SNC * SG * 2, NS = BATCH * GH;
    if (G == 256 && NU == 256 && NS == 16) {
        if (bid < NS) return;
        const int k = bid - NS;
        for (int r = 0; r < 2; ++r) { if (r == 1 && k >= WIN_ND) break;
            ssd_out_unit(r ? 240 + k : k, in, L, ws, lds, tid, lane, wave); __syncthreads(); }
        return; }
    for (int un = bid; un < NU; un += G) { ssd_out_unit(un, in, L, ws, lds, tid, lane, wave); __syncthreads(); } }
template <int WHICH> PHASE_FN void ph_gemm_resid(InP in, int L, float* hbuf, unsigned char* ws, LAS unsigned char* lds) { LND(in); LND(hbuf); LND(ws); LND(lds); PH_IDS;
    pg8::StaticOrder S; S.init(T, DM, G, bid);
    if constexpr (WHICH == 0) { const float* base = (L == 0) ? in->p[0] : hbuf;
        pg8::Gemm g{ws + WS_MIX, ws + WS_WOUT + L * SZ_WOUT, T, DM, DM, 0};
        pg8::EpiResid E{base, hbuf, nullptr, DM}; pg8::gemm_phase<pg8::EpiResid, pg8::StaticOrder, true, true>(lds, g, S, E);
    } else {
        pg8::Gemm g{ws + R_ACT, ws + WS_WDN, T, DM, FF0, 2 * FF0};
        pg8::EpiResid8 E{hbuf, hbuf, nullptr, DM, (const float*)(ws + WS_SA2), (const float*)(ws + WS_SDD)}; pg8::gemm_phase<pg8::EpiResid8, pg8::StaticOrder, true, true, 1>(lds, g, S, E); } }
PHASE_FN void ph_gemm_gu(unsigned char* ws, LAS unsigned char* lds) { LND(ws); LND(lds); PH_IDS;
    pg8::Gemm g{ws + WS_HN8, ws + WS_WGU, T, 2 * FF0, DM, 0}; pg8::StaticOrder S; S.init(T, 2 * FF0, G, bid);
    pg8::EpiSwiGLU8 E{(bf16*)(ws + R_ACT), FF0, (const float*)(ws + WS_SA), (const float*)(ws + WS_SWD)}; pg8::gemm_phase<pg8::EpiSwiGLU8, pg8::StaticOrder, true, true, 1>(lds, g, S, E); }
PHASE_FN void ph_moe_permute(unsigned char* ws, LAS unsigned char* lds) { LND(ws); LND(lds); PH_IDS; moe_permute_phase(ws, (unsigned*)(ws + WS_CTL), lds, bid, G, tid, lane, wave); }
PHASE_FN void ph_moe_gu(unsigned char* ws, LAS unsigned char* lds) { LND(ws); LND(lds); PH_IDS;
    int toff[9]; moe_tile_prefix((unsigned*)(ws + WS_CTL) + CW_CNT, toff);
    pg8::Gemm g{ws + R_XP, ws + WS_WMGU, MAXSLOTS, 2 * FFE, DM, 0}; pg8::GroupOrder S; S.init(toff, 2 * FFE / 256, G, bid);
    pg8::EpiSwiGLU8 E{(bf16*)(ws + R_ACTP), FFE, (const float*)(ws + WS_XSC), (const float*)(ws + WS_SWM)}; pg8::gemm_phase<pg8::EpiSwiGLU8, pg8::GroupOrder, true, true, 1>(lds, g, S, E); }
PHASE_FN void ph_moe_down(unsigned char* ws, LAS unsigned char* lds) { LND(ws); LND(lds); PH_IDS;
    int toff[9]; moe_tile_prefix((unsigned*)(ws + WS_CTL) + CW_CNT, toff);
    pg8::Gemm g{ws + R_ACTP, ws + WS_WMDN, MAXSLOTS, DM, FFE, 2 * FFE}; pg8::GroupOrder S; S.init(toff, DM / 256, G, bid);
    pg8::EpiBf16Plain8 E{(bf16*)(ws + R_XP), DM, (const float*)(ws + WS_SA2), (const float*)(ws + WS_SDM)}; pg8::gemm_phase<pg8::EpiBf16Plain8, pg8::GroupOrder, true, true, 1>(lds, g, S, E); }
PHASE_FN void ph_act_quant(int L, unsigned char* ws) { LND(ws); PH_IDS;
    if (L == 0) act_quant_phase<FF0>(ws + R_ACT, (float*)(ws + WS_SA2), T, gw, NGW, lane);
    else { int toff[9]; moe_tile_prefix((unsigned*)(ws + WS_CTL) + CW_CNT, toff); act_quant_phase<FFE>(ws + R_ACTP, (float*)(ws + WS_SA2), toff[8] * 256, gw, NGW, lane); } }
PHASE_FN void ph_moe_combine(unsigned char* ws, float* h) { LND(ws); LND(h); PH_IDS; moe_combine_phase(ws, h, gw, NGW, lane); }
PHASE_FN void ph_gemm_ple(int L, float* h, unsigned char* ws, LAS unsigned char* lds) { LND(h); LND(ws); LND(lds); PH_IDS;
    pg8::StaticOrder S; S.init(T, DM, G, bid);
    { pg8::Gemm g{ws + WS_HN8, ws + WS_WPG8 + (size_t)L * DM * DM, T, DM, DM, 0};
      pg8::EpiPle8 E{h, (const bf16*)(ws + WS_E), DM, (const float*)(ws + WS_SA), (const float*)(ws + WS_SPG) + L * DM, (const float*)(ws + WS_RSE) + L * T}; pg8::gemm_phase<pg8::EpiPle8, pg8::StaticOrder, true, true, 1>(lds, g, S, E); } }
PHASE_FN void ph_h_quant(float* h, unsigned char* ws) { LND(h); LND(ws); PH_IDS; h_quant_phase(h, (signed char*)(ws + WS_HN8), (float*)(ws + WS_SA), gw, NGW, lane); }

__device__ __forceinline__ bool in_range(int k, int lo, int hi) { LND(lo); LND(hi); return lo <= k && k < hi; }
#ifndef MK_DIS
#define MK_DIS 0u
#endif
#define ON(j) (!((MK_DIS >> (j)) & 1u))
#ifndef MK_DUP
#define MK_DUP 0u
#endif
#define DUP(j) ((MK_DUP >> (j)) & 1u)
#define IN(k) in_range((k), lo, hi)
#define SEAM(k) do { if (IN(k) && IN((k) + 1)) { XcdBarrier bb_ = bar; LND(bb_.bar); LND(bb_.x); xcd_barrier(bb_); } } while (0)
template <int L> __device__ __forceinline__ void layer_phases(InP in, float* hbuf, unsigned char* ws, LAS unsigned char* lds, const XcdBarrier& bar, const int lo, const int hi) {

        const int pb = 1 + PH_PER_LAYER * L;
        if (IN(pb + 0) && ON(0)) { ph_rms<0>(in, L, hbuf, ws, lds); if (DUP(0)) { __syncthreads(); ph_rms<0>(in, L, hbuf, ws, lds); } }
        SEAM(pb + 0);
        if (IN(pb + 1) && ON(1)) { ph_gemm_win(L, ws, lds); if (DUP(1)) { __syncthreads(); ph_gemm_win(L, ws, lds); }
            { const int Gs = gridDim.x, tail = ((T / 256) * (D_INP / 256)) % Gs;
              __syncthreads(); if (tail > 0 && tail < Gs) ph_gemm_pe(in, L, ws, lds, tail, Gs - tail); else ph_gemm_pe(in, L, ws, lds, -1, 0); } }
        SEAM(pb + 1);
        if (IN(pb + 2) && ON(2)) { ph_conv(in, L, ws); if (DUP(2)) ph_conv(in, L, ws); }
        SEAM(pb + 2);
        if (IN(pb + 3) && ON(3)) {
            ph_gemm_plain<0>(L, ws, lds); ph_gemm_plain<1>(L, ws, lds);
            __syncthreads();
            ph_gdn_prep(ws, lds);
            ph_ssd_state(in, L, ws, lds);
            if (DUP(3)) { ph_gemm_plain<0>(L, ws, lds); ph_gemm_plain<1>(L, ws, lds); __syncthreads(); }
            if (DUP(4)) { ph_gdn_prep(ws, lds); }
            if (DUP(14)) { ph_ssd_state(in, L, ws, lds); }
        }
        SEAM(pb + 3);
        if (IN(pb + 4) && ON(4)) ph_mlaprep(in, L, ws);
        SEAM(pb + 4);
        if (IN(pb + 5) && ON(5)) {
#ifndef NO_GSCAN
            ph_gdn_scan(in, L, ws, lds);
#endif
            const int fgrp = (int)(blockIdx.x % 3u); const bool fill_first = fgrp == 1, fill_mid = fgrp == 2;
#define PH5_FILL() do { __syncthreads(); if (L == 0) { ph_moe_gu_quant(in, ws, lds, NEXP * ST_EXP, NEXP * ST_EXP + 64); ph_down_quant(in, ws, lds); ph_moe_gu_quant(in, ws, lds, 0, MOE_GU_L0); } \
            else { ph_moe_gu_quant(in, ws, lds, NEXP * ST_EXP + 64, NEXP * ST_EXP + 128); ph_moe_gu_quant(in, ws, lds, MOE_GU_L0, NEXP * ST_EXP); } __syncthreads(); } while (0)
            if (fill_first) PH5_FILL();
#ifndef NO_ATTN
            ph_attn(ws, lds);
#endif
            if (fill_mid) PH5_FILL();
#ifndef NO_SSDOUT
            ph_ssd_out(in, L, ws, lds);
#endif
            if (!fill_first && !fill_mid) PH5_FILL();
#undef PH5_FILL
            if (DUP(5)) ph_gdn_scan(in, L, ws, lds);
            if (DUP(6)) ph_attn(ws, lds);
            if (DUP(7)) ph_ssd_out(in, L, ws, lds);
        }
        SEAM(pb + 5);
        if (IN(pb + 6) && ON(6)) ph_gemm_resid<0>(in, L, hbuf, ws, lds);
        SEAM(pb + 6);
        if (IN(pb + 7) && ON(7)) { if (L == 0) ph_rms<1>(in, L, hbuf, ws, lds); else ph_rms<2>(in, L, hbuf, ws, lds); }
        SEAM(pb + 7);
        if (IN(pb + 8) && ON(8)) { if (L == 0) { ph_gemm_gu(ws, lds); if (DUP(8)) { __syncthreads(); ph_gemm_gu(ws, lds); } } else ph_moe_permute(ws, lds); }
        SEAM(pb + 8);
        if (IN(pb + 9) && ON(9)) { if (L == 0) ph_act_quant(L, ws); else { ph_moe_gu(ws, lds); if (DUP(9)) { __syncthreads(); ph_moe_gu(ws, lds); } } }
        SEAM(pb + 9);
        if (IN(pb + 10) && ON(10)) { if (L == 0) ph_gemm_resid<1>(in, L, hbuf, ws, lds); else ph_act_quant(L, ws); }
        SEAM(pb + 10);
        if (IN(pb + 11) && ON(11)) { if (L == 1) { ph_moe_down(ws, lds); if (DUP(10)) { __syncthreads(); ph_moe_down(ws, lds); } } else ph_h_quant(hbuf, ws); }
        SEAM(pb + 11);
        if (IN(pb + 12) && ON(12)) { if (L == 1) ph_moe_combine(ws, hbuf); }
        if (L == 1) SEAM(pb + 12);
        if (IN(pb + 13) && ON(12)) ph_gemm_ple(L, hbuf, ws, lds);
        SEAM(pb + 13);
    }
__global__ void __launch_bounds__(NTHR, 2) mk_fwd(Args a) {
    extern __shared__ __attribute__((aligned(16))) unsigned char lds_raw[];
    LAS unsigned char* lds = (LAS unsigned char*)lds_raw;
    volatile LAS unsigned* MISC = (volatile LAS unsigned*)(lds + MISC_OFF);
    InP in = (InP)__builtin_amdgcn_kernarg_segment_ptr();
    const int tid = threadIdx.x;
    unsigned char* ws = a.ws; unsigned* ctl = (unsigned*)(ws + WS_CTL);
    if (tid < 64) MISC[tid] = 0u;
    __syncthreads();
    XcdBarrier bar = xcd_barrier_post(ctl + CW_BAR, MISC + 8);
    const int lo = a.ph_lo, hi = a.ph_hi;
    float* hbuf = a.out;

    if (IN(0) && ON(13)) { ph_prologue(in, ws, lds); if (DUP(13)) { __syncthreads(); ph_prologue(in, ws, lds); } }
    SEAM(0);
    layer_phases<0>(in, hbuf, ws, lds, bar, lo, hi);
    layer_phases<1>(in, hbuf, ws, lds, bar, lo, hi);
}

extern "C" void kernel_launch(void* const* d_in, const int* in_sizes, int n_in, void* d_out, int out_size, void* d_ws, size_t ws_size, hipStream_t stream) {
    static int grid = 0;
    if (grid == 0) {
        if (n_in != 33 || out_size != T * DM || ws_size < WS_END) { fprintf(stderr, "kernel_launch: unexpected shapes (n_in %d, out %d, ws %zu < %zu); nothing launched\n", n_in, out_size, ws_size, (size_t)WS_END); grid = -1; return; }
        int dev = 0, cus = 0, per_cu = 0;
        if (hipGetDevice(&dev) != hipSuccess || hipDeviceGetAttribute(&cus, hipDeviceAttributeMultiprocessorCount, dev) != hipSuccess) { grid = -1; return; }
        if (hipFuncSetAttribute((const void*)mk_fwd, hipFuncAttributeMaxDynamicSharedMemorySize, LDS_BYTES) != hipSuccess) { fprintf(stderr, "kernel_launch: hipFuncSetAttribute failed\n"); grid = -1; return; }
        if (hipOccupancyMaxActiveBlocksPerMultiprocessor(&per_cu, (const void*)mk_fwd, NTHR, LDS_BYTES) != hipSuccess || per_cu < 1) { fprintf(stderr, "kernel_launch: occupancy query says %d\n", per_cu); }
        (void)hipGetLastError();
        grid = cus;
    }
    if (grid < 0) return;
    (void)hipMemsetAsync((char*)d_ws + WS_CTL, 0, CTL_ZERO_BYTES, stream);
    Args a{};
    for (int i = 0; i < 33; ++i) a.in.p[i] = (const float*)d_in[i];
    a.out = (float*)d_out; a.ws = (unsigned char*)d_ws;
#if MK_PER_PHASE
#ifndef MK_MAXPH
#define MK_MAXPH N_PHASES
#endif
    for (int ph = 0; ph < MK_MAXPH; ++ph) {
        if (ph == 1 + 12) continue;
        a.ph_lo = ph; a.ph_hi = ph + 1;
        hipLaunchKernelGGL(mk_fwd, dim3(grid), dim3(NTHR), LDS_BYTES, stream, a);
    }
#else
    a.ph_lo = 0; a.ph_hi = N_PHASES;
    hipLaunchKernelGGL(mk_fwd, dim3(grid), dim3(NTHR), LDS_BYTES, stream, a);
#endif
}
```

```cpp
#include <hip/hip_runtime.h>
#include <cstdio>
#include <cstdint>

#define GAS __attribute__((address_space(1)))
#define LAS __attribute__((address_space(3)))
typedef unsigned short bf16;
typedef unsigned short bf16_t;
typedef unsigned v4u __attribute__((ext_vector_type(4)));
typedef unsigned v2u __attribute__((ext_vector_type(2)));
typedef float f32x4 __attribute__((ext_vector_type(4)));
typedef float f32x2 __attribute__((ext_vector_type(2)));
typedef short bf16x8 __attribute__((ext_vector_type(8)));
typedef short s16x4 __attribute__((ext_vector_type(4)));
typedef unsigned u32x4 __attribute__((ext_vector_type(4)));
typedef GAS unsigned gu32;
#define RLX_AGENT __ATOMIC_RELAXED, __HIP_MEMORY_SCOPE_AGENT
#define LDS_WAIT() asm volatile("s_waitcnt lgkmcnt(0)" ::: "memory")
#define VM_WAIT() asm volatile("s_waitcnt vmcnt(0)" ::: "memory")

typedef __bf16 bf16x2_t __attribute__((ext_vector_type(2)));
__device__ __forceinline__ unsigned cvt_pk_bf16(float lo, float hi) { unsigned r; asm volatile("v_cvt_pk_bf16_f32 %0, %1, %2" : "=v"(r) : "v"(lo), "v"(hi)); return r; }
__device__ __forceinline__ unsigned cvt_pk_bf16_cv(float lo, float hi) { f32x2 v = {lo, hi}; bf16x2_t b = __builtin_convertvector(v, bf16x2_t); return __builtin_bit_cast(unsigned, b); }
__device__ __forceinline__ float bf2f(unsigned short b) { return __uint_as_float(((unsigned)b) << 16); }
__device__ __forceinline__ float bflo(unsigned w) { return __uint_as_float(w << 16); }
__device__ __forceinline__ float bfhi(unsigned w) { return __uint_as_float(w & 0xffff0000u); }
__device__ __forceinline__ unsigned short f2bf(float f) { return (unsigned short)(cvt_pk_bf16(f, 0.f) & 0xffffu); }
__device__ __forceinline__ float sigmoidf_(float x) { return __builtin_amdgcn_rcpf(1.0f + __expf(-x)); }
__device__ __forceinline__ float siluf_(float x) { return x * __builtin_amdgcn_rcpf(1.0f + __expf(-x)); }
__device__ __forceinline__ float softplusf_(float x) { return x > 20.f ? x : log1pf(__expf(x)); }
template <int X> __device__ __forceinline__ float shx(float v) {
    return __int_as_float(__builtin_amdgcn_ds_swizzle(__float_as_int(v), (X << 10) | 0x1f)); }
__device__ __forceinline__ float sum32(float v) { auto r = __builtin_amdgcn_permlane32_swap(__float_as_uint(v), __float_as_uint(v), false, false); return __uint_as_float(r[0]) + __uint_as_float(r[1]); }
__device__ __forceinline__ float max32(float v) { auto r = __builtin_amdgcn_permlane32_swap(__float_as_uint(v), __float_as_uint(v), false, false); return fmaxf(__uint_as_float(r[0]), __uint_as_float(r[1])); }
__device__ __forceinline__ float other32(float v, int lane) { auto r = __builtin_amdgcn_permlane32_swap(__float_as_uint(v), __float_as_uint(v), false, false); return __uint_as_float(lane < 32 ? r[1] : r[0]); }
__device__ __forceinline__ float wave_sum(float v) {
    v += shx<1>(v); v += shx<2>(v); v += shx<4>(v); v += shx<8>(v); v += shx<16>(v); return sum32(v); }
__device__ __forceinline__ float wave_scan(float v, int lane) {
    asm volatile("" : "+v"(lane));
#pragma unroll
    for (int o = 1; o < 64; o <<= 1) { const float t = __int_as_float(__builtin_amdgcn_ds_bpermute(((lane - o) & 63) << 2, __float_as_int(v))); if (lane >= o) v += t; }
    return v; }

namespace pg8 {
#define PG8_LAS __attribute__((address_space(3)))
constexpr int BM = 256, BK = 64, HALF = 128, HTB = HALF * BK * 2  , STAGE_BYTES = 8 * HTB, NXCD = 8, WGM = 4;

__host__ __device__ __forceinline__ int lds_byte(int r, int c) { const int st = (r >> 4) * 2 + (c >> 5), rr = r & 15, cc = c & 31, ob = rr * 64 + cc * 2; return st * 1024 + (ob ^ (((ob >> 9) & 1) << 5)); }
__host__ __device__ __forceinline__ void stage_rc(int b, int& R, int& C) { const int st = b / 1024, sb = b % 1024, swz = sb ^ (((sb >> 9) & 1) << 5); R = (st >> 1) * 16 + swz / 64; C = (st & 1) * 32 + (swz % 64) / 2; }
__host__ __device__ __forceinline__ int perm32(int rho) { const int n = rho >> 4, i = rho & 15; return 8 * (i >> 2) + 4 * n + (i & 3); }

struct Unit { int pm, pn, pb; };
struct Gemm { const void* A; const void* Bt; int M, N, K; int ldaB; };
typedef int i32x4 __attribute__((ext_vector_type(4)));
template <int ES> __device__ __forceinline__ f32x4 mma16(bf16x8 a, bf16x8 b, f32x4 c) {
    if constexpr (ES == 2) return __builtin_amdgcn_mfma_f32_16x16x32_bf16(a, b, c, 0, 0, 0);
    else return __builtin_bit_cast(f32x4, __builtin_amdgcn_mfma_i32_16x16x64_i8(__builtin_bit_cast(i32x4, a), __builtin_bit_cast(i32x4, b), __builtin_bit_cast(i32x4, c), 0, 0, 0)); }

struct StaticOrder {
    int nM, nN, nwg, G, c;
    __host__ __device__ void init(int M, int N, int G_, int c_) { nM = M / BM; nN = N / BM; nwg = nM * nN; G = G_; c = c_; }
    __host__ __device__ bool next(int i, Unit& u) const {
        const long L = (long)i * G + c; if (L >= nwg) return false;
        int wgid = (int)L; { const int q = nwg / NXCD, r = nwg % NXCD, xcd = wgid % NXCD, off = wgid / NXCD; wgid = (xcd < r ? xcd * (q + 1) : r * (q + 1) + (xcd - r) * q) + off; }
        const int nig = WGM * nN, gid = wgid / nig, fm = gid * WGM, gsz = (nM - fm) < WGM ? (nM - fm) : WGM;
        u.pm = fm + ((wgid % nig) % gsz); u.pn = (wgid % nig) / gsz; u.pb = u.pn; return true;
    }
    __device__ __forceinline__ void a_ready(const Unit&) const {}
    __device__ __forceinline__ void done(const Unit&) const {}
};
struct GroupOrder {
    int t1, t2, t3, t4, t5, t6, t7, t8;
    int nN, nwg, G, c;
    __device__ void init(const int* toff, int nN_, int G_, int c_) {
        t1 = toff[1]; t2 = toff[2]; t3 = toff[3]; t4 = toff[4]; t5 = toff[5]; t6 = toff[6]; t7 = toff[7]; t8 = toff[8];
        nN = nN_; G = G_; c = c_; nwg = t8 * nN; }
    __device__ bool next(int i, Unit& u) const {
        int wgid = (i * G) + (c % NXCD) * (G / NXCD) + c / NXCD;
        if (wgid >= nwg) return false;
        const int tt = wgid / nN;
        int e = 0, b0 = 0, b1 = t1;
        if (wgid >= t1 * nN) { e = 1; b0 = t1; b1 = t2; }
        if (wgid >= t2 * nN) { e = 2; b0 = t2; b1 = t3; }
        if (wgid >= t3 * nN) { e = 3; b0 = t3; b1 = t4; }
        if (wgid >= t4 * nN) { e = 4; b0 = t4; b1 = t5; }
        if (wgid >= t5 * nN) { e = 5; b0 = t5; b1 = t6; }
        if (wgid >= t6 * nN) { e = 6; b0 = t6; b1 = t7; }
        if (wgid >= t7 * nN) { e = 7; b0 = t7; b1 = t8; }
        (void)tt;
        const int loc = wgid - b0 * nN, nMe = b1 - b0;
        const int nig = WGM * nN, gid = loc / nig, fm = gid * WGM, gsz = (nMe - fm) < WGM ? (nMe - fm) : WGM;
        u.pm = b0 + fm + ((loc % nig) % gsz); u.pn = (loc % nig) / gsz; u.pb = e * nN + u.pn; return true;
    }
    __device__ __forceinline__ void a_ready(const Unit&) const {}
    __device__ __forceinline__ void done(const Unit&) const {}
};

struct EpiBf16Plain {
    static constexpr bool PERM = true;
    bf16_t* O; int ldc;
    __device__ __forceinline__ void operator()(const f32x4 (&acc)[2][2][4][2], const Unit& u, int wr, int wc, int fr, int fq) const {
        const int row0 = u.pm * BM + wr * 64 + fr, col0 = u.pn * BM + wc * 32 + 8 * fq;
#pragma unroll
        for (int ai = 0; ai < 2; ++ai)
#pragma unroll
            for (int m = 0; m < 4; ++m) { bf16_t* rowp = O + (size_t)(row0 + ai * HALF + m * 16) * ldc + col0;
#pragma unroll
                for (int bj = 0; bj < 2; ++bj) { const f32x4 v0 = acc[ai][bj][m][0], v1 = acc[ai][bj][m][1];
                    u32x4 w; w.x = cvt_pk_bf16(v0[0], v0[1]); w.y = cvt_pk_bf16(v0[2], v0[3]); w.z = cvt_pk_bf16(v1[0], v1[1]); w.w = cvt_pk_bf16(v1[2], v1[3]);
                    *(u32x4*)(rowp + bj * HALF) = w; } }
    }
};
struct EpiBf16Plain8 {
    static constexpr bool PERM = true;
    bf16_t* O; int ldc; const float* sa; const float* sw;
    __device__ __forceinline__ void operator()(const f32x4 (&acc)[2][2][4][2], const Unit& u, int wr, int wc, int fr, int fq) const {
        const int row0 = u.pm * BM + wr * 64 + fr, col0 = u.pn * BM + wc * 32 + 8 * fq, wrow0 = u.pb * BM + wc * 32 + 8 * fq;
        f32x4 s0[2], s1[2];
#pragma unroll
        for (int bj = 0; bj < 2; ++bj) { s0[bj] = *(const f32x4*)(sw + wrow0 + bj * HALF); s1[bj] = *(const f32x4*)(sw + wrow0 + bj * HALF + 4); }
#pragma unroll
        for (int ai = 0; ai < 2; ++ai)
#pragma unroll
            for (int m = 0; m < 4; ++m) { const int row = row0 + ai * HALF + m * 16; bf16_t* rowp = O + (size_t)row * ldc + col0; const float s = sa[row];
#pragma unroll
                for (int bj = 0; bj < 2; ++bj) { const i32x4 a = __builtin_bit_cast(i32x4, acc[ai][bj][m][0]), b = __builtin_bit_cast(i32x4, acc[ai][bj][m][1]);
                    u32x4 w; w.x = cvt_pk_bf16((float)a[0] * s * s0[bj][0], (float)a[1] * s * s0[bj][1]); w.y = cvt_pk_bf16((float)a[2] * s * s0[bj][2], (float)a[3] * s * s0[bj][3]);
                    w.z = cvt_pk_bf16((float)b[0] * s * s1[bj][0], (float)b[1] * s * s1[bj][1]); w.w = cvt_pk_bf16((float)b[2] * s * s1[bj][2], (float)b[3] * s * s1[bj][3]);
                    *(u32x4*)(rowp + bj * HALF) = w; } }
    }
};
struct EpiSwiGLU {
    static constexpr bool PERM = true;
    bf16_t* O; int ldc;
    __device__ __forceinline__ void operator()(const f32x4 (&acc)[2][2][4][2], const Unit& u, int wr, int wc, int fr, int fq) const {
        const int row0 = u.pm * BM + wr * 64 + fr, col0 = u.pn * HALF + wc * 32 + 8 * fq;
#pragma unroll
        for (int ai = 0; ai < 2; ++ai)
#pragma unroll
            for (int m = 0; m < 4; ++m) { bf16_t* rowp = O + (size_t)(row0 + ai * HALF + m * 16) * ldc + col0;
                float r[8];
#pragma unroll
                for (int n = 0; n < 2; ++n)
#pragma unroll
                    for (int j = 0; j < 4; ++j) { const float g = acc[ai][0][m][n][j], up = acc[ai][1][m][n][j]; r[n * 4 + j] = siluf_(g) * up; }
                u32x4 w; w.x = cvt_pk_bf16(r[0], r[1]); w.y = cvt_pk_bf16(r[2], r[3]); w.z = cvt_pk_bf16(r[4], r[5]); w.w = cvt_pk_bf16(r[6], r[7]);
                *(u32x4*)rowp = w; }
    }
};
struct EpiSwiGLU8 {
    static constexpr bool PERM = true;
    bf16_t* O; int ldc; const float* sa; const float* sw;
    __device__ __forceinline__ void operator()(const f32x4 (&acc)[2][2][4][2], const Unit& u, int wr, int wc, int fr, int fq) const {
        const int row0 = u.pm * BM + wr * 64 + fr, col0 = u.pn * HALF + wc * 32 + 8 * fq, wrow0 = u.pb * BM + wc * 32 + 8 * fq;
        const f32x4 g0 = *(const f32x4*)(sw + wrow0), g1 = *(const f32x4*)(sw + wrow0 + 4), u0 = *(const f32x4*)(sw + wrow0 + HALF), u1 = *(const f32x4*)(sw + wrow0 + HALF + 4);
#pragma unroll
        for (int ai = 0; ai < 2; ++ai)
#pragma unroll
            for (int m = 0; m < 4; ++m) { const int row = row0 + ai * HALF + m * 16; bf16_t* rowp = O + (size_t)row * ldc + col0; const float s = sa[row];
                float r[8];
#pragma unroll
                for (int n = 0; n < 2; ++n)
#pragma unroll
                    for (int j = 0; j < 4; ++j) { const i32x4 gi = __builtin_bit_cast(i32x4, acc[ai][0][m][n]), ui = __builtin_bit_cast(i32x4, acc[ai][1][m][n]);
                        const float g = (float)gi[j] * s * (n ? g1[j] : g0[j]), up = (float)ui[j] * s * (n ? u1[j] : u0[j]); r[n * 4 + j] = siluf_(g) * up; }
                u32x4 w; w.x = cvt_pk_bf16(r[0], r[1]); w.y = cvt_pk_bf16(r[2], r[3]); w.z = cvt_pk_bf16(r[4], r[5]); w.w = cvt_pk_bf16(r[6], r[7]);
                *(u32x4*)rowp = w; }
    }
};
struct EpiResid {
    static constexpr bool PERM = false;
    const float* base; float* out; bf16_t* ob; int ldc;
    __device__ __forceinline__ void operator()(const f32x4 (&acc)[2][2][4][2], const Unit& u, int wr, int wc, int fr, int fq) const {
        const int row0 = u.pm * BM + wr * 64 + fr, col0 = u.pn * BM + wc * 32 + 4 * fq;
#pragma unroll
        for (int ai = 0; ai < 2; ++ai)
#pragma unroll
            for (int m = 0; m < 4; ++m) { const size_t off = (size_t)(row0 + ai * HALF + m * 16) * ldc + col0;
#pragma unroll
                for (int bj = 0; bj < 2; ++bj)
#pragma unroll
                    for (int n = 0; n < 2; ++n) { const size_t o2 = off + bj * HALF + n * 16; const f32x4 r = *(const f32x4*)(base + o2) + acc[ai][bj][m][n];
                        *(f32x4*)(out + o2) = r;
                        if (ob) { v2u w; w.x = cvt_pk_bf16(r[0], r[1]); w.y = cvt_pk_bf16(r[2], r[3]); *(v2u*)(ob + o2) = w; } } }
    }
};
struct EpiResid8 {
    static constexpr bool PERM = false;
    const float* base; float* out; bf16_t* ob; int ldc; const float* sa; const float* sw;
    __device__ __forceinline__ void operator()(const f32x4 (&acc)[2][2][4][2], const Unit& u, int wr, int wc, int fr, int fq) const {
        const int row0 = u.pm * BM + wr * 64 + fr, col0 = u.pn * BM + wc * 32 + 4 * fq;
        f32x4 sc[2][2];
#pragma unroll
        for (int bj = 0; bj < 2; ++bj)
#pragma unroll
            for (int n = 0; n < 2; ++n) sc[bj][n] = *(const f32x4*)(sw + col0 + bj * HALF + n * 16);
#pragma unroll
        for (int ai = 0; ai < 2; ++ai)
#pragma unroll
            for (int m = 0; m < 4; ++m) { const int row = row0 + ai * HALF + m * 16; const size_t off = (size_t)row * ldc + col0; const float s = sa[row];
#pragma unroll
                for (int bj = 0; bj < 2; ++bj)
#pragma unroll
                    for (int n = 0; n < 2; ++n) { const size_t o2 = off + bj * HALF + n * 16; const i32x4 a = __builtin_bit_cast(i32x4, acc[ai][bj][m][n]); f32x4 r = *(const f32x4*)(base + o2);
                        r[0] += (float)a[0] * s * sc[bj][n][0]; r[1] += (float)a[1] * s * sc[bj][n][1]; r[2] += (float)a[2] * s * sc[bj][n][2]; r[3] += (float)a[3] * s * sc[bj][n][3];
                        *(f32x4*)(out + o2) = r;
                        if (ob) { v2u w; w.x = cvt_pk_bf16(r[0], r[1]); w.y = cvt_pk_bf16(r[2], r[3]); *(v2u*)(ob + o2) = w; } } }
    }
};
struct EpiPeSS {
    static constexpr bool PERM = true;
    bf16_t* O; int ldc; const float* g; float* ss;
    __device__ __forceinline__ void operator()(const f32x4 (&acc)[2][2][4][2], const Unit& u, int wr, int wc, int fr, int fq) const {
        const int row0 = u.pm * BM + wr * 64 + fr, col0 = u.pn * BM + wc * 32 + 8 * fq;
#pragma unroll
        for (int ai = 0; ai < 2; ++ai)
#pragma unroll
            for (int m = 0; m < 4; ++m) { const int row = row0 + ai * HALF + m * 16; bf16_t* rowp = O + (size_t)row * ldc + col0; float q = 0.f;
#pragma unroll
                for (int bj = 0; bj < 2; ++bj) { const f32x4 v0 = acc[ai][bj][m][0], v1 = acc[ai][bj][m][1];
                    const f32x4 ga = *(const f32x4*)(g + col0 + bj * HALF), gb = *(const f32x4*)(g + col0 + bj * HALF + 4);
                    q += (v0[0] * v0[0] + v0[1] * v0[1]) + (v0[2] * v0[2] + v0[3] * v0[3]) + (v1[0] * v1[0] + v1[1] * v1[1]) + (v1[2] * v1[2] + v1[3] * v1[3]);
                    u32x4 w; w.x = cvt_pk_bf16(v0[0] * ga[0], v0[1] * ga[1]); w.y = cvt_pk_bf16(v0[2] * ga[2], v0[3] * ga[3]);
                    w.z = cvt_pk_bf16(v1[0] * gb[0], v1[1] * gb[1]); w.w = cvt_pk_bf16(v1[2] * gb[2], v1[3] * gb[3]);
                    *(u32x4*)(rowp + bj * HALF) = w; }
                q += shx<16>(q); q = sum32(q);
                if (fq == 0) ss[(size_t)row * 32 + u.pn * 4 + wc] = q;
                asm volatile("" ::: "memory"); }
    }
};
struct EpiPle8 {
    static constexpr bool PERM = false;
    float* h; const bf16_t* e; int ldc; const float* sa; const float* sw; const float* ss;
    __device__ __forceinline__ void operator()(const f32x4 (&acc)[2][2][4][2], const Unit& u, int wr, int wc, int fr, int fq) const {
        const int row0 = u.pm * BM + wr * 64 + fr, col0 = u.pn * BM + wc * 32 + 4 * fq;
        f32x4 sc[2][2];
#pragma unroll
        for (int bj = 0; bj < 2; ++bj)
#pragma unroll
            for (int n = 0; n < 2; ++n) sc[bj][n] = *(const f32x4*)(sw + col0 + bj * HALF + n * 16);
#pragma unroll
        for (int ai = 0; ai < 2; ++ai)
#pragma unroll
            for (int m = 0; m < 4; ++m) { const int row = row0 + ai * HALF + m * 16; const size_t off = (size_t)row * ldc + col0; const float s = sa[row]; const float rse = ss[row];
#pragma unroll
                for (int bj = 0; bj < 2; ++bj)
#pragma unroll
                    for (int n = 0; n < 2; ++n) { const size_t o2 = off + bj * HALF + n * 16; const i32x4 a = __builtin_bit_cast(i32x4, acc[ai][bj][m][n]); const v2u ew = *(const v2u*)(e + o2);
                        f32x4 r = *(const f32x4*)(h + o2);
                        r[0] += sigmoidf_((float)a[0] * s * sc[bj][n][0]) * (bflo(ew.x) * rse); r[1] += sigmoidf_((float)a[1] * s * sc[bj][n][1]) * (bfhi(ew.x) * rse);
                        r[2] += sigmoidf_((float)a[2] * s * sc[bj][n][2]) * (bflo(ew.y) * rse); r[3] += sigmoidf_((float)a[3] * s * sc[bj][n][3]) * (bfhi(ew.y) * rse);
                        *(f32x4*)(h + o2) = r; } }
    }
};
struct EpiPle {
    static constexpr bool PERM = false;
    float* h; const bf16_t* e; int ldc;
    __device__ __forceinline__ void operator()(const f32x4 (&acc)[2][2][4][2], const Unit& u, int wr, int wc, int fr, int fq) const {
        const int row0 = u.pm * BM + wr * 64 + fr, col0 = u.pn * BM + wc * 32 + 4 * fq;
#pragma unroll
        for (int ai = 0; ai < 2; ++ai)
#pragma unroll
            for (int m = 0; m < 4; ++m) { const size_t off = (size_t)(row0 + ai * HALF + m * 16) * ldc + col0;
#pragma unroll
                for (int bj = 0; bj < 2; ++bj)
#pragma unroll
                    for (int n = 0; n < 2; ++n) { const size_t o2 = off + bj * HALF + n * 16; const f32x4 a = acc[ai][bj][m][n]; const v2u ew = *(const v2u*)(e + o2);
                        f32x4 r = *(const f32x4*)(h + o2);
                        r[0] += sigmoidf_(a[0]) * bflo(ew.x); r[1] += sigmoidf_(a[1]) * bfhi(ew.x); r[2] += sigmoidf_(a[2]) * bflo(ew.y); r[3] += sigmoidf_(a[3]) * bfhi(ew.y);
                        *(f32x4*)(h + o2) = r; } }
    }
};

template <class Epi, class Sched, bool ALIGN_EPI = false, bool SP2 = false, int ES = 2  >
__device__ __forceinline__ void gemm_phase(PG8_LAS unsigned char* lds, const Gemm g, const Sched& S, const Epi& E) {
    int tid_ = threadIdx.x; asm volatile("" : "+v"(tid_));
    const int tid = tid_, wid = __builtin_amdgcn_readfirstlane(tid >> 6), lane = tid & 63, wr = wid >> 2, wc = wid & 3, fr = lane & 15, fq = lane >> 4;
    const int K = g.K, nt = (K * ES) / (BK * 2), ldaB = g.ldaB ? g.ldaB : K * ES;
    unsigned voffA[2], voffB[2];
#pragma unroll
    for (int i = 0; i < 2; ++i) { int R, C; stage_rc(tid * 16 + i * 8192, R, C); const int Rb = Epi::PERM ? ((R & ~31) + perm32(R & 31)) : R;
        voffA[i] = (unsigned)(R * ldaB + C * 2); voffB[i] = (unsigned)(Rb * K * ES + C * 2); }
    const size_t kstep = (size_t)(BK * 2);
    const size_t hstep = (size_t)HALF * K * ES;
    const size_t tstep = 2 * hstep;
    const size_t hstepA = (size_t)HALF * ldaB, tstepA = 2 * hstepA;
    const unsigned ldsw = (unsigned)wid * 1024u;
    const int aoff = lds_byte(wr * 64 + fr, fq * 8), boff = lds_byte(wc * 32 + fr, fq * 8);
#define PG8_SA(b, h) (((b) * 2 + (h)) * HTB)
#define PG8_SB(b, h) ((4 + (b) * 2 + (h)) * HTB)
#define PG8_STAGE(bufoff, gbase, voff) do { _Pragma("unroll") for (int _i = 0; _i < 2; ++_i) \
        __builtin_amdgcn_global_load_lds((const unsigned*)((const char*)(gbase) + (voff)[_i]), (PG8_LAS unsigned*)(lds + (bufoff) + ldsw + _i * 8192), 16, 0, 0); } while (0)
#define PG8_LDA(dst, b, h) do { _Pragma("unroll") for (int m = 0; m < 4; ++m) _Pragma("unroll") for (int k = 0; k < 2; ++k) dst[m][k] = *(const PG8_LAS bf16x8*)(lds + PG8_SA(b, h) + aoff + m * 2048 + k * 1024); } while (0)
#define PG8_LDB(dst, b, h) do { _Pragma("unroll") for (int n = 0; n < 2; ++n) _Pragma("unroll") for (int k = 0; k < 2; ++k) dst[n][k] = *(const PG8_LAS bf16x8*)(lds + PG8_SB(b, h) + boff + n * 2048 + k * 1024); } while (0)
#define PG8_MMA(ai, bj, At, Bt) do { __builtin_amdgcn_s_setprio(1); _Pragma("unroll") for (int m = 0; m < 4; ++m) _Pragma("unroll") for (int n = 0; n < 2; ++n) _Pragma("unroll") for (int k = 0; k < 2; ++k) \
        acc[ai][bj][m][n] = mma16<ES>(Bt[n][k], At[m][k], acc[ai][bj][m][n]); __builtin_amdgcn_s_setprio(0); } while (0)
#define PG8_WAIT_V(n) asm volatile("s_waitcnt vmcnt(" #n ")" ::: "memory")
#define PG8_WAIT_L(n) asm volatile("s_waitcnt lgkmcnt(" #n ")" ::: "memory")
#define PG8_BAR __builtin_amdgcn_s_barrier()
#define PG8_SCHED __builtin_amdgcn_sched_barrier(0)
    Unit cur, nxt; int ui = 0;
    if (!S.next(0, cur)) return;
    f32x4 acc[2][2][4][2];
#pragma unroll
    for (int a = 0; a < 2; ++a)
#pragma unroll
        for (int b = 0; b < 2; ++b)
#pragma unroll
            for (int m = 0; m < 4; ++m)
#pragma unroll
                for (int n = 0; n < 2; ++n) acc[a][b][m][n] = (f32x4){0.f, 0.f, 0.f, 0.f};
    bf16x8 At[4][2], B0[2][2], B1[2][2];
    const char* cA = (const char*)g.A + (size_t)cur.pm * tstepA; const char* cB = (const char*)g.Bt + (size_t)cur.pb * tstep;
    S.a_ready(cur);
    if constexpr (SP2) {
        PG8_STAGE(PG8_SB(0, 0), cB, voffB); PG8_STAGE(PG8_SB(0, 1), cB + hstep, voffB); PG8_STAGE(PG8_SA(0, 0), cA, voffA); PG8_STAGE(PG8_SA(0, 1), cA + hstepA, voffA);
        if (wr == 1) PG8_BAR;
        PG8_WAIT_V(2); PG8_BAR;
        PG8_STAGE(PG8_SB(1, 0), cB + kstep, voffB); PG8_STAGE(PG8_SA(1, 0), cA + kstep, voffA); PG8_STAGE(PG8_SB(1, 1), cB + hstep + kstep, voffB);
        PG8_WAIT_V(6); PG8_BAR;
    } else {
        PG8_STAGE(PG8_SB(0, 0), cB, voffB); PG8_STAGE(PG8_SA(0, 0), cA, voffA); PG8_STAGE(PG8_SB(0, 1), cB + hstep, voffB); PG8_STAGE(PG8_SA(0, 1), cA + hstepA, voffA);
        if (wr == 1) PG8_BAR;
        PG8_WAIT_V(4); PG8_BAR;
        PG8_STAGE(PG8_SB(1, 0), cB + kstep, voffB); PG8_STAGE(PG8_SA(1, 0), cA + kstep, voffA); PG8_STAGE(PG8_SB(1, 1), cB + hstep + kstep, voffB);
        PG8_WAIT_V(6); PG8_BAR;
    }
    for (;;) {
        const bool has_next = S.next(ui + 1, nxt);
        const char* nA = has_next ? (const char*)g.A + (size_t)nxt.pm * tstepA : cA; const char* nB = has_next ? (const char*)g.Bt + (size_t)nxt.pb * tstep : cB;
        for (int t = 0; t < nt; t += 2) {
            const bool last = (t == nt - 2);
            const char* a1 = cA + (size_t)(t + 1) * kstep;
            const char* a2 = last ? nA : cA + (size_t)(t + 2) * kstep; const char* b2 = last ? nB : cB + (size_t)(t + 2) * kstep;
            const char* a3 = a2 + kstep; const char* b3 = b2 + kstep;
            if (last && has_next) S.a_ready(nxt);
            if constexpr (SP2) {
            PG8_LDB(B0, 0, 0); PG8_LDB(B1, 0, 1); PG8_SCHED; PG8_LDA(At, 0, 0); PG8_STAGE(PG8_SA(1, 1), a1 + hstepA, voffA);
            PG8_WAIT_V(8); PG8_WAIT_L(0); PG8_BAR; PG8_MMA(0, 0, At, B0); PG8_MMA(0, 1, At, B1); PG8_BAR; PG8_SCHED;
            PG8_LDA(At, 0, 1); PG8_STAGE(PG8_SB(0, 0), b2, voffB); PG8_STAGE(PG8_SB(0, 1), b2 + hstep, voffB); PG8_STAGE(PG8_SA(0, 0), a2, voffA);
            PG8_WAIT_V(8); PG8_WAIT_L(0); PG8_BAR; PG8_MMA(1, 0, At, B0); PG8_MMA(1, 1, At, B1); PG8_BAR; PG8_SCHED;
            PG8_LDB(B0, 1, 0); PG8_LDB(B1, 1, 1); PG8_SCHED; PG8_LDA(At, 1, 0); PG8_STAGE(PG8_SA(0, 1), a2 + hstepA, voffA);
            PG8_WAIT_V(8); PG8_WAIT_L(0); PG8_BAR; PG8_MMA(0, 0, At, B0); PG8_MMA(0, 1, At, B1); PG8_BAR; PG8_SCHED;
            PG8_LDA(At, 1, 1); PG8_STAGE(PG8_SB(1, 0), b3, voffB); PG8_STAGE(PG8_SB(1, 1), b3 + hstep, voffB); PG8_STAGE(PG8_SA(1, 0), a3, voffA);
            PG8_WAIT_V(8); PG8_WAIT_L(0); PG8_BAR; PG8_MMA(1, 0, At, B0); PG8_MMA(1, 1, At, B1); PG8_BAR; PG8_SCHED;
            } else {
            PG8_LDB(B0, 0, 0); PG8_SCHED; PG8_LDA(At, 0, 0); PG8_STAGE(PG8_SA(1, 1), a1 + hstepA, voffA);
            PG8_WAIT_L(8); PG8_BAR; PG8_WAIT_L(0); PG8_MMA(0, 0, At, B0); PG8_BAR; PG8_SCHED;
            PG8_LDB(B1, 0, 1); PG8_STAGE(PG8_SB(0, 0), b2, voffB);
            PG8_BAR; PG8_WAIT_L(0); PG8_MMA(0, 1, At, B1); PG8_BAR;
            PG8_LDA(At, 0, 1); PG8_STAGE(PG8_SA(0, 0), a2, voffA);
            PG8_BAR; PG8_WAIT_L(0); PG8_MMA(1, 0, At, B0); PG8_BAR; PG8_SCHED;
            PG8_STAGE(PG8_SB(0, 1), b2 + hstep, voffB);
            PG8_WAIT_V(6); PG8_BAR; PG8_MMA(1, 1, At, B1); PG8_BAR;
            PG8_LDB(B0, 1, 0); PG8_SCHED; PG8_LDA(At, 1, 0); PG8_STAGE(PG8_SA(0, 1), a2 + hstepA, voffA);
            PG8_WAIT_L(8); PG8_BAR; PG8_WAIT_L(0); PG8_MMA(0, 0, At, B0); PG8_BAR; PG8_SCHED;
            PG8_LDB(B1, 1, 1); PG8_STAGE(PG8_SB(1, 0), b3, voffB);
            PG8_BAR; PG8_WAIT_L(0); PG8_MMA(0, 1, At, B1); PG8_BAR;
            PG8_LDA(At, 1, 1); PG8_STAGE(PG8_SA(1, 0), a3, voffA);
            PG8_BAR; PG8_WAIT_L(0); PG8_MMA(1, 0, At, B0); PG8_BAR; PG8_SCHED;
            PG8_STAGE(PG8_SB(1, 1), b3 + hstep, voffB);
            PG8_WAIT_V(6); PG8_BAR; PG8_MMA(1, 1, At, B1); PG8_BAR;
            }
        }
        if constexpr (ALIGN_EPI) { if (wr == 0) PG8_BAR; }
        E(acc, cur, wr, wc, fr, fq); S.done(cur);
#ifdef DBG_EPI2
        if (ES == 1) { asm volatile("" ::: "memory"); E(acc, cur, wr, wc, fr, fq); }
#endif
        if (!has_next) break;
#pragma unroll
        for (int a = 0; a < 2; ++a)
#pragma unroll
            for (int b = 0; b < 2; ++b)
#pragma unroll
                for (int m = 0; m < 4; ++m)
#pragma unroll
                    for (int n = 0; n < 2; ++n) acc[a][b][m][n] = (f32x4){0.f, 0.f, 0.f, 0.f};
        cur = nxt; cA = nA; cB = nB; ++ui;
        if constexpr (ALIGN_EPI) { if (wr == 1) PG8_BAR; }
    }
    PG8_WAIT_V(0);
    if constexpr (!ALIGN_EPI) { if (wr == 0) PG8_BAR; }
    PG8_BAR;
#undef PG8_SA
#undef PG8_SB
#undef PG8_STAGE
#undef PG8_LDA
#undef PG8_LDB
#undef PG8_MMA
#undef PG8_WAIT_V
#undef PG8_WAIT_L
#undef PG8_BAR
#undef PG8_SCHED
}
}

constexpr int NWAVES = 8, NTHR = 512;
constexpr int BATCH = 4, SEQ = 4096, T = BATCH * SEQ, DM = 2048, DEPTH = 2;
constexpr float EPS = 1e-6f;
constexpr int PLE_DIM = 256;
constexpr int GH = 4, GD = 128, GW = 512, GCH = 64, GNC = SEQ / GCH;
constexpr int SH = 16, SP = 64, SWD = 1024, SG = 2, SN = 128, SCH = 256, SNC = SEQ / SCH, SCONV = 1536;
constexpr int MH = 4, MQR = 384, MKVR = 256, MNOPE = 128, MROPE = 64, MQK = 192, MV = 128;
constexpr int D_IN = 5336, D_INP = 5376;
constexpr int FF0 = 5632, NEXP = 8, FFE = 7168;
constexpr int U_GQ = 0, U_GK = 512, U_GV = 1024, U_GZ = 1536, U_SZ = 2048, U_SX = 3072, U_MQ = 4608, U_MKV = 4992, U_MPE = 5248, U_GB = 5312, U_GA = 5316, U_SDT = 5320;
constexpr int S_GDN = 0, S_GBA = 2048, S_SZ = 2056, S_SX = 3080, S_SDT = 4616, S_MQ = 4632, S_MKV = 5016, S_MPE = 5272;
constexpr int MAXSLOT_TILES = 136, MAXSLOTS = MAXSLOT_TILES * 256;

constexpr size_t MiB = 1u << 20;
constexpr size_t al256(size_t x) { return (x + 255) & ~(size_t)255; }
constexpr size_t WS_CTL = 0, CTL_ZERO_BYTES = 1 * MiB;
constexpr size_t SZ_WIN = (size_t)D_INP * DM * 2, SZ_WOUT = (size_t)DM * DM * 2, SZ_WQB = (size_t)768 * MQR * 2, SZ_WKVB = (size_t)1024 * MKVR * 2;
constexpr size_t SZ_WGU = (size_t)2 * FF0 * DM * 2, SZ_WDN = (size_t)DM * FF0 * 2, SZ_WMGU = (size_t)NEXP * 2 * FFE * DM * 2, SZ_WMDN = (size_t)NEXP * DM * FFE * 2;
constexpr size_t SZ_WPP = (size_t)DM * PLE_DIM * 2, SZ_WPG = (size_t)DM * DM * 2;
constexpr size_t WS_WIN = 1 * MiB;
constexpr size_t WS_WOUT = WS_WIN + 2 * SZ_WIN;
constexpr size_t WS_WQB = WS_WOUT + 2 * SZ_WOUT;
constexpr size_t WS_WKVB = WS_WQB + 2 * SZ_WQB;
constexpr size_t WS_WGU = WS_WKVB + 2 * SZ_WKVB;
constexpr size_t WS_WDN = WS_WGU + SZ_WGU;
constexpr size_t WS_WMGU = WS_WDN + SZ_WDN;
constexpr size_t WS_WMDN = WS_WMGU + SZ_WMGU;
constexpr size_t WS_SWIN = WS_WIN + 2 * SZ_WIN - 1 * MiB;
constexpr size_t WS_SDD = WS_WDN + 12 * MiB;
constexpr size_t WS_SDM = WS_WMDN + 120 * MiB;
constexpr size_t WS_SA2 = WS_WMDN + 121 * MiB;
static_assert(SZ_WDN / 2 <= 12 * MiB && SZ_WMDN / 2 <= 120 * MiB && WS_SA2 + (size_t)MAXSLOTS * 4 <= WS_WMDN + SZ_WMDN, "int8 down map");
constexpr size_t WS_WPG8 = WS_WGU + 26 * MiB;
constexpr size_t WS_SPG = WS_WGU + 35 * MiB;
static_assert(WS_WPG8 + 2 * (size_t)DM * DM <= WS_SPG && WS_SPG + 16384 <= WS_WDN, "ple int8 map");
constexpr size_t WS_SWD = WS_WGU + 24 * MiB;
constexpr size_t WS_SWM = WS_WMGU + 236 * MiB;
constexpr size_t WS_HN8 = WS_WMGU + 240 * MiB;
constexpr size_t WS_SA = WS_WMGU + 280 * MiB;
constexpr size_t WS_SSP = WS_WMGU + 284 * MiB;
constexpr size_t WS_RSE = WS_WMGU + 290 * MiB;
constexpr size_t WS_XSC = WS_WMGU + 281 * MiB;
static_assert(SZ_WGU / 2 <= 24 * MiB && SZ_WMGU / 2 <= 236 * MiB && WS_XSC + (size_t)MAXSLOTS * 4 <= WS_WMDN && WS_HN8 + (size_t)T * DM <= WS_SA, "int8 map");
constexpr size_t WS_WPP = WS_WMDN + SZ_WMDN;
constexpr size_t WS_WPG = WS_WPP + 2 * SZ_WPP;
constexpr size_t WS_PB = WS_WPG + 2 * SZ_WPG;
constexpr size_t WS_ROPE = WS_PB + (size_t)2 * T * PLE_DIM * 2;
constexpr size_t WS_HN = WS_ROPE + (size_t)T * 64 * 4;
constexpr size_t WS_MIX = WS_HN + (size_t)T * DM * 2;
constexpr size_t WS_E = WS_MIX + (size_t)T * DM * 2;
constexpr size_t WS_ROUTE = WS_E + (size_t)T * DM * 2;
constexpr size_t WS_R = WS_ROUTE + (size_t)T * 2 * 4 * 3;
constexpr size_t R_U = WS_R;
constexpr size_t R_GQKV = R_U + (size_t)T * D_INP * 2;
constexpr size_t R_GBG = R_GQKV + (size_t)T * 1536 * 2;
constexpr size_t R_XC = R_GBG + (size_t)T * 8 * 4;
constexpr size_t R_DT = R_XC + (size_t)T * 1536 * 2;
constexpr size_t R_QLN = R_DT + (size_t)T * 16 * 4;
constexpr size_t R_KVLN = R_QLN + (size_t)T * MQR * 2;
constexpr size_t R_QRAW = R_KVLN + (size_t)T * MKVR * 2;
constexpr size_t R_KVRAW = R_QRAW + (size_t)T * 768 * 2;
constexpr size_t R_Q = R_KVRAW + (size_t)T * 1024 * 2;
constexpr size_t R_K = R_Q + (size_t)T * 768 * 2;
constexpr int GNU = BATCH * GH * GNC;
constexpr size_t R_GUT = R_K + (size_t)T * 768 * 2;
constexpr size_t R_GW = R_GUT + (size_t)GNU * 8192 * 2;
constexpr size_t R_GQD = R_GW + (size_t)GNU * 8192 * 2;
constexpr size_t R_GKDT = R_GQD + (size_t)GNU * 8192 * 2;
constexpr size_t R_GIN = R_GKDT + (size_t)GNU * 8192 * 2;
constexpr size_t R_GEND = R_GIN + (size_t)GNU * 4096 * 2;
constexpr size_t R_SST = R_GEND + 4096;
constexpr size_t R_SPV = R_SST + (size_t)BATCH * SNC * SH * SP * SN * 4;
constexpr size_t R_SDA = R_SPV + (size_t)BATCH * SNC * SH * SP * SN * 2;
constexpr size_t R_MIXEND = R_SDA + 4096;
constexpr size_t R_ACT = WS_R;
constexpr size_t R_XP = WS_R;
constexpr size_t R_ACTP = R_XP + (size_t)MAXSLOTS * DM * 2;
constexpr size_t R_FFNEND = R_ACTP + (size_t)MAXSLOTS * FFE * 2;
constexpr size_t WS_END = (R_MIXEND > R_FFNEND ? R_MIXEND : R_FFNEND);
static_assert(WS_END < (size_t)1850 * MiB * 1ull && (WS_R % 256) == 0, "d_ws map");

constexpr int CW_TMO = 0;
constexpr int CW_CNT = 64;
constexpr int CW_CUR = 128;
constexpr int CW_TOFF = 192;
constexpr int CW_CMAX = 65536;

constexpr int CW_BAR = 4096;

constexpr int RING_BYTES = 131072;
constexpr int MISC_OFF = RING_BYTES;
constexpr int LDS_BYTES = 147456;

#define XB_TMO      128
#define XB_XCNT(j)  (256  + 64 * (j))
#define XB_XSUB(j)  (1280 + 64 * (j))
#define XB_XGEN(j)  (2304 + 64 * (j))
#define XB_TOP      3328
#define XB_TOPGEN   3392
#define XCD_BAR_WORDS 3456
#define XB_SPIN_CAP (1u << 18)

__device__ __forceinline__ unsigned xb_ld(unsigned* p)              { return __hip_atomic_load(p, __ATOMIC_RELAXED, __HIP_MEMORY_SCOPE_AGENT); }
__device__ __forceinline__ unsigned xb_add(unsigned* p, unsigned v) { return __hip_atomic_fetch_add(p, v, __ATOMIC_RELAXED, __HIP_MEMORY_SCOPE_AGENT); }
__device__ __forceinline__ unsigned xb_xcc_id() { return (unsigned)__builtin_amdgcn_s_getreg((3 << 11) | 20) & 0xFu; }
#define XB_SPIN(cond, bar) do { unsigned _sp = 0; while (cond) { __builtin_amdgcn_s_sleep(1); \
    if ((++_sp & 255u) == 0u) { if (xb_ld(&(bar)[XB_TMO])) break; if (_sp > XB_SPIN_CAP) { atomicAdd(&(bar)[XB_TMO], 1u); break; } } } } while (0)

struct XcdBarrier {
    unsigned* bar; unsigned x;
    volatile LAS unsigned* st;
};
__device__ __forceinline__ XcdBarrier xcd_barrier_post(unsigned* bar, volatile LAS unsigned* st) {
    XcdBarrier b; b.bar = bar; b.x = xb_xcc_id(); b.st = st;
    if (threadIdx.x == 0) (void)xb_add(&bar[XB_XCNT(b.x)], 1u);
    return b;
}
__device__ __forceinline__ void xcd_barrier_complete(unsigned* bar, unsigned x, unsigned& nloc, unsigned& nx) {
    const unsigned G = gridDim.x * gridDim.y * gridDim.z;
    unsigned sum, cnt, mine, sp = 0u;
    for (;;) {
        sum = 0u; cnt = 0u; mine = 0u;
#pragma unroll
        for (unsigned j = 0; j < 16; ++j) { const unsigned c = xb_ld(&bar[XB_XCNT(j)]); sum += c; cnt += (c > 0u) ? 1u : 0u; mine = (j == x) ? c : mine; }
        if (sum == G) break;
        __builtin_amdgcn_s_sleep(1);
        if ((++sp & 255u) == 0u) { if (xb_ld(&bar[XB_TMO])) break; if (sp > XB_SPIN_CAP) { atomicAdd(&bar[XB_TMO], 1u); break; } }
    }
    nloc = mine > 0u ? mine : 1u; nx = cnt > 0u ? cnt : 1u;
}
__device__ __forceinline__ void xcd_barrier(const XcdBarrier& b) {
    asm volatile("s_waitcnt vmcnt(0)" ::: "memory");
    __syncthreads();
    if (threadIdx.x == 0) {
        unsigned* bar = b.bar;
        __builtin_amdgcn_s_waitcnt(0);
        unsigned nloc = b.st[0], nx = b.st[1];
        if (nloc == 0u) { xcd_barrier_complete(bar, b.x, nloc, nx); b.st[0] = nloc; b.st[1] = nx; }
        const unsigned old = xb_add(&bar[XB_XSUB(b.x)], 1u);
        const unsigned gen = old / nloc;
        if (old + 1u == (gen + 1u) * nloc) {
            __builtin_amdgcn_fence(__ATOMIC_RELEASE, "agent");
            asm volatile("s_waitcnt vmcnt(0)" ::: "memory");
            const unsigned og = xb_add(&bar[XB_TOP], 1u);
            const unsigned tg = og / nx;
            if (og + 1u == (tg + 1u) * nx) xb_add(&bar[XB_TOPGEN], 1u);
            else XB_SPIN(xb_ld(&bar[XB_TOPGEN]) == tg, bar);
            __builtin_amdgcn_fence(__ATOMIC_ACQUIRE, "agent");
            xb_add(&bar[XB_XGEN(b.x)], 1u);
            asm volatile("s_waitcnt vmcnt(0)" ::: "memory");
        } else {
            XB_SPIN(xb_ld(&bar[XB_XGEN(b.x)]) == gen, bar);
            __builtin_amdgcn_fence(__ATOMIC_ACQUIRE, "agent");
            asm volatile("s_waitcnt vmcnt(0)" ::: "memory");
        }
    }
    __syncthreads();
}

#define MFMA16(a, b, c) __builtin_amdgcn_mfma_f32_16x16x32_bf16((a), (b), (c), 0, 0, 0)
__device__ __forceinline__ bf16x8 lds_frag(const LAS unsigned char* base, int ldb, int row0, int k0, int lane) {
    return *(const LAS bf16x8*)(base + (row0 + (lane & 15)) * ldb + (k0 + 8 * (lane >> 4)) * 2);
}
__device__ __forceinline__ bf16x8 glb_frag(const bf16* base, int ld, int row0, int k0, int lane) {
    return *(const bf16x8*)(base + (size_t)(row0 + (lane & 15)) * ld + k0 + 8 * (lane >> 4));
}
__device__ __forceinline__ s16x4 tr_rd(const LAS unsigned char* p) { return __builtin_amdgcn_ds_read_tr16_b64_v4i16((LAS s16x4*)p); }
__device__ __forceinline__ bf16x8 lds_frag_tr(const LAS unsigned char* base, int ldb, int k0, int n0, int lane) {
    const int g = lane >> 4, q = (lane & 15) >> 2, p = lane & 3;
    const LAS unsigned char* a = base + (k0 + 8 * g + q) * ldb + (n0 + 4 * p) * 2;
    const s16x4 lo = tr_rd(a), hi = tr_rd(a + 4 * ldb);
    return (bf16x8){lo[0], lo[1], lo[2], lo[3], hi[0], hi[1], hi[2], hi[3]};
}
__device__ __forceinline__ bf16x8 lds_frag_trp(const LAS unsigned char* base, int ldb, int k0, int n0, int lane) {
    const int g = lane >> 4, q = (lane & 15) >> 2, p = lane & 3;
    const LAS unsigned char* a = base + (k0 + 4 * g + q) * ldb + (n0 + 4 * p) * 2;
    const s16x4 lo = tr_rd(a), hi = tr_rd(a + 16 * ldb);
    return (bf16x8){lo[0], lo[1], lo[2], lo[3], hi[0], hi[1], hi[2], hi[3]};
}
__device__ __forceinline__ bf16x8 pack_frag(const f32x4 a, const f32x4 b) {
    u32x4 w; w.x = cvt_pk_bf16(a[0], a[1]); w.y = cvt_pk_bf16(a[2], a[3]); w.z = cvt_pk_bf16(b[0], b[1]); w.w = cvt_pk_bf16(b[2], b[3]);
    return __builtin_bit_cast(bf16x8, w);
}
__device__ __forceinline__ v2u pack4(const f32x4 a) { v2u w; w.x = cvt_pk_bf16(a[0], a[1]); w.y = cvt_pk_bf16(a[2], a[3]); return w; }
__device__ __forceinline__ v2u pack4_mfma(const f32x4 a) { v2u w; w.x = cvt_pk_bf16_cv(a[0], a[1]); w.y = cvt_pk_bf16_cv(a[2], a[3]); return w; }

__device__ __forceinline__ void tr_item(const float* __restrict__ W, int ld, int sc, int k0, bf16* __restrict__ WT, int K, int drow0, LAS float* scr, int lane) {
#pragma unroll 8
    for (int i = 0; i < 32; ++i) { const int kk = 2 * i + (lane >> 5); scr[kk * 33 + (lane & 31)] = sc >= 0 ? W[(size_t)(k0 + kk) * ld + sc] : 0.f; }
    LDS_WAIT(); asm volatile("" ::: "memory");
    const int c = lane & 7;
#pragma unroll
    for (int j = 0; j < 4; ++j) { const int n = (lane >> 3) + 8 * j; const LAS float* s = scr + (8 * c) * 33 + n;
        v4u o; o.x = cvt_pk_bf16(s[0 * 33], s[1 * 33]); o.y = cvt_pk_bf16(s[2 * 33], s[3 * 33]); o.z = cvt_pk_bf16(s[4 * 33], s[5 * 33]); o.w = cvt_pk_bf16(s[6 * 33], s[7 * 33]);
        *(v4u*)(WT + (size_t)(drow0 + n) * K + k0 + 8 * c) = o; }
    LDS_WAIT(); asm volatile("" ::: "memory");
}
__device__ __forceinline__ int win_src(int d) {
    if (d < 2048) return d;
    if (d < 4608) return d + 8;
    if (d < 5312) return d + 24;
    if (d < 5320) return S_GBA + (d - 5312);
    if (d < 5336) return S_SDT + (d - 5320);
    return -1;
}
__device__ __forceinline__ void conv_plain(const float* W, int ld, int K, int ncb, bf16* WT, int it, LAS float* scr, int lane) {
    const int kb = it / ncb, nb = it % ncb; tr_item(W, ld, 32 * nb + (lane & 31), 64 * kb, WT, K, 32 * nb, scr, lane);
}
__device__ __forceinline__ void conv_gu(const float* W, int ld, int K, int ncb, bf16* WT, int s, int it, LAS float* scr, int lane) {
    const int kb = it / ncb, nb = it % ncb; tr_item(W, ld, 32 * nb + (lane & 31), 64 * kb, WT, K, 256 * (nb >> 2) + 128 * s + 32 * (nb & 3), scr, lane);
}
__device__ __forceinline__ void q8_strip(const float* __restrict__ W, int ld, int sc  , signed char* __restrict__ W8, float* __restrict__ sw, int drow0, LAS unsigned char* lds, int lane, int wave) {
    const float* wp = W + (size_t)(256 * wave + (lane >> 5)) * ld + (sc < 0 ? 0 : sc);
    LAS float* scr = (LAS float*)(lds + wave * 16384); LAS float* cm = (LAS float*)(lds + 8448);
    float v[128];
#pragma unroll
    for (int i = 0; i < 128; ++i) v[i] = sc < 0 ? 0.f : wp[(size_t)(2 * i) * ld];
    float mx = 0.f;
#pragma unroll
    for (int i = 0; i < 128; ++i) mx = fmaxf(mx, fabsf(v[i]));
    mx = max32(mx);
    if (lane < 32) cm[wave * 32 + lane] = mx;
    __syncthreads();
#pragma unroll
    for (int w = 0; w < 8; ++w) mx = fmaxf(mx, cm[w * 32 + (lane & 31)]);
    const float inv = mx > 0.f ? 127.0f / mx : 0.f;
    if (wave == 0 && lane < 32) sw[drow0 + lane] = mx > 0.f ? mx * (1.0f / 127.0f) : 1.0f;
#pragma unroll
    for (int c = 0; c < 4; ++c) {
#pragma unroll
        for (int i = 0; i < 32; ++i) scr[(2 * i + (lane >> 5)) * 33 + (lane & 31)] = v[32 * c + i] * inv;
        LDS_WAIT(); asm volatile("" ::: "memory");
        const int n = lane & 31, kh = lane >> 5; unsigned w[8];
#pragma unroll
        for (int q = 0; q < 8; ++q) { unsigned pk = 0u;
#pragma unroll
            for (int b = 0; b < 4; ++b) { int x = (int)rintf(scr[(32 * kh + 4 * q + b) * 33 + n]); x = x > 127 ? 127 : (x < -127 ? -127 : x); pk |= ((unsigned)x & 0xffu) << (8 * b); }
            w[q] = pk; }
        v4u* dst = (v4u*)(W8 + (size_t)(drow0 + n) * DM + 256 * wave + 64 * c + 32 * kh);
        dst[0] = (v4u){w[0], w[1], w[2], w[3]}; dst[1] = (v4u){w[4], w[5], w[6], w[7]};
        LDS_WAIT(); asm volatile("" ::: "memory");
    }
    __syncthreads();
}
__device__ __forceinline__ void down_colmax_item(const float* __restrict__ W, int r0, int c0, unsigned* __restrict__ cmax, int lane) {
    const f32x4* wp = (const f32x4*)(W + (size_t)r0 * DM + c0) + lane;
    f32x4 mx = {0.f, 0.f, 0.f, 0.f};
#pragma unroll 16
    for (int i = 0; i < 256; ++i) { const f32x4 v = wp[(size_t)i * (DM / 4)]; mx[0] = fmaxf(mx[0], fabsf(v[0])); mx[1] = fmaxf(mx[1], fabsf(v[1])); mx[2] = fmaxf(mx[2], fabsf(v[2])); mx[3] = fmaxf(mx[3], fabsf(v[3])); }
#pragma unroll
    for (int i = 0; i < 4; ++i) __hip_atomic_fetch_max(cmax + c0 + 4 * lane + i, __float_as_uint(mx[i]), RLX_AGENT);
}
__device__ __forceinline__ void down_quant_item(const float* __restrict__ W, int K, int ch, int n0, const unsigned* __restrict__ cmax, signed char* __restrict__ W8, float* __restrict__ sw, int drow0,
                                                LAS unsigned char* lds, int lane, int wave) {
    const int r0 = 2048 * ch + 256 * wave;
    LAS float* scr = (LAS float*)(lds + wave * 16384);
    const float mx = __uint_as_float(__hip_atomic_load(cmax + n0 + (lane & 31), RLX_AGENT));
    const float inv = mx > 0.f ? 127.0f / mx : 0.f;
    if (ch == 0 && wave == 0 && lane < 32) sw[drow0 + lane] = mx > 0.f ? mx * (1.0f / 127.0f) : 1.0f;
    if (r0 < K) {
        const float* wp = W + (size_t)(r0 + (lane >> 5)) * DM + n0 + (lane & 31);
        float v[128];
#pragma unroll
        for (int i = 0; i < 128; ++i) v[i] = wp[(size_t)(2 * i) * DM];
#pragma unroll
        for (int c = 0; c < 4; ++c) {
#pragma unroll
            for (int i = 0; i < 32; ++i) scr[(2 * i + (lane >> 5)) * 33 + (lane & 31)] = v[32 * c + i] * inv;
            LDS_WAIT(); asm volatile("" ::: "memory");
            const int n = lane & 31, kh = lane >> 5; unsigned w[8];
#pragma unroll
            for (int q = 0; q < 8; ++q) { unsigned pk = 0u;
#pragma unroll
                for (int b = 0; b < 4; ++b) { int x = (int)rintf(scr[(32 * kh + 4 * q + b) * 33 + n]); x = x > 127 ? 127 : (x < -127 ? -127 : x); pk |= ((unsigned)x & 0xffu) << (8 * b); }
                w[q] = pk; }
            v4u* dst = (v4u*)(W8 + (size_t)(drow0 + n) * K + r0 + 64 * c + 32 * kh);
            dst[0] = (v4u){w[0], w[1], w[2], w[3]}; dst[1] = (v4u){w[4], w[5], w[6], w[7]};
            LDS_WAIT(); asm volatile("" ::: "memory");
        }
    }
}
__device__ __forceinline__ void down_rowq_item(const float* __restrict__ W, int K, int k0, signed char* __restrict__ W8, float* __restrict__ sk, LAS unsigned char* lds, int tid, int lane, int wave) {
    const float MG = 12582912.0f;
#pragma unroll 1
    for (int grp = 0; grp < 2; ++grp) {
        const int r0 = 8 * wave + 4 * grp;
        f32x4 x[4][8];
#pragma unroll
        for (int r = 0; r < 4; ++r)
#pragma unroll
            for (int j = 0; j < 8; ++j) x[r][j] = *(const f32x4*)(W + (size_t)(k0 + r0 + r) * DM + 4 * (lane + 64 * j));
#pragma unroll
        for (int r = 0; r < 4; ++r) { float mx = 0.f;
#pragma unroll
            for (int j = 0; j < 8; ++j) mx = fmaxf(fmaxf(mx, fmaxf(fabsf(x[r][j][0]), fabsf(x[r][j][1]))), fmaxf(fabsf(x[r][j][2]), fabsf(x[r][j][3])));
            mx = fmaxf(mx, shx<1>(mx)); mx = fmaxf(mx, shx<2>(mx)); mx = fmaxf(mx, shx<4>(mx)); mx = fmaxf(mx, shx<8>(mx)); mx = fmaxf(mx, shx<16>(mx)); mx = max32(mx);
            const float inv = mx > 0.f ? 127.0f / mx : 0.f;
            if (lane == 0) sk[k0 + r0 + r] = mx > 0.f ? mx * (1.0f / 127.0f) : 1.0f;
            LAS unsigned* row = (LAS unsigned*)(lds + (r0 + r) * 2048) + lane;
#pragma unroll
            for (int j = 0; j < 8; ++j) {
                const unsigned y0 = __float_as_uint(fmaf(x[r][j][0], inv, MG)), y1 = __float_as_uint(fmaf(x[r][j][1], inv, MG)), y2 = __float_as_uint(fmaf(x[r][j][2], inv, MG)), y3 = __float_as_uint(fmaf(x[r][j][3], inv, MG));
                const unsigned lo = __builtin_amdgcn_perm(y1, y0, 0x0c0c0400u), hi = __builtin_amdgcn_perm(y3, y2, 0x0c0c0400u);
                row[64 * j] = __builtin_amdgcn_perm(hi, lo, 0x05040100u); } }
    }
    __syncthreads();
    const LAS unsigned* col = (const LAS unsigned*)lds + tid;
    signed char* o = W8 + (size_t)(4 * tid) * K + k0;
#pragma unroll
    for (int kq = 0; kq < 4; ++kq) { unsigned oc[4][4];
#pragma unroll
        for (int b = 0; b < 4; ++b) { const int kr = 16 * kq + 4 * b;
            const unsigned d0 = col[(kr + 0) * 512], d1 = col[(kr + 1) * 512], d2 = col[(kr + 2) * 512], d3 = col[(kr + 3) * 512];
            const unsigned t01l = __builtin_amdgcn_perm(d1, d0, 0x05010400u), t01h = __builtin_amdgcn_perm(d1, d0, 0x07030602u);
            const unsigned t23l = __builtin_amdgcn_perm(d3, d2, 0x05010400u), t23h = __builtin_amdgcn_perm(d3, d2, 0x07030602u);
            oc[0][b] = __builtin_amdgcn_perm(t23l, t01l, 0x05040100u); oc[1][b] = __builtin_amdgcn_perm(t23l, t01l, 0x07060302u);
            oc[2][b] = __builtin_amdgcn_perm(t23h, t01h, 0x05040100u); oc[3][b] = __builtin_amdgcn_perm(t23h, t01h, 0x07060302u); }
#pragma unroll
        for (int c = 0; c < 4; ++c) *(v4u*)(o + (size_t)c * K + 16 * kq) = (v4u){oc[c][0], oc[c][1], oc[c][2], oc[c][3]}; }
    __syncthreads();
}
constexpr size_t WS_SKG = WS_WGU + 36 * MiB;
constexpr size_t WS_SKD = WS_WDN + 13 * MiB;
constexpr size_t WS_SKM = WS_WMDN + 122 * MiB;
constexpr int DQ_DENSE = FF0 / 64, DQ_EXP = FFE / 64, DQ_TOTAL = DQ_DENSE + NEXP * DQ_EXP;
__device__ __forceinline__ void down_quant_phase(const float* wd, const float* wmd, unsigned char* ws, LAS unsigned char* lds, int first, int stride, int lane, int wave) {
    const int tid = wave * 64 + lane;
    for (int it = first; it < DQ_TOTAL; it += stride) {
        if (it < DQ_DENSE) down_rowq_item(wd, FF0, 64 * it, (signed char*)(ws + WS_WDN), (float*)(ws + WS_SKD), lds, tid, lane, wave);
        else { const int r = it - DQ_DENSE, e = r / DQ_EXP, q = r % DQ_EXP;
            down_rowq_item(wmd + (size_t)e * FFE * DM, FFE, 64 * q, (signed char*)(ws + WS_WMDN) + (size_t)e * DM * FFE, (float*)(ws + WS_SKM) + (size_t)e * FFE, lds, tid, lane, wave); }
    }
}
__device__ __forceinline__ void scale_fold(int L, unsigned char* ws, int gtid, int NGT) {
    if (L == 0) { float* sw = (float*)(ws + WS_SWD); const float* sk = (const float*)(ws + WS_SKD); float* sd = (float*)(ws + WS_SDD);
        for (int k = gtid; k < FF0; k += NGT) sw[256 * (k >> 7) + 128 + (k & 127)] *= sk[k];
        for (int n = gtid; n < DM; n += NGT) { sd[n] = 1.0f; ((float*)(ws + WS_SPG))[n] = 1.0f; } }
    else { float* swm = (float*)(ws + WS_SWM); const float* sk = (const float*)(ws + WS_SKM); float* sd = (float*)(ws + WS_SDM);
        for (int i = gtid; i < NEXP * FFE; i += NGT) { const int e = i / FFE, k = i - e * FFE; swm[(size_t)e * 2 * FFE + 256 * (k >> 7) + 128 + (k & 127)] *= sk[i]; }
        for (int n = gtid; n < NEXP * DM; n += NGT) sd[n] = 1.0f;
        for (int n = gtid; n < DM; n += NGT) ((float*)(ws + WS_SPG))[DM + n] = 1.0f; }
}
struct In { const float* p[33]; };
typedef const In __attribute__((address_space(4)))* InP;
constexpr int IT_WIN = 0, IT_WOUT = 32 * 64, IT_WQB = 6 * 24, IT_WKVB = 4 * 32, IT_WPP = 4 * 64, IT_WPG = 32 * 64;
constexpr int IT_LAYER = IT_WIN + IT_WOUT + IT_WQB + IT_WKVB + IT_WPP + IT_WPG;
constexpr int IT_FD = 0, IT_DENSE = 0;
constexpr int IT_MD = 0, IT_EXP = 0;
constexpr int ST_WIN = 2 * 168, ST_DENSE = 2 * 176, ST_EXP = 2 * 224, ST_TOTAL = ST_WIN + ST_DENSE + NEXP * ST_EXP;
constexpr int IT_TOTAL = 2 * IT_LAYER + IT_DENSE + NEXP * IT_EXP;
__device__ __forceinline__ void moe_gu_quant_phase(InP in, unsigned char* ws, LAS unsigned char* lds, int lo, int hi, int first, int stride, int lane, int wave) {
    for (int st = lo + first; st < hi; st += stride) { int r = st;
        if (r >= NEXP * ST_EXP) { const int q = r - NEXP * ST_EXP, Lg = q >> 6, nb = q & 63;
            if (nb < 32) down_rowq_item(in->p[31] + (size_t)Lg * DM * DM, DM, 64 * nb, (signed char*)(ws + WS_WPG8) + (size_t)Lg * DM * DM, (float*)(ws + WS_SKG) + Lg * DM, lds, wave * 64 + lane, lane, wave);
            continue; }
        { const int e = r / ST_EXP; r -= e * ST_EXP; const int s = r / 224, nb = r % 224;
          q8_strip(in->p[27 + s] + (size_t)e * DM * FFE, FFE, 32 * nb + (lane & 31), (signed char*)(ws + WS_WMGU) + (size_t)e * 2 * FFE * DM, (float*)(ws + WS_SWM) + (size_t)e * 2 * FFE,
                   256 * (nb >> 2) + 128 * s + 32 * (nb & 3), lds, lane, wave); }
    }
}
__device__ __forceinline__ void prologue_phase(InP in, unsigned char* ws, LAS unsigned char* lds, int gw, int NGW, int wave, int lane, int gtid, int NGT, int bid, int G) {
    LAS float* scr = (LAS float*)(lds + wave * 16384);
    for (int it = gw; it < IT_TOTAL; it += NGW) {
        int r = it;
        if (r < 2 * IT_LAYER) {
            const int L = r / IT_LAYER; r -= L * IT_LAYER;
            if (r < IT_WOUT) { conv_plain(in->p[5] + (size_t)L * DM * DM, DM, DM, 64, (bf16*)(ws + WS_WOUT + L * SZ_WOUT), r, scr, lane); continue; }
            r -= IT_WOUT;
            if (r < IT_WQB) { conv_plain(in->p[17] + (size_t)L * MQR * 768, 768, MQR, 24, (bf16*)(ws + WS_WQB + L * SZ_WQB), r, scr, lane); continue; }
            r -= IT_WQB;
            if (r < IT_WKVB) { conv_plain(in->p[19] + (size_t)L * MKVR * 1024, 1024, MKVR, 32, (bf16*)(ws + WS_WKVB + L * SZ_WKVB), r, scr, lane); continue; }
            r -= IT_WKVB;
            if (r < IT_WPP) { conv_plain(in->p[30] + (size_t)L * PLE_DIM * DM, DM, PLE_DIM, 64, (bf16*)(ws + WS_WPP + L * SZ_WPP), r, scr, lane); continue; }
            r -= IT_WPP;
            continue;
        }
        r -= 2 * IT_LAYER;
        if (r < IT_DENSE) {
            continue;
        }
        r -= IT_DENSE;
        { }
    }
    for (int st = bid; st < ST_WIN + ST_DENSE; st += G) {
        int r = st;
        if (r < ST_WIN) { const int L = r / 168, nb = r % 168;
            q8_strip(in->p[4] + (size_t)L * DM * D_IN, D_IN, win_src(32 * nb + (lane & 31)), (signed char*)(ws + WS_WIN) + (size_t)L * (SZ_WIN / 2), (float*)(ws + WS_SWIN) + L * D_INP, 32 * nb, lds, lane, wave); continue; }
        r -= ST_WIN;
        if (r < ST_DENSE) { const int s = r / 176, nb = r % 176;
            q8_strip(in->p[23 + s], FF0, 32 * nb + (lane & 31), (signed char*)(ws + WS_WGU), (float*)(ws + WS_SWD), 256 * (nb >> 2) + 128 * s + 32 * (nb & 3), lds, lane, wave); continue; }
    }
    { const float* p = in->p[1]; bf16* pb = (bf16*)(ws + WS_PB);
      for (size_t i = (size_t)gtid * 8; i < (size_t)2 * T * PLE_DIM; i += (size_t)NGT * 8) {
          const f32x4 a = *(const f32x4*)(p + i), b = *(const f32x4*)(p + i + 4);
          v4u o; o.x = cvt_pk_bf16(a[0], a[1]); o.y = cvt_pk_bf16(a[2], a[3]); o.z = cvt_pk_bf16(b[0], b[1]); o.w = cvt_pk_bf16(b[2], b[3]);
          *(v4u*)(pb + i) = o; } }
    { const int* pos = (const int*)in->p[2]; float* rt = (float*)(ws + WS_ROPE);
      for (int i = gtid; i < T * 32; i += NGT) { const int m = i >> 5, k = i & 31;
          const float inv = 1.0f / powf(10000.0f, (float)k * (1.0f / 32.0f)); const float ang = (float)pos[m] * inv;
          float s, c; sincosf(ang, &s, &c); rt[m * 64 + k] = c; rt[m * 64 + 32 + k] = s; } }
}

template <bool ROUTE, bool OUT8>
__device__ __forceinline__ void rms_phase(const float* __restrict__ h, const float* __restrict__ g, bf16* __restrict__ hn, signed char* __restrict__ hn8, float* __restrict__ sa, const float* __restrict__ Wr,
                                          int* tok_e, float* tok_w, unsigned* cnt, LAS unsigned char* lds, int gw, int NGW, int lane, int tid) {
    LAS float* wr = (LAS float*)lds;
    LAS unsigned* lcnt = (LAS unsigned*)(lds + 65536);
    if (ROUTE) {
        for (int i = tid; i < DM * 8 / 4; i += NTHR) ((LAS f32x4*)wr)[i] = ((const f32x4*)Wr)[i];
        if (tid < 8) lcnt[tid] = 0u;
        __syncthreads();
    }
    f32x4 gv[8];
#pragma unroll
    for (int j = 0; j < 8; ++j) gv[j] = ((const f32x4*)g)[lane + 64 * j];
    for (int m = gw; m < T; m += NGW) {
        const f32x4* xr = (const f32x4*)(h + (size_t)m * DM) + lane;
        f32x4 v[8]; float s = 0.f;
#pragma unroll
        for (int j = 0; j < 8; ++j) { v[j] = xr[64 * j]; s += (v[j].x * v[j].x + v[j].y * v[j].y) + (v[j].z * v[j].z + v[j].w * v[j].w); }
        const float rs = rsqrtf(wave_sum(s) * (1.0f / DM) + EPS);
#pragma unroll
        for (int j = 0; j < 8; ++j) v[j] = v[j] * rs * gv[j];
        if (OUT8) {
            float mx = 0.f;
#pragma unroll
            for (int j = 0; j < 8; ++j) mx = fmaxf(fmaxf(mx, fmaxf(fabsf(v[j].x), fabsf(v[j].y))), fmaxf(fabsf(v[j].z), fabsf(v[j].w)));
            mx = fmaxf(mx, shx<1>(mx)); mx = fmaxf(mx, shx<2>(mx)); mx = fmaxf(mx, shx<4>(mx)); mx = fmaxf(mx, shx<8>(mx)); mx = fmaxf(mx, shx<16>(mx)); mx = max32(mx);
            const float inv = mx > 0.f ? 127.0f / mx : 0.f;
            unsigned* o4 = (unsigned*)(hn8 + (size_t)m * DM) + lane;
#pragma unroll
            for (int j = 0; j < 8; ++j) { const int a = (int)rintf(v[j].x * inv), b = (int)rintf(v[j].y * inv), c = (int)rintf(v[j].z * inv), d = (int)rintf(v[j].w * inv);
                o4[64 * j] = ((unsigned)a & 0xffu) | (((unsigned)b & 0xffu) << 8) | (((unsigned)c & 0xffu) << 16) | (((unsigned)d & 0xffu) << 24); }
            if (lane == 0) sa[m] = mx > 0.f ? mx * (1.0f / 127.0f) : 1.0f;
        } else {
            v2u* o8 = (v2u*)(hn + (size_t)m * DM) + lane;
#pragma unroll
            for (int j = 0; j < 8; ++j) o8[64 * j] = pack4(v[j]);
        }
        if (ROUTE) {
            float lg[8];
#pragma unroll
            for (int e = 0; e < 8; ++e) lg[e] = 0.f;
#pragma unroll
            for (int j = 0; j < 8; ++j)
#pragma unroll
                for (int i = 0; i < 4; ++i) { const int k = 256 * j + 4 * lane + i; const f32x4 w0 = *(const LAS f32x4*)(wr + k * 8), w1 = *(const LAS f32x4*)(wr + k * 8 + 4); const float x = v[j][i];
                    lg[0] += x * w0[0]; lg[1] += x * w0[1]; lg[2] += x * w0[2]; lg[3] += x * w0[3]; lg[4] += x * w1[0]; lg[5] += x * w1[1]; lg[6] += x * w1[2]; lg[7] += x * w1[3]; }
#pragma unroll
            for (int e = 0; e < 8; ++e) lg[e] = wave_sum(lg[e]);
            if (lane == 0) {
                int e1 = 0; float v1 = lg[0];
#pragma unroll
                for (int e = 1; e < 8; ++e) if (lg[e] > v1) { v1 = lg[e]; e1 = e; }
                int e2 = -1; float v2 = -3.0e38f;
#pragma unroll
                for (int e = 0; e < 8; ++e) if (e != e1 && lg[e] > v2) { v2 = lg[e]; e2 = e; }
                const float w1 = 1.0f / (1.0f + __expf(v2 - v1));
                tok_e[2 * m] = e1; tok_e[2 * m + 1] = e2; tok_w[2 * m] = w1; tok_w[2 * m + 1] = 1.0f - w1;
                __hip_atomic_fetch_add(&lcnt[e1], 1u, __ATOMIC_RELAXED, __HIP_MEMORY_SCOPE_WORKGROUP); __hip_atomic_fetch_add(&lcnt[e2], 1u, __ATOMIC_RELAXED, __HIP_MEMORY_SCOPE_WORKGROUP);
            }
        }
    }
    if (ROUTE) { __syncthreads(); if (tid < 8) { const unsigned c = lcnt[tid]; if (c) __hip_atomic_fetch_add(cnt + tid, c, RLX_AGENT); } }
}

__device__ __forceinline__ void conv_phase(InP in, int L, unsigned char* ws, int gw, int NGW, int lane) {
    const bf16* u = (const bf16*)(ws + R_U);
    bf16* gqkv = (bf16*)(ws + R_GQKV); float* gbg = (float*)(ws + R_GBG); bf16* xc = (bf16*)(ws + R_XC); float* dtb = (float*)(ws + R_DT);
    bf16* qln = (bf16*)(ws + R_QLN); bf16* kvln = (bf16*)(ws + R_KVLN);
    const int per = (T + NGW - 1) / NGW, ma = gw * per, mb = (ma + per < T) ? ma + per : T;
    if (ma >= T) return;
    const float* cw = in->p[6] + (size_t)L * 1536 * 4;
    for (int hd = 0; hd < GH; ++hd) {
        f32x4 w[3][2];
#pragma unroll
        for (int t3 = 0; t3 < 3; ++t3)
#pragma unroll
            for (int i = 0; i < 2; ++i) w[t3][i] = *(const f32x4*)(cw + (size_t)(t3 * 512 + hd * 128 + 2 * lane + i) * 4);
        unsigned x0[3], x1[3], x2[3];
#pragma unroll
        for (int t3 = 0; t3 < 3; ++t3) {
            const int col = t3 * 512 + hd * 128 + 2 * lane;
            const int s0 = (ma % SEQ);
            x0[t3] = (s0 >= 3) ? *(const unsigned*)(u + (size_t)(ma - 3) * D_INP + col) : 0u;
            x1[t3] = (s0 >= 2) ? *(const unsigned*)(u + (size_t)(ma - 2) * D_INP + col) : 0u;
            x2[t3] = (s0 >= 1) ? *(const unsigned*)(u + (size_t)(ma - 1) * D_INP + col) : 0u;
        }
        for (int m = ma; m < mb; ++m) {
            if ((m % SEQ) == 0) {
#pragma unroll
                for (int t3 = 0; t3 < 3; ++t3) { x0[t3] = 0u; x1[t3] = 0u; x2[t3] = 0u; }
            }
            float y[3][2];
#pragma unroll
            for (int t3 = 0; t3 < 3; ++t3) {
                const unsigned x3 = *(const unsigned*)(u + (size_t)m * D_INP + t3 * 512 + hd * 128 + 2 * lane);
                const float a = w[t3][0][0] * bflo(x0[t3]) + w[t3][0][1] * bflo(x1[t3]) + w[t3][0][2] * bflo(x2[t3]) + w[t3][0][3] * bflo(x3);
                const float b = w[t3][1][0] * bfhi(x0[t3]) + w[t3][1][1] * bfhi(x1[t3]) + w[t3][1][2] * bfhi(x2[t3]) + w[t3][1][3] * bfhi(x3);
                y[t3][0] = siluf_(a); y[t3][1] = siluf_(b);
                x0[t3] = x1[t3]; x1[t3] = x2[t3]; x2[t3] = x3;
            }
            const float sq = wave_sum(y[0][0] * y[0][0] + y[0][1] * y[0][1]), sk = wave_sum(y[1][0] * y[1][0] + y[1][1] * y[1][1]);
            const float rq = rsqrtf(sq + EPS) * 0.08838834764831845f, rk = rsqrtf(sk + EPS);
            bf16* o = gqkv + (size_t)m * 1536 + hd * 128 + 2 * lane;
            *(unsigned*)(o) = cvt_pk_bf16(y[0][0] * rq, y[0][1] * rq);
            *(unsigned*)(o + 512) = cvt_pk_bf16(y[1][0] * rk, y[1][1] * rk);
            *(unsigned*)(o + 1024) = cvt_pk_bf16(y[2][0], y[2][1]);
        }
    }
    {
        const float alog = (lane < 4) ? in->p[7][L * GH + lane] : 0.f, dtbias = (lane < 4) ? in->p[8][L * GH + lane] : 0.f;
        const float sdtb = (lane < 16) ? in->p[13][L * SH + lane] : 0.f;
        for (int m = ma; m < mb; ++m) {
            if (lane < 4) {
                const float bb = bf2f(u[(size_t)m * D_INP + U_GB + lane]), aa = bf2f(u[(size_t)m * D_INP + U_GA + lane]);
                gbg[(size_t)m * 8 + lane] = sigmoidf_(bb);
                gbg[(size_t)m * 8 + 4 + lane] = -__expf(alog) * softplusf_(aa + dtbias);
            }
            if (lane < 16) dtb[(size_t)m * 16 + lane] = softplusf_(bf2f(u[(size_t)m * D_INP + U_SDT + lane]) + sdtb);
        }
    }
    {
        const float* sw = in->p[10] + (size_t)L * SCONV * 4; const float* sb = in->p[11] + (size_t)L * SCONV;
        for (int ch = 0; ch < 3; ++ch) {
            const int c0 = ch * 512 + 8 * lane;
            f32x4 w[8]; float bias[8];
#pragma unroll
            for (int i = 0; i < 8; ++i) { w[i] = *(const f32x4*)(sw + (size_t)(c0 + i) * 4); bias[i] = sb[c0 + i]; }
            v4u x0, x1, x2; const v4u z4 = {0u, 0u, 0u, 0u};
            { const int s0 = (ma % SEQ);
              x0 = (s0 >= 3) ? *(const v4u*)(u + (size_t)(ma - 3) * D_INP + U_SX + c0) : z4;
              x1 = (s0 >= 2) ? *(const v4u*)(u + (size_t)(ma - 2) * D_INP + U_SX + c0) : z4;
              x2 = (s0 >= 1) ? *(const v4u*)(u + (size_t)(ma - 1) * D_INP + U_SX + c0) : z4; }
            for (int m = ma; m < mb; ++m) {
                if ((m % SEQ) == 0) { x0 = z4; x1 = z4; x2 = z4; }
                const v4u x3 = *(const v4u*)(u + (size_t)m * D_INP + U_SX + c0);
                float y[8];
#pragma unroll
                for (int i = 0; i < 4; ++i) {
                    const float a = w[2 * i][0] * bflo(x0[i]) + w[2 * i][1] * bflo(x1[i]) + w[2 * i][2] * bflo(x2[i]) + w[2 * i][3] * bflo(x3[i]) + bias[2 * i];
                    const float b = w[2 * i + 1][0] * bfhi(x0[i]) + w[2 * i + 1][1] * bfhi(x1[i]) + w[2 * i + 1][2] * bfhi(x2[i]) + w[2 * i + 1][3] * bfhi(x3[i]) + bias[2 * i + 1];
                    y[2 * i] = siluf_(a); y[2 * i + 1] = siluf_(b);
                }
                v4u o; o.x = cvt_pk_bf16(y[0], y[1]); o.y = cvt_pk_bf16(y[2], y[3]); o.z = cvt_pk_bf16(y[4], y[5]); o.w = cvt_pk_bf16(y[6], y[7]);
                *(v4u*)(xc + (size_t)m * SCONV + c0) = o;
                x0 = x1; x1 = x2; x2 = x3;
            }
        }
    }
    {
        const float* qg = in->p[16] + (size_t)L * MQR; const float* kg = in->p[18] + (size_t)L * MKVR;
        float gq[8], gk[4];
#pragma unroll
        for (int i = 0; i < 8; ++i) gq[i] = (lane < 48) ? qg[8 * lane + i] : 0.f;
#pragma unroll
        for (int i = 0; i < 4; ++i) gk[i] = kg[4 * lane + i];
        const v4u z4 = {0u, 0u, 0u, 0u};
        for (int m = ma; m < mb; ++m) {
            const v4u qv = (lane < 48) ? *(const v4u*)(u + (size_t)m * D_INP + U_MQ + 8 * lane) : z4;
            const v2u kv = *(const v2u*)(u + (size_t)m * D_INP + U_MKV + 4 * lane);
            float q[8], k[4];
#pragma unroll
            for (int i = 0; i < 4; ++i) { q[2 * i] = bflo(qv[i]); q[2 * i + 1] = bfhi(qv[i]); }
            k[0] = bflo(kv.x); k[1] = bfhi(kv.x); k[2] = bflo(kv.y); k[3] = bfhi(kv.y);
            float sq = 0.f, sk = 0.f;
#pragma unroll
            for (int i = 0; i < 8; ++i) sq += q[i] * q[i];
#pragma unroll
            for (int i = 0; i < 4; ++i) sk += k[i] * k[i];
            const float rq = rsqrtf(wave_sum(sq) * (1.0f / MQR) + EPS), rk = rsqrtf(wave_sum(sk) * (1.0f / MKVR) + EPS);
            if (lane < 48) { v4u o; o.x = cvt_pk_bf16(q[0] * rq * gq[0], q[1] * rq * gq[1]); o.y = cvt_pk_bf16(q[2] * rq * gq[2], q[3] * rq * gq[3]);
                o.z = cvt_pk_bf16(q[4] * rq * gq[4], q[5] * rq * gq[5]); o.w = cvt_pk_bf16(q[6] * rq * gq[6], q[7] * rq * gq[7]);
                *(v4u*)(qln + (size_t)m * MQR + 8 * lane) = o; }
            { v2u o; o.x = cvt_pk_bf16(k[0] * rk * gk[0], k[1] * rk * gk[1]); o.y = cvt_pk_bf16(k[2] * rk * gk[2], k[3] * rk * gk[3]);
              *(v2u*)(kvln + (size_t)m * MKVR + 4 * lane) = o; }
        }
    }
}

__device__ __forceinline__ void mlaprep_phase(InP in, int L, unsigned char* ws, int gw, int NGW, int lane) {
    const bf16* qraw = (const bf16*)(ws + R_QRAW); const bf16* kvraw = (const bf16*)(ws + R_KVRAW); const bf16* u = (const bf16*)(ws + R_U);
    bf16* Q = (bf16*)(ws + R_Q); bf16* K = (bf16*)(ws + R_K); const float* rope = (const float*)(ws + WS_ROPE);
    const float* qg = in->p[20] + (size_t)L * MQK; const float* kg = in->p[21] + (size_t)L * MQK;
    const float qg0 = qg[lane], qg1 = qg[64 + lane], qg2 = qg[128 + lane], kg0 = kg[lane], kg1 = kg[64 + lane], kg2 = kg[128 + lane];
    constexpr float QS = 0.07216878364870323f * 1.4426950408889634f;
    for (int m = gw; m < T; m += NGW) {
        const float cs = rope[(size_t)m * 64 + (lane & 31)], sn = rope[(size_t)m * 64 + 32 + (lane & 31)];
        const float kpe = bf2f(u[(size_t)m * D_INP + U_MPE + lane]);
        for (int hd = 0; hd < MH; ++hd) {
            {   const bf16* qr = qraw + (size_t)m * 768 + hd * MQK;
                float a = bf2f(qr[lane]), b = bf2f(qr[64 + lane]), c = bf2f(qr[128 + lane]);
                const float rs = rsqrtf(wave_sum(a * a + b * b + c * c) * (1.0f / MQK) + EPS);
                a *= rs * qg0; b *= rs * qg1; c *= rs * qg2;
                const float pc = other32(c, lane);
                const float cr = (lane < 32) ? (c * cs - pc * sn) : (c * cs + pc * sn);
                bf16* o = Q + (size_t)m * 768 + hd * MQK;
                o[lane] = f2bf(a * QS); o[64 + lane] = f2bf(b * QS); o[128 + lane] = f2bf(cr * QS); }
            {   const bf16* kr = kvraw + (size_t)m * 1024 + hd * 256;
                float a = bf2f(kr[lane]), b = bf2f(kr[64 + lane]), c = kpe;
                const float rs = rsqrtf(wave_sum(a * a + b * b + c * c) * (1.0f / MQK) + EPS);
                a *= rs * kg0; b *= rs * kg1; c *= rs * kg2;
                const float pc = other32(c, lane);
                const float cr = (lane < 32) ? (c * cs - pc * sn) : (c * cs + pc * sn);
                bf16* o = K + (size_t)m * 768 + hd * MQK;
                o[lane] = f2bf(a); o[64 + lane] = f2bf(b); o[128 + lane] = f2bf(cr); }
        }
    }
}

__device__ __forceinline__ void moe_tile_prefix(const unsigned* cnt, int (&toff)[9]) {
    int acc = 0; toff[0] = 0;
#pragma unroll
    for (int e = 0; e < 8; ++e) { const int c = __builtin_amdgcn_readfirstlane((int)__hip_atomic_load(cnt + e, RLX_AGENT)); acc += (c + 255) >> 8; toff[e + 1] = acc; }
}
__device__ __forceinline__ void moe_permute_phase(unsigned char* ws, unsigned* ctl, LAS unsigned char* lds, int bid, int G, int tid, int lane, int wave) {
    const int* tok_e = (const int*)(ws + WS_ROUTE); int* slot = (int*)(ws + WS_ROUTE + (size_t)T * 16);
    const signed char* hn8 = (const signed char*)(ws + WS_HN8); signed char* xp8 = (signed char*)(ws + R_XP); const float* sa = (const float*)(ws + WS_SA); float* xsc = (float*)(ws + WS_XSC);
    LAS int* sl = (LAS int*)lds;
    int toff[9]; moe_tile_prefix(ctl + CW_CNT, toff);
    for (int blk = bid; blk < T / 64; blk += G) {
        if (wave == 0) {
            const int t = 64 * blk + lane; const int e1 = tok_e[2 * t], e2 = tok_e[2 * t + 1]; int s1 = 0, s2 = 0;
#pragma unroll
            for (int e = 0; e < 8; ++e) {
                const bool is1 = (e1 == e), is2 = (e2 == e);
                const unsigned long long mask = __ballot(is1 || is2);
                const int n = __popcll(mask);
                unsigned base = 0u;
                if (lane == 0 && n) base = __hip_atomic_fetch_add(ctl + CW_CUR + e, (unsigned)n, RLX_AGENT);
                base = (unsigned)__builtin_amdgcn_readfirstlane((int)base);
                const int rank = __popcll(mask & ((1ull << lane) - 1ull));
                const int s = toff[e] * 256 + (int)base + rank;
                if (is1) s1 = s; if (is2) s2 = s;
            }
            slot[2 * t] = s1; slot[2 * t + 1] = s2; sl[2 * lane] = s1; sl[2 * lane + 1] = s2;
        }
        __syncthreads();
#pragma unroll 4
        for (int i = 0; i < 16; ++i) { const int r = wave * 16 + i; const int t = 64 * blk + (r >> 1); const int s = sl[r];
            const v4u* src = (const v4u*)(hn8 + (size_t)t * DM) + lane; v4u* dst = (v4u*)(xp8 + (size_t)s * DM) + lane;
#pragma unroll
            for (int j = 0; j < 2; ++j) dst[64 * j] = src[64 * j];
            if (lane == 0) xsc[s] = sa[t]; }
        __syncthreads();
    }
}
__device__ __forceinline__ void moe_combine_phase(unsigned char* ws, float* h, const float* __restrict__ sk, int gw, int NGW, int lane) {
    f32x4 kk[8];
#pragma unroll
    for (int j = 0; j < 8; ++j) kk[j] = ((const f32x4*)sk)[lane + 64 * j];
    const float* tok_w = (const float*)(ws + WS_ROUTE + (size_t)T * 8); const int* slot = (const int*)(ws + WS_ROUTE + (size_t)T * 16);
    const bf16* yp = (const bf16*)(ws + R_XP); signed char* h8 = (signed char*)(ws + WS_HN8); float* sa8 = (float*)(ws + WS_SA);
    for (int m = gw; m < T; m += NGW) {
        const int s0 = __hip_atomic_load(slot + 2 * m, RLX_AGENT), s1 = __hip_atomic_load(slot + 2 * m + 1, RLX_AGENT);
        const float w0 = __hip_atomic_load(tok_w + 2 * m, RLX_AGENT), w1 = __hip_atomic_load(tok_w + 2 * m + 1, RLX_AGENT);
        f32x4* hr = (f32x4*)(h + (size_t)m * DM) + lane; const v2u* y0 = (const v2u*)(yp + (size_t)s0 * DM) + lane; const v2u* y1 = (const v2u*)(yp + (size_t)s1 * DM) + lane;
        f32x4 v[8]; float mx = 0.f;
#pragma unroll
        for (int j = 0; j < 8; ++j) { v[j] = hr[64 * j]; const v2u a = y0[64 * j], b = y1[64 * j];
            v[j][0] += w0 * bflo(a.x) + w1 * bflo(b.x); v[j][1] += w0 * bfhi(a.x) + w1 * bfhi(b.x); v[j][2] += w0 * bflo(a.y) + w1 * bflo(b.y); v[j][3] += w0 * bfhi(a.y) + w1 * bfhi(b.y);
            hr[64 * j] = v[j]; v[j] = v[j] * kk[j]; mx = fmaxf(fmaxf(mx, fmaxf(fabsf(v[j][0]), fabsf(v[j][1]))), fmaxf(fabsf(v[j][2]), fabsf(v[j][3]))); }
        mx = fmaxf(mx, shx<1>(mx)); mx = fmaxf(mx, shx<2>(mx)); mx = fmaxf(mx, shx<4>(mx)); mx = fmaxf(mx, shx<8>(mx)); mx = fmaxf(mx, shx<16>(mx)); mx = max32(mx);
        const float inv = mx > 0.f ? 127.0f / mx : 0.f;
        unsigned* o4 = (unsigned*)(h8 + (size_t)m * DM) + lane;
#pragma unroll
        for (int j = 0; j < 8; ++j) { const int a = (int)rintf(v[j][0] * inv), b = (int)rintf(v[j][1] * inv), c = (int)rintf(v[j][2] * inv), d = (int)rintf(v[j][3] * inv);
            o4[64 * j] = ((unsigned)a & 0xffu) | (((unsigned)b & 0xffu) << 8) | (((unsigned)c & 0xffu) << 16) | (((unsigned)d & 0xffu) << 24); }
        if (lane == 0) sa8[m] = mx > 0.f ? mx * (1.0f / 127.0f) : 1.0f;
    }
}
__device__ __forceinline__ void ssd_scan_phase(unsigned char* ws, int gtid, int NGT) {
    const float* st = (const float*)(ws + R_SST); bf16* pv = (bf16*)(ws + R_SPV); const float* dA = (const float*)(ws + R_SDA);
    for (int i = gtid; i < BATCH * SH * SP * SN; i += NGT) {
        const int pn = i % (SP * SN), bh = i / (SP * SN), hd = bh % SH, b = bh / SH;
        float hs = 0.f;
#pragma unroll 4
        for (int c = 0; c < SNC; ++c) { const size_t idx = ((size_t)((b * SNC + c) * SH + hd)) * (SP * SN) + pn;
            pv[idx] = f2bf(hs); hs = hs * dA[(b * SNC + c) * SH + hd] + st[idx]; }
    }
}

template <int F> __device__ __forceinline__ void act_quant_phase(unsigned char* act, float* sa, int nrows, int gw, int NGW, int lane) {
    constexpr int NV = F / 8 / 64;
    static_assert(F % 512 == 0, "row chunks");
    for (int r = gw; r < nrows; r += NGW) {
        v4u* row = (v4u*)(act + (size_t)r * F * 2);
        v4u x[NV]; float mx = 0.f;
#pragma unroll
        for (int j = 0; j < NV; ++j) { x[j] = row[lane + 64 * j];
#pragma unroll
            for (int i = 0; i < 4; ++i) mx = fmaxf(mx, fmaxf(fabsf(bflo(x[j][i])), fabsf(bfhi(x[j][i])))); }
        mx = fmaxf(mx, shx<1>(mx)); mx = fmaxf(mx, shx<2>(mx)); mx = fmaxf(mx, shx<4>(mx)); mx = fmaxf(mx, shx<8>(mx)); mx = fmaxf(mx, shx<16>(mx)); mx = max32(mx);
        const float inv = (mx > 0.f && mx < 3.0e38f) ? 127.0f / mx : 0.f;
        asm volatile("s_waitcnt vmcnt(0)" ::: "memory");
        v2u* orow = (v2u*)(act + (size_t)r * F * 2);
#pragma unroll
        for (int j = 0; j < NV; ++j) { unsigned w0 = 0u, w1 = 0u;
#pragma unroll
            for (int i = 0; i < 2; ++i) { const int a = (int)rintf(bflo(x[j][i]) * inv), b = (int)rintf(bfhi(x[j][i]) * inv); w0 |= (((unsigned)a & 0xffu) | (((unsigned)b & 0xffu) << 8)) << (16 * i); }
#pragma unroll
            for (int i = 0; i < 2; ++i) { const int a = (int)rintf(bflo(x[j][2 + i]) * inv), b = (int)rintf(bfhi(x[j][2 + i]) * inv); w1 |= (((unsigned)a & 0xffu) | (((unsigned)b & 0xffu) << 8)) << (16 * i); }
            orow[lane + 64 * j] = (v2u){w0, w1}; }
        if (lane == 0) sa[r] = (mx > 0.f && mx < 3.0e38f) ? mx * (1.0f / 127.0f) : 1.0f;
    }
}

__device__ __forceinline__ void h_quant_phase(const float* __restrict__ h, signed char* __restrict__ h8, float* __restrict__ sa8, const float* __restrict__ sk  , int gw, int NGW, int lane) {
    f32x4 kk[8];
#pragma unroll
    for (int j = 0; j < 8; ++j) kk[j] = ((const f32x4*)sk)[lane + 64 * j];
    for (int m = gw; m < T; m += NGW) {
        const f32x4* hr = (const f32x4*)(h + (size_t)m * DM) + lane; f32x4 v[8]; float mx = 0.f;
#pragma unroll
        for (int j = 0; j < 8; ++j) { v[j] = hr[64 * j] * kk[j]; mx = fmaxf(fmaxf(mx, fmaxf(fabsf(v[j][0]), fabsf(v[j][1]))), fmaxf(fabsf(v[j][2]), fabsf(v[j][3]))); }
        mx = fmaxf(mx, shx<1>(mx)); mx = fmaxf(mx, shx<2>(mx)); mx = fmaxf(mx, shx<4>(mx)); mx = fmaxf(mx, shx<8>(mx)); mx = fmaxf(mx, shx<16>(mx)); mx = max32(mx);
        const float inv = mx > 0.f ? 127.0f / mx : 0.f;
        unsigned* o4 = (unsigned*)(h8 + (size_t)m * DM) + lane;
#pragma unroll
        for (int j = 0; j < 8; ++j) { const int a = (int)rintf(v[j][0] * inv), b = (int)rintf(v[j][1] * inv), c = (int)rintf(v[j][2] * inv), d = (int)rintf(v[j][3] * inv);
            o4[64 * j] = ((unsigned)a & 0xffu) | (((unsigned)b & 0xffu) << 8) | (((unsigned)c & 0xffu) << 16) | (((unsigned)d & 0xffu) << 24); }
        if (lane == 0) sa8[m] = mx > 0.f ? mx * (1.0f / 127.0f) : 1.0f;
    }
}

struct GdnPre { v4u pf[6]; float g, be; };
__device__ __forceinline__ void gdn_prep_fetch(int unit, GdnPre& P, unsigned char* ws, int tid, int lane, int wave) {
    const int n = unit % GNC, bh = unit / GNC, hd = bh % GH, b = bh / GH; const int m0 = b * SEQ + n * GCH;
    const bf16* gqkv = (const bf16*)(ws + R_GQKV); const float* gbg = (const float*)(ws + R_GBG);
#pragma unroll
    for (int i = 0; i < 6; ++i) { const int idx = tid + NTHR * i, tn = idx >> 10, r = (idx & 1023) >> 4, ch = idx & 15;
        P.pf[i] = *(const GAS v4u*)(gqkv + (size_t)(m0 + r) * 1536 + tn * 512 + hd * 128 + ch * 8); }
    if (wave == 0) { P.g = gbg[(size_t)(m0 + lane) * 8 + 4 + hd]; P.be = gbg[(size_t)(m0 + lane) * 8 + hd]; }
}
__device__ __forceinline__ void gdn_prep_unit(int unit, int next_unit, GdnPre& P, unsigned char* ws, LAS unsigned char* lds, int tid, int lane, int wave) {
    const int n = unit % GNC, bh = unit / GNC, hd = bh % GH, b = bh / GH; const int m0 = b * SEQ + n * GCH; (void)m0; (void)hd;
    bf16* UT = (bf16*)(ws + R_GUT) + (size_t)unit * 8192; bf16* Wc = (bf16*)(ws + R_GW) + (size_t)unit * 8192; bf16* Qd = (bf16*)(ws + R_GQD) + (size_t)unit * 8192;
    bf16* KdT = (bf16*)(ws + R_GKDT) + (size_t)unit * 8192; bf16* Intra = (bf16*)(ws + R_GIN) + (size_t)unit * 4096; float* Gend = (float*)(ws + R_GEND);
    constexpr int LDB = 272;
    LAS unsigned char* Ks = lds; LAS unsigned char* Qs = lds + 17408; LAS unsigned char* Vs = lds + 34816;
    LAS float* MT = (LAS float*)(lds + 52224);
    LAS float* gcs = (LAS float*)(lds + 69632); LAS float* rsc = (LAS float*)(lds + 69888);
    LAS float* Xl = (LAS float*)(lds + 70400);
#pragma unroll
    for (int i = 0; i < 6; ++i) { const int idx = tid + NTHR * i, tn = idx >> 10, r = (idx & 1023) >> 4, ch = idx & 15;
        LAS unsigned char* dst = (tn == 0 ? Qs : (tn == 1 ? Ks : Vs)) + r * LDB + ch * 16;
        *(LAS v4u*)dst = P.pf[i]; }
    if (wave == 0) { float g = P.g; const float be = P.be;
        g = wave_scan(g, lane);
        gcs[lane] = g; rsc[lane] = be; rsc[64 + lane] = be * __expf(g); }
    __syncthreads();
    if (next_unit >= 0) gdn_prep_fetch(next_unit, P, ws, tid, lane, wave);
    {
        const int ct = wave >> 1, st0 = 2 * (wave & 1), g4 = lane >> 4, r16 = lane & 15;
        f32x4 ak[2] = {{0.f, 0.f, 0.f, 0.f}, {0.f, 0.f, 0.f, 0.f}}, aq[2] = {{0.f, 0.f, 0.f, 0.f}, {0.f, 0.f, 0.f, 0.f}};
#pragma unroll
        for (int ks = 0; ks < 4; ++ks) { const bf16x8 fk = lds_frag(Ks, LDB, 16 * ct, 32 * ks, lane), fq = lds_frag(Qs, LDB, 16 * ct, 32 * ks, lane);
#pragma unroll
            for (int j = 0; j < 2; ++j) { const bf16x8 fb = lds_frag(Ks, LDB, 16 * (st0 + j), 32 * ks, lane); ak[j] = MFMA16(fk, fb, ak[j]); aq[j] = MFMA16(fq, fb, aq[j]); } }
#pragma unroll
        for (int j = 0; j < 2; ++j) { const int s = 16 * (st0 + j) + r16; const float gs = gcs[s]; f32x4 mv;
#pragma unroll
            for (int i = 0; i < 4; ++i) { const int c = 16 * ct + 4 * g4 + i; const float dec = __expf(fminf(gcs[c] - gs, 0.f));
                mv[i] = (s < c) ? rsc[c] * ak[j][i] * dec : 0.f;
                Intra[c * 64 + s] = f2bf((s <= c) ? aq[j][i] * dec : 0.f); }
            *(LAS f32x4*)(MT + s * 68 + 16 * ct + 4 * g4) = mv; }
    }
    __syncthreads();
    {
#pragma unroll
        for (int i = 0; i < 2; ++i) { const int id = tid + NTHR * i, c = id >> 4, ch = id & 15; const float eg = __expf(gcs[c]);
            const v4u v = *(const LAS v4u*)(Qs + c * LDB + ch * 16);
            v4u o; o.x = cvt_pk_bf16(bflo(v.x) * eg, bfhi(v.x) * eg); o.y = cvt_pk_bf16(bflo(v.y) * eg, bfhi(v.y) * eg); o.z = cvt_pk_bf16(bflo(v.z) * eg, bfhi(v.z) * eg); o.w = cvt_pk_bf16(bflo(v.w) * eg, bfhi(v.w) * eg);
            *(v4u*)(Qd + c * 128 + ch * 8) = o; }
        const float gl = gcs[63];
#pragma unroll
        for (int i = 0; i < 2; ++i) { const int id = tid + NTHR * i, d = id >> 3, cb = id & 7; float y[8];
#pragma unroll
            for (int j = 0; j < 8; ++j) { const int c = 8 * cb + j; y[j] = bf2f(((const LAS unsigned short*)Ks)[c * 136 + d]) * __expf(gl - gcs[c]); }
            v4u o; o.x = cvt_pk_bf16(y[0], y[1]); o.y = cvt_pk_bf16(y[2], y[3]); o.z = cvt_pk_bf16(y[4], y[5]); o.w = cvt_pk_bf16(y[6], y[7]);
            *(v4u*)(KdT + d * 64 + 8 * cb) = o; }
        if (tid == 0) Gend[unit] = __expf(gl);
    }
    if (tid < 256) {
        const int col = tid, sec = __builtin_amdgcn_readfirstlane(tid >> 7);
        const LAS unsigned short* sp = (const LAS unsigned short*)(sec ? Ks : Vs) + (col & 127);
        const LAS float* rs = rsc + sec * 64;
        LAS float* Xc = Xl + col;
#pragma unroll
        for (int blk = 0; blk < 4; ++blk) {
            float acc[16];
#pragma unroll
            for (int i = 0; i < 16; ++i) acc[i] = bf2f(sp[(16 * blk + i) * 136]) * rs[16 * blk + i];
            for (int s = 0; s < 16 * blk; ++s) {
                const float xs = Xc[s * 256];
                const LAS f32x4* mt = (const LAS f32x4*)(MT + s * 68 + 16 * blk);
#pragma unroll
                for (int q = 0; q < 4; ++q) { const f32x4 m4 = mt[q]; acc[4 * q] -= m4[0] * xs; acc[4 * q + 1] -= m4[1] * xs; acc[4 * q + 2] -= m4[2] * xs; acc[4 * q + 3] -= m4[3] * xs; }
            }
#pragma unroll
            for (int j = 0; j < 16; ++j) { const float xj = acc[j]; const LAS float* mt = MT + (16 * blk + j) * 68 + 16 * blk;
#pragma unroll
                for (int i = j + 1; i < 16; ++i) acc[i] -= mt[i] * xj; }
            if (blk < 3) {
#pragma unroll
                for (int i = 0; i < 16; ++i) Xc[(16 * blk + i) * 256] = acc[i]; }
            if (!sec) { v4u o0, o1;
                o0.x = cvt_pk_bf16(acc[0], acc[1]); o0.y = cvt_pk_bf16(acc[2], acc[3]); o0.z = cvt_pk_bf16(acc[4], acc[5]); o0.w = cvt_pk_bf16(acc[6], acc[7]);
                o1.x = cvt_pk_bf16(acc[8], acc[9]); o1.y = cvt_pk_bf16(acc[10], acc[11]); o1.z = cvt_pk_bf16(acc[12], acc[13]); o1.w = cvt_pk_bf16(acc[14], acc[15]);
                *(v4u*)(UT + col * 64 + 16 * blk) = o0; *(v4u*)(UT + col * 64 + 16 * blk + 8) = o1;
            } else {
#pragma unroll
                for (int i = 0; i < 16; ++i) Wc[(16 * blk + i) * 128 + (col - 128)] = f2bf(acc[i]); }
        }
    }
    __syncthreads();
}

__device__ __forceinline__ bf16x8 gfrag(const bf16* base, int ld, int row0, int k0, int lane) {
    return *(const GAS bf16x8*)(base + (size_t)(row0 + (lane & 15)) * ld + k0 + 8 * (lane >> 4));
}
__device__ __forceinline__ void gdn_scan_unit(int bh, const float* __restrict__ norm_g, unsigned char* ws, LAS unsigned char* lds, int tid, int lane, int wave) {
    const int hd = bh % GH, b = bh / GH;
    const bf16* UTb = (const bf16*)(ws + R_GUT); const bf16* Wb = (const bf16*)(ws + R_GW); const bf16* Qdb = (const bf16*)(ws + R_GQD);
    const bf16* KdTb = (const bf16*)(ws + R_GKDT); const bf16* Inb = (const bf16*)(ws + R_GIN); const float* Gend = (const float*)(ws + R_GEND);
    const bf16* u = (const bf16*)(ws + R_U); bf16* mix = (bf16*)(ws + WS_MIX);
    constexpr int STB = 272, VTB = 144;
    LAS unsigned char* ST0 = lds; LAS unsigned char* VT = lds + 69632; LAS float* ssq = (LAS float*)(lds + 88064); LAS float* NG = (LAS float*)(lds + 88576);
    LAS unsigned char* OT = lds + 89088; constexpr int OTB = 528;
    const int ct = wave & 3, eh = wave >> 2, g4 = lane >> 4, r16 = lane & 15;
    f32x4 S[8];
#pragma unroll
    for (int i = 0; i < 8; ++i) S[i] = (f32x4){0.f, 0.f, 0.f, 0.f};
    for (int i = tid; i < 2 * 34816 / 16; i += NTHR) ((LAS v4u*)ST0)[i] = (v4u){0u, 0u, 0u, 0u};
    if (tid < GD) NG[tid] = norm_g[tid];
    bf16x8 aW[4], aQ[4], aI[2], aK[2]; v2u ut[4]; v4u zz[2];
    const float gall = *(const GAS float*)(Gend + (size_t)bh * GNC + lane);
    const size_t u0 = (size_t)bh * GNC;
#define GS_EARLY(W_, Q_, U_, un) do { _Pragma("unroll") for (int ks = 0; ks < 4; ++ks) { W_[ks] = gfrag(Wb + (un) * 8192, 128, 16 * ct, 32 * ks, lane); Q_[ks] = gfrag(Qdb + (un) * 8192, 128, 16 * ct, 32 * ks, lane); } \
        _Pragma("unroll") for (int j = 0; j < 4; ++j) U_[j] = *(const GAS v2u*)(UTb + (un) * 8192 + (16 * (4 * eh + j) + r16) * 64 + 16 * ct + 4 * g4); } while (0)
#define GS_LATE(un) do { _Pragma("unroll") for (int ks = 0; ks < 2; ++ks) { aI[ks] = gfrag(Inb + (un) * 4096, 64, 16 * ct, 32 * ks, lane); aK[ks] = gfrag(KdTb + (un) * 8192, 64, 16 * wave, 32 * ks, lane); } \
        } while (0)
#define GS_Z(n_) do { _Pragma("unroll") for (int p = 0; p < 2; ++p) zz[p] = *(const GAS v4u*)(u + (size_t)(b * SEQ + (n_) * GCH + 8 * wave + 4 * p + g4) * D_INP + U_GZ + hd * 128 + 8 * r16); } while (0)
    GS_EARLY(aW, aQ, ut, u0); GS_LATE(u0);
    __syncthreads();
    for (int n = 0; n < GNC; ++n) {
        const int cur = n & 1;
        LAS unsigned char* STc = ST0 + cur * 34816; LAS unsigned char* STn = ST0 + (cur ^ 1) * 34816;
        GS_Z(n);
        f32x4 o[4];
        {
            bf16x8 stf[4][4];
#pragma unroll
            for (int j = 0; j < 4; ++j)
#pragma unroll
                for (int ks = 0; ks < 4; ++ks) stf[j][ks] = lds_frag(STc, STB, 16 * (4 * eh + j), 32 * ks, lane);
            __builtin_amdgcn_sched_barrier(0);
#pragma unroll
            for (int j = 0; j < 4; ++j) { f32x4 av = {0.f, 0.f, 0.f, 0.f}, ao = {0.f, 0.f, 0.f, 0.f};
#pragma unroll
                for (int ks = 0; ks < 4; ++ks) { av = MFMA16(aW[ks], stf[j][ks], av); ao = MFMA16(stf[j][ks], aQ[ks], ao); }
                o[j] = ao;
                f32x4 vn; vn[0] = bflo(ut[j].x) - av[0]; vn[1] = bfhi(ut[j].x) - av[1]; vn[2] = bflo(ut[j].y) - av[2]; vn[3] = bfhi(ut[j].y) - av[3];
                *(LAS v2u*)(VT + (16 * (4 * eh + j) + r16) * VTB + (16 * ct + 4 * g4) * 2) = pack4(vn); }
        }
        __builtin_amdgcn_sched_barrier(0);
        if (n + 1 < GNC) GS_EARLY(aW, aQ, ut, u0 + n + 1);
        __syncthreads();
        float ss = 0.f;
        {
            bf16x8 vtf[8][2];
#pragma unroll
            for (int et = 0; et < 8; ++et)
#pragma unroll
                for (int ks = 0; ks < 2; ++ks) vtf[et][ks] = lds_frag(VT, VTB, 16 * et, 32 * ks, lane);
            __builtin_amdgcn_sched_barrier(0);
            if (eh == 0) {
#pragma unroll
                for (int j = 0; j < 4; ++j) { o[j] = MFMA16(vtf[j][0], aI[0], o[j]); o[j] = MFMA16(vtf[j][1], aI[1], o[j]); }
            } else {
#pragma unroll
                for (int j = 0; j < 4; ++j) { o[j] = MFMA16(vtf[4 + j][0], aI[0], o[j]); o[j] = MFMA16(vtf[4 + j][1], aI[1], o[j]); }
            }
            const float ge = __builtin_bit_cast(float, __builtin_amdgcn_readlane(__builtin_bit_cast(int, gall), n));
#pragma unroll
            for (int et = 0; et < 8; ++et) { f32x4 acc = S[et] * ge;
                acc = MFMA16(aK[0], vtf[et][0], acc); acc = MFMA16(aK[1], vtf[et][1], acc);
                S[et] = acc;
                *(LAS v2u*)(STn + (16 * et + r16) * STB + (16 * wave + 4 * g4) * 2) = pack4_mfma(acc); }
        }
        __builtin_amdgcn_sched_barrier(0);
        if (n + 1 < GNC) GS_LATE(u0 + n + 1);
#pragma unroll
        for (int j = 0; j < 4; ++j) { ss += (o[j][0] * o[j][0] + o[j][1] * o[j][1]) + (o[j][2] * o[j][2] + o[j][3] * o[j][3]);
            *(LAS f32x4*)(OT + (16 * ct + r16) * OTB + (16 * (4 * eh + j) + 4 * g4) * 4) = o[j]; }
        ss += shx<16>(ss); ss = sum32(ss);
        if (g4 == 0) ssq[eh * 64 + 16 * ct + r16] = ss;
        __syncthreads();
#pragma unroll
        for (int p = 0; p < 2; ++p) { const int row = 8 * wave + 4 * p + g4, e0 = 8 * r16;
            const float tot = ssq[row] + ssq[64 + row]; const float rs = rsqrtf(tot * (1.0f / GD) + EPS);
            const f32x4 oa = *(const LAS f32x4*)(OT + row * OTB + e0 * 4), ob = *(const LAS f32x4*)(OT + row * OTB + e0 * 4 + 16);
            const f32x4 na = *(const LAS f32x4*)(NG + e0), nb = *(const LAS f32x4*)(NG + e0 + 4); const v4u zv = zz[p];
            u32x4 w;
            w.x = cvt_pk_bf16(oa[0] * rs * na[0] * siluf_(bflo(zv.x)), oa[1] * rs * na[1] * siluf_(bfhi(zv.x))); w.y = cvt_pk_bf16(oa[2] * rs * na[2] * siluf_(bflo(zv.y)), oa[3] * rs * na[3] * siluf_(bfhi(zv.y)));
            w.z = cvt_pk_bf16(ob[0] * rs * nb[0] * siluf_(bflo(zv.z)), ob[1] * rs * nb[1] * siluf_(bfhi(zv.z))); w.w = cvt_pk_bf16(ob[2] * rs * nb[2] * siluf_(bflo(zv.w)), ob[3] * rs * nb[3] * siluf_(bfhi(zv.w)));
            *(GAS u32x4*)(mix + (size_t)(b * SEQ + n * GCH + row) * DM + hd * 128 + e0) = w; }
    }
#undef GS_EARLY
#undef GS_LATE
#undef GS_Z
    __syncthreads();
}

__device__ __forceinline__ void attn_unit(int b, int hd, int qb, unsigned char* ws, LAS unsigned char* lds, int tid, int lane, int wave) {
    const bf16* Q = (const bf16*)(ws + R_Q); const bf16* K = (const bf16*)(ws + R_K); const bf16* KV = (const bf16*)(ws + R_KVRAW); bf16* mix = (bf16*)(ws + WS_MIX);
    constexpr int VLB = 288, KBUF = 64 * 384, VBUF = 64 * VLB;
    LAS unsigned char* Ks0 = lds; LAS unsigned char* Vs0 = lds + 2 * KBUF;
    const int g4 = lane >> 4, r16 = lane & 15;
    const size_t mb = (size_t)b * SEQ;
    bf16x8 qf[6];
#pragma unroll
    for (int ks = 0; ks < 6; ++ks) qf[ks] = glb_frag(Q + mb * 768 + hd * MQK, 768, 128 * qb + 16 * wave, 32 * ks, lane);
    const int nkt = 2 * (qb + 1);
    v4u kst[3], vst[2];
#define ATT_KMAP const int id = tid + NTHR * i, rest = id >> 3, r = 2 * (rest / 6) + ((id >> 2) & 1), ch = (rest % 6) * 4 + (id & 3)
#define ATT_LOAD(kt) do { _Pragma("unroll") for (int i = 0; i < 3; ++i) { ATT_KMAP; \
            kst[i] = *(const v4u*)(K + (mb + 64 * (kt) + r) * 768 + hd * MQK + 8 * ch); } \
        _Pragma("unroll") for (int i = 0; i < 2; ++i) { const int id = tid + NTHR * i, r = id >> 4, ch = id & 15; \
            vst[i] = *(const v4u*)(KV + (mb + 64 * (kt) + r) * 1024 + hd * 256 + 128 + 8 * ch); } } while (0)
#define ATT_STORE(buf) do { _Pragma("unroll") for (int i = 0; i < 3; ++i) { ATT_KMAP; \
            *(LAS v4u*)(Ks0 + (buf) * KBUF + ((r >> 4) * 6 + (ch >> 2)) * 1024 + ((((r & 15) * 64) + (ch & 3) * 16) ^ (((r >> 3) & 1) << 5))) = kst[i]; } \
        _Pragma("unroll") for (int i = 0; i < 2; ++i) { const int id = tid + NTHR * i, r = id >> 4, ch = id & 15; \
            *(LAS v4u*)(Vs0 + (buf) * VBUF + r * VLB + ch * 16) = vst[i]; } } while (0)
    ATT_LOAD(0); ATT_STORE(0); ATT_LOAD(1);
    __syncthreads();
    const int klane = ((r16 * 64) + g4 * 16) ^ ((r16 >> 3) << 5);
    f32x4 O[8];
#pragma unroll
    for (int i = 0; i < 8; ++i) O[i] = (f32x4){0.f, 0.f, 0.f, 0.f};
    float mrun = -1.0e30f, lrun = 0.f;
    const int qpos = 128 * qb + 16 * wave + r16;
    for (int kt = 0; kt < nkt; ++kt) {
        const int cur = kt & 1;
        if (kt + 1 < nkt) ATT_STORE(cur ^ 1);
        if (kt + 2 < nkt) ATT_LOAD(kt + 2);
        const LAS unsigned char* Kc = Ks0 + cur * KBUF + klane; const LAS unsigned char* Vc = Vs0 + cur * VBUF;
        f32x4 s[4];
#pragma unroll
        for (int nt = 0; nt < 4; ++nt) { f32x4 acc = {0.f, 0.f, 0.f, 0.f};
#pragma unroll
            for (int ks = 0; ks < 6; ++ks) acc = MFMA16(*(const LAS bf16x8*)(Kc + (nt * 6 + ks) * 1024), qf[ks], acc);
            s[nt] = acc; }
        if (kt >= 2 * qb) {
#pragma unroll
            for (int nt = 0; nt < 4; ++nt)
#pragma unroll
                for (int i = 0; i < 4; ++i) { const int key = 64 * kt + 16 * nt + 4 * g4 + i; if (key > qpos) s[nt][i] = -__builtin_inff(); }
        }
        float mx = s[0][0];
#pragma unroll
        for (int nt = 0; nt < 4; ++nt)
#pragma unroll
            for (int i = 0; i < 4; ++i) mx = fmaxf(mx, s[nt][i]);
        mx = fmaxf(mx, shx<16>(mx)); mx = max32(mx);
        const float mnew = fmaxf(mrun, mx), alpha = __builtin_amdgcn_exp2f(mrun - mnew); mrun = mnew;
        float ps = 0.f;
#pragma unroll
        for (int nt = 0; nt < 4; ++nt)
#pragma unroll
            for (int i = 0; i < 4; ++i) { const float p = __builtin_amdgcn_exp2f(s[nt][i] - mnew); s[nt][i] = p; ps += p; }
        lrun = lrun * alpha + ps;
        const bf16x8 pf0 = pack_frag(s[0], s[1]), pf1 = pack_frag(s[2], s[3]);
        if (!__all(alpha == 1.0f)) {
#pragma unroll
            for (int dt = 0; dt < 8; ++dt) O[dt] = O[dt] * alpha; }
#pragma unroll
        for (int dt = 0; dt < 8; ++dt) { f32x4 acc = O[dt];
            acc = MFMA16(lds_frag_trp(Vc, VLB, 0, 16 * dt, lane), pf0, acc);
            acc = MFMA16(lds_frag_trp(Vc, VLB, 32, 16 * dt, lane), pf1, acc);
            O[dt] = acc; }
        __syncthreads();
    }
#undef ATT_KMAP
#undef ATT_LOAD
#undef ATT_STORE
    lrun += shx<16>(lrun); lrun = sum32(lrun);
    const float inv = 1.0f / lrun;
    bf16* orow = mix + (mb + qpos) * DM + 1536 + hd * MV;
#pragma unroll
    for (int dt = 0; dt < 8; ++dt) *(v2u*)(orow + 16 * dt + 4 * g4) = pack4(O[dt] * inv);
}

__device__ __forceinline__ void ssd_state_unit(int unit, const float* __restrict__ a_log, unsigned char* ws, LAS unsigned char* lds, int tid, int lane, int wave) {
    const int hd = unit % SH, bc = unit / SH; const int m0 = bc * SCH;
    const bf16* xc = (const bf16*)(ws + R_XC); const float* dtb = (const float*)(ws + R_DT);
    float* st = (float*)(ws + R_SST) + (size_t)unit * (SP * SN); float* dA = (float*)(ws + R_SDA);
    constexpr int XLB = 144, BLB = 272;
    LAS unsigned char* Xs = lds; LAS unsigned char* Bs = lds + 36864; LAS float* acs = (LAS float*)(lds + 106496);
    const int grp = hd >> 3;
#pragma unroll
    for (int i = 0; i < 8; ++i) { const int id = tid + NTHR * i, r = id >> 4, ch = id & 15;
        *(LAS v4u*)(Bs + r * BLB + ch * 16) = *(const v4u*)(xc + (size_t)(m0 + r) * SCONV + 1024 + grp * 128 + 8 * ch); }
    if (wave == 0) { const float A = -__expf(a_log[hd]); float d[4]; float run = 0.f;
#pragma unroll
        for (int i = 0; i < 4; ++i) { run += dtb[(size_t)(m0 + 4 * lane + i) * 16 + hd] * A; d[i] = run; }
        const float ex = wave_scan(run, lane) - run;
#pragma unroll
        for (int i = 0; i < 4; ++i) acs[4 * lane + i] = d[i] + ex; }
    __syncthreads();
    const float alast = acs[255];
#pragma unroll
    for (int i = 0; i < 4; ++i) { const int id = tid + NTHR * i, r = id >> 3, ch = id & 7;
        const v4u v = *(const v4u*)(xc + (size_t)(m0 + r) * SCONV + hd * 64 + 8 * ch);
        const float sc = dtb[(size_t)(m0 + r) * 16 + hd] * __expf(alast - acs[r]);
        v4u o; o.x = cvt_pk_bf16(bflo(v.x) * sc, bfhi(v.x) * sc); o.y = cvt_pk_bf16(bflo(v.y) * sc, bfhi(v.y) * sc); o.z = cvt_pk_bf16(bflo(v.z) * sc, bfhi(v.z) * sc); o.w = cvt_pk_bf16(bflo(v.w) * sc, bfhi(v.w) * sc);
        *(LAS v4u*)(Xs + r * XLB + ch * 16) = o; }
    if (tid == 0) dA[unit] = __expf(alast);
    __syncthreads();
    { const int pt = wave & 3, nh = wave >> 2, g4 = lane >> 4, r16 = lane & 15;
      f32x4 acc[4] = {{0.f, 0.f, 0.f, 0.f}, {0.f, 0.f, 0.f, 0.f}, {0.f, 0.f, 0.f, 0.f}, {0.f, 0.f, 0.f, 0.f}};
#pragma unroll
      for (int ks = 0; ks < 8; ++ks) { const bf16x8 a = lds_frag_tr(Xs, XLB, 32 * ks, 16 * pt, lane);
#pragma unroll
          for (int j = 0; j < 4; ++j) acc[j] = MFMA16(a, lds_frag_tr(Bs, BLB, 32 * ks, 16 * (4 * nh + j), lane), acc[j]); }
#pragma unroll
      for (int j = 0; j < 4; ++j)
#pragma unroll
          for (int i = 0; i < 4; ++i) st[(16 * pt + 4 * g4 + i) * SN + 16 * (4 * nh + j) + r16] = acc[j][i]; }
    __syncthreads();
}

__device__ __forceinline__ void ssd_out_unit(int unit, InP in, int L, unsigned char* ws, LAS unsigned char* lds, int tid, int lane, int wave) {
    asm volatile("" : "+v"(tid), "+v"(lane));
    const int hf = unit & 1, grp = (unit >> 1) & 1, bc = unit >> 2; const int m0 = bc * SCH;
    const bf16* xc = (const bf16*)(ws + R_XC); const float* dtb = (const float*)(ws + R_DT); const bf16* pv = (const bf16*)(ws + R_SPV);
    const bf16* u = (const bf16*)(ws + R_U); bf16* mix = (bf16*)(ws + WS_MIX);
    const float* a_log = in->p[12] + L * SH; const float* dsk = in->p[14] + L * SH; const float* ng = in->p[15] + (size_t)L * SWD;
    constexpr int CLB = 272, XLB = 144;
    LAS unsigned char* Cs = lds; LAS unsigned char* Bs = lds + 34816;
    LAS float* acs8 = (LAS float*)(lds + 104448); LAS float* dt8 = (LAS float*)(lds + 112640);
    const int nS = 128 * (hf + 1);
    const int g4 = lane >> 4, r16 = lane & 15;
#pragma unroll
    for (int i = 0; i < 4; ++i) { const int id = tid + NTHR * i, r = id >> 4, ch = id & 15;
        *(LAS v4u*)(Cs + r * CLB + ch * 16) = *(const v4u*)(xc + (size_t)(m0 + 128 * hf + r) * SCONV + 1280 + grp * 128 + 8 * ch); }
    for (int i = 0; i < 4 * (hf + 1); ++i) { const int id = tid + NTHR * i, r = id >> 4, ch = id & 15;
        *(LAS v4u*)(Bs + r * CLB + ch * 16) = *(const v4u*)(xc + (size_t)(m0 + r) * SCONV + 1024 + grp * 128 + 8 * ch); }
    { const int hd = 8 * grp + wave; const float A = -__expf(a_log[hd]); float d[4], dv[4]; float run = 0.f;
#pragma unroll
      for (int i = 0; i < 4; ++i) { dv[i] = dtb[(size_t)(m0 + 4 * lane + i) * 16 + hd]; run += dv[i] * A; d[i] = run; }
      const float ex = wave_scan(run, lane) - run;
#pragma unroll
      for (int i = 0; i < 4; ++i) { acs8[wave * 256 + 4 * lane + i] = d[i] + ex; dt8[wave * 256 + 4 * lane + i] = dv[i]; } }
    __syncthreads();
    const int lim = 8 * hf + wave;
    const int lloc = 128 * hf + 16 * wave + r16;
    bf16x8 bC[4];
#pragma unroll
    for (int ks = 0; ks < 4; ++ks) bC[ks] = lds_frag(Cs, CLB, 16 * wave, 32 * ks, lane);
    v2u cb[16];
#pragma unroll
    for (int stt = 0; stt < 16; ++stt) { f32x4 acc = {0.f, 0.f, 0.f, 0.f};
        if (stt <= lim) {
#pragma unroll
            for (int ks = 0; ks < 4; ++ks) acc = MFMA16(lds_frag(Bs, CLB, 16 * stt, 32 * ks, lane), bC[ks], acc); }
        cb[stt] = pack4_mfma(acc); }
    __syncthreads();
    float ssq = 0.f;
    constexpr int XB2 = 136;
    LAS unsigned char* Xb0 = lds + 34816; LAS unsigned char* Xb1 = lds + 69632;
    LAS unsigned char* Pb0 = lds; LAS unsigned char* Pb1 = lds + 17408;
    v4u xr[4], pr[2];
#define SO_PLOAD(hd_) do { const bf16* ph_ = pv + ((size_t)bc * SH + (hd_)) * (SP * SN); _Pragma("unroll") for (int i = 0; i < 2; ++i) { const int id = tid + NTHR * i; pr[i] = *(const GAS v4u*)(ph_ + (size_t)id * 8); } } while (0)
#define SO_PSTORE(buf) do { _Pragma("unroll") for (int i = 0; i < 2; ++i) { const int id = tid + NTHR * i, r = id >> 4, ch = id & 15; *(LAS v4u*)((buf) + r * CLB + ch * 16) = pr[i]; } } while (0)
#define SO_XLOAD(hd_) do { _Pragma("unroll") for (int i = 0; i < 4; ++i) if (i < 2 * (hf + 1)) { const int id = tid + NTHR * i, r = id >> 3, ch = id & 7; \
            xr[i] = *(const GAS v4u*)(xc + (size_t)(m0 + r) * SCONV + (hd_) * 64 + 8 * ch); } } while (0)
#define SO_XSTORE(buf) do { _Pragma("unroll") for (int i = 0; i < 4; ++i) if (i < 2 * (hf + 1)) { const int id = tid + NTHR * i, r = id >> 3, ch = id & 7; \
            LAS v2u* d_ = (LAS v2u*)((buf) + r * XB2 + ch * 16); d_[0] = (v2u){xr[i].x, xr[i].y}; d_[1] = (v2u){xr[i].z, xr[i].w}; } } while (0)
    SO_XLOAD(8 * grp); SO_PLOAD(8 * grp); SO_XSTORE(Xb0); SO_PSTORE(Pb0);
    __syncthreads();
    for (int e = 0; e < 8; ++e) {
        const int hd = 8 * grp + e;
        LAS unsigned char* Xs = (e & 1) ? Xb1 : Xb0; LAS unsigned char* Xn = (e & 1) ? Xb0 : Xb1;
        LAS unsigned char* Ps = (e & 1) ? Pb1 : Pb0; LAS unsigned char* Pn = (e & 1) ? Pb0 : Pb1;
        if (e + 1 < 8) { SO_XLOAD(hd + 1); SO_PLOAD(hd + 1); }

        const LAS float* ac = acs8 + e * 256; const LAS float* dd = dt8 + e * 256;
        const float al = ac[lloc];
        f32x4 y[4] = {{0.f, 0.f, 0.f, 0.f}, {0.f, 0.f, 0.f, 0.f}, {0.f, 0.f, 0.f, 0.f}, {0.f, 0.f, 0.f, 0.f}};
#pragma unroll
        for (int kb = 0; kb < 8; ++kb) {
            if (2 * kb <= lim) {
                f32x4 m0v, m1v;
                const f32x4 c0 = {bflo(cb[2 * kb].x), bfhi(cb[2 * kb].x), bflo(cb[2 * kb].y), bfhi(cb[2 * kb].y)}, c1 = {bflo(cb[2 * kb + 1].x), bfhi(cb[2 * kb + 1].x), bflo(cb[2 * kb + 1].y), bfhi(cb[2 * kb + 1].y)};
#pragma unroll
                for (int i = 0; i < 4; ++i) { const int s0 = 32 * kb + 4 * g4 + i, s1 = s0 + 16;
                    m0v[i] = (s0 <= lloc) ? c0[i] * __expf(al - ac[s0]) * dd[s0] : 0.f;
                    m1v[i] = (s1 <= lloc) ? c1[i] * __expf(al - ac[s1]) * dd[s1] : 0.f; }
                const bf16x8 mf = pack_frag(m0v, m1v);
#pragma unroll
                for (int pt = 0; pt < 4; ++pt) y[pt] = MFMA16(lds_frag_trp(Xs, XB2, 32 * kb, 16 * pt, lane), mf, y[pt]);
            }
            __builtin_amdgcn_sched_barrier(0);
        }
        const float eal = __expf(al), dk = dsk[hd];
#pragma unroll
        for (int pt = 0; pt < 4; ++pt) { f32x4 acc = {0.f, 0.f, 0.f, 0.f};
#pragma unroll
            for (int ks = 0; ks < 4; ++ks) acc = MFMA16(lds_frag(Ps, CLB, 16 * pt, 32 * ks, lane), bC[ks], acc);
            const v2u xv = *(const LAS v2u*)(Xs + lloc * XB2 + (16 * pt + 4 * g4) * 2);
            const v2u zq = *(const GAS v2u*)(u + (size_t)(m0 + lloc) * D_INP + U_SZ + hd * 64 + 16 * pt + 4 * g4);
            f32x4 r;
            r[0] = (y[pt][0] + eal * acc[0] + dk * bflo(xv.x)) * siluf_(bflo(zq.x)); r[1] = (y[pt][1] + eal * acc[1] + dk * bfhi(xv.x)) * siluf_(bfhi(zq.x));
            r[2] = (y[pt][2] + eal * acc[2] + dk * bflo(xv.y)) * siluf_(bflo(zq.y)); r[3] = (y[pt][3] + eal * acc[3] + dk * bfhi(xv.y)) * siluf_(bfhi(zq.y));
            const v2u pk = pack4(r);
            const float q0 = bflo(pk.x), q1 = bfhi(pk.x), q2 = bflo(pk.y), q3 = bfhi(pk.y);
            ssq += (q0 * q0 + q1 * q1) + (q2 * q2 + q3 * q3);
            *(v2u*)(mix + (size_t)(m0 + lloc) * DM + 512 + hd * 64 + 16 * pt + 4 * g4) = pk; }
        if (e + 1 < 8) { SO_XSTORE(Xn); SO_PSTORE(Pn); }
        __syncthreads();
    }
#undef SO_XLOAD
#undef SO_XSTORE
#undef SO_PLOAD
#undef SO_PSTORE
    ssq += shx<16>(ssq); ssq = sum32(ssq);
    const float rs = rsqrtf(ssq * (1.0f / 512.0f) + EPS);
    VM_WAIT();
    for (int e = 0; e < 8; ++e) { const int hd = 8 * grp + e;
#pragma unroll
        for (int pt = 0; pt < 4; ++pt) { bf16* p = mix + (size_t)(m0 + lloc) * DM + 512 + hd * 64 + 16 * pt + 4 * g4; const v2u pk = *(const v2u*)p;
            const f32x4 gg = *(const f32x4*)(ng + hd * 64 + 16 * pt + 4 * g4);
            f32x4 r; r[0] = bflo(pk.x) * rs * gg[0]; r[1] = bfhi(pk.x) * rs * gg[1]; r[2] = bflo(pk.y) * rs * gg[2]; r[3] = bfhi(pk.y) * rs * gg[3];
            *(v2u*)p = pack4(r); } }
}

#ifndef MK_PER_PHASE
#define MK_PER_PHASE 0
#endif
#define PHASE_FN __device__ __forceinline__
#define LND(p) asm volatile("" : "+s"(p))
#define PH_IDS int tid_ = threadIdx.x; asm volatile("" : "+v"(tid_)); int G_ = gridDim.x, bid_ = blockIdx.x; LND(G_); LND(bid_); const int tid = tid_, G = G_, bid = bid_; const int lane = tid & 63, wave = __builtin_amdgcn_readfirstlane(tid >> 6); \
    const int gw = bid * NWAVES + wave, NGW = G * NWAVES, gtid = bid * NTHR + tid, NGT = G * NTHR; (void)lane; (void)gw; (void)NGW; (void)gtid; (void)NGT
constexpr int PH_PER_LAYER = 14, N_PHASES = 1 + 2 * PH_PER_LAYER;
struct Args { In in; float* out; unsigned char* ws; int ph_lo, ph_hi; };

PHASE_FN void ph_prologue(InP in, unsigned char* ws, LAS unsigned char* lds) { LND(in); LND(ws); LND(lds); PH_IDS; prologue_phase(in, ws, lds, gw, NGW, wave, lane, gtid, NGT, bid, G); }
template <int WHICH> PHASE_FN void ph_rms(InP in, int L, float* hbuf, unsigned char* ws, LAS unsigned char* lds) { LND(in); LND(hbuf); LND(ws); LND(lds); PH_IDS;
    const float* h = (WHICH == 0 && L == 0) ? in->p[0] : hbuf; const float* g = (WHICH == 0 ? in->p[3] : in->p[22]) + (size_t)L * DM;
    if (WHICH == 2) rms_phase<true, true>(h, g, nullptr, (signed char*)(ws + WS_HN8), (float*)(ws + WS_SA), in->p[26], (int*)(ws + WS_ROUTE), (float*)(ws + WS_ROUTE + (size_t)T * 8), (unsigned*)(ws + WS_CTL) + CW_CNT, lds, gw, NGW, lane, tid);
    else rms_phase<false, true>(h, g, nullptr, (signed char*)(ws + WS_HN8), (float*)(ws + WS_SA), nullptr, nullptr, nullptr, nullptr, lds, gw, NGW, lane, tid);
    if (WHICH == 1) scale_fold(0, ws, gtid, NGT);
    if (WHICH == 2) scale_fold(1, ws, gtid, NGT); }
PHASE_FN void ph_gemm_win(int L, unsigned char* ws, LAS unsigned char* lds) { LND(ws); LND(lds); PH_IDS;
    pg8::Gemm g{ws + WS_HN8, ws + WS_WIN + (size_t)L * (SZ_WIN / 2), T, D_INP, DM, 0}; pg8::StaticOrder S; S.init(T, D_INP, G, bid);
    pg8::EpiBf16Plain8 E{(bf16*)(ws + R_U), D_INP, (const float*)(ws + WS_SA), (const float*)(ws + WS_SWIN) + L * D_INP}; pg8::gemm_phase<pg8::EpiBf16Plain8, pg8::StaticOrder, true, true, 1>(lds, g, S, E); }
PHASE_FN void ph_conv(InP in, int L, unsigned char* ws) { LND(in); LND(ws); PH_IDS; conv_phase(in, L, ws, gw, NGW, lane); }
template <int WHICH> PHASE_FN void ph_gemm_plain(int L, unsigned char* ws, LAS unsigned char* lds, int first = -1, int nblk = 0) { LND(ws); LND(lds); PH_IDS;
    const bf16* A = WHICH == 0 ? (const bf16*)(ws + R_QLN) : WHICH == 1 ? (const bf16*)(ws + R_KVLN) : (const bf16*)(ws + WS_PB) + (size_t)L * T * PLE_DIM;
    const bf16* Bt = WHICH == 0 ? (const bf16*)(ws + WS_WQB + L * SZ_WQB) : WHICH == 1 ? (const bf16*)(ws + WS_WKVB + L * SZ_WKVB) : (const bf16*)(ws + WS_WPP + L * SZ_WPP);
    bf16* O = WHICH == 0 ? (bf16*)(ws + R_QRAW) : WHICH == 1 ? (bf16*)(ws + R_KVRAW) : (bf16*)(ws + WS_E);
    constexpr int N = WHICH == 0 ? 768 : WHICH == 1 ? 1024 : DM, K = WHICH == 0 ? MQR : WHICH == 1 ? MKVR : PLE_DIM;
    pg8::Gemm g{A, Bt, T, N, K, 0}; pg8::StaticOrder S;
    if (first < 0) S.init(T, N, G, bid); else { if (bid < first) return; S.init(T, N, nblk, bid - first); }
    pg8::EpiBf16Plain E{O, N}; pg8::gemm_phase<pg8::EpiBf16Plain, pg8::StaticOrder, true, true>(lds, g, S, E); }
constexpr int WIN_ND = 16;
PHASE_FN void ph_down_quant(InP in, unsigned char* ws, LAS unsigned char* lds) { LND(in); LND(ws); LND(lds); PH_IDS;
    const int NS = BATCH * GH + (G == 256 ? WIN_ND : 0); if (G > 2 * NS) { if (bid < NS) return; down_quant_phase(in->p[25], in->p[29], ws, lds, bid - NS, G - NS, lane, wave); }
    else down_quant_phase(in->p[25], in->p[29], ws, lds, bid, G, lane, wave); }
constexpr int MOE_GU_L0 = 768;
PHASE_FN void ph_moe_gu_quant(InP in, unsigned char* ws, LAS unsigned char* lds, int lo, int hi) { LND(in); LND(ws); LND(lds); PH_IDS;
    const int NS = BATCH * GH + (G == 256 ? WIN_ND : 0); if (G > 2 * NS) { if (bid < NS) return; moe_gu_quant_phase(in, ws, lds, lo, hi, bid - NS, G - NS, lane, wave); }
    else moe_gu_quant_phase(in, ws, lds, lo, hi, bid, G, lane, wave); }
PHASE_FN void ph_gemm_pe(InP in, int L, unsigned char* ws, LAS unsigned char* lds, int first, int nblk) { LND(in); LND(ws); LND(lds); PH_IDS;
    pg8::Gemm g{(const bf16*)(ws + WS_PB) + (size_t)L * T * PLE_DIM, ws + WS_WPP + L * SZ_WPP, T, DM, PLE_DIM, 0}; pg8::StaticOrder S;
    if (first < 0) S.init(T, DM, G, bid); else { if (bid < first) return; S.init(T, DM, nblk, bid - first); }
    pg8::EpiPeSS E{(bf16*)(ws + WS_E), DM, in->p[32] + (size_t)L * DM, (float*)(ws + WS_SSP) + (size_t)L * T * 32}; pg8::gemm_phase<pg8::EpiPeSS, pg8::StaticOrder, true, true>(lds, g, S, E); }
PHASE_FN void ph_gdn_prep(unsigned char* ws, LAS unsigned char* lds) { LND(ws); LND(lds); PH_IDS; GdnPre P; if (bid < GNU) gdn_prep_fetch(bid, P, ws, tid, lane, wave);
    for (int un = bid; un < GNU; un += G) gdn_prep_unit(un, un + G < GNU ? un + G : -1, P, ws, lds, tid, lane, wave); }
PHASE_FN void ph_ssd_state(InP in, int L, unsigned char* ws, LAS unsigned char* lds) { LND(in); LND(ws); LND(lds); PH_IDS; const float* a_log = in->p[12] + L * SH; for (int un = bid; un < BATCH * SNC * SH; un += G) ssd_state_unit(un, a_log, ws, lds, tid, lane, wave); }
PHASE_FN void ph_mlaprep(InP in, int L, unsigned char* ws) { LND(in); LND(ws); PH_IDS; mlaprep_phase(in, L, ws, gw, NGW, lane); ssd_scan_phase(ws, gtid, NGT);
    { const f32x4* sp = (const f32x4*)((const float*)(ws + WS_SSP) + (size_t)L * T * 32); float* rs = (float*)(ws + WS_RSE) + (size_t)L * T;
      for (int r = gtid; r < T; r += NGT) { float q = 0.f;
#pragma unroll
          for (int j = 0; j < 8; ++j) { const f32x4 x = sp[(size_t)r * 8 + j]; q += (x[0] + x[1]) + (x[2] + x[3]); }
          rs[r] = rsqrtf(q * (1.0f / DM) + EPS); } }
#ifdef MK_ZERO_MIX
    for (size_t i = gtid; i < (size_t)T * DM / 8; i += NGT) ((v4u*)(ws + WS_MIX))[i] = (v4u){0u, 0u, 0u, 0u};
#endif
}
PHASE_FN void ph_gdn_scan(InP in, int L, unsigned char* ws, LAS unsigned char* lds) { LND(in); LND(ws); LND(lds); PH_IDS; if (bid < BATCH * GH) gdn_scan_unit(bid, in->p[9] + L * GD, ws, lds, tid, lane, wave); }
PHASE_FN void ph_attn(unsigned char* ws, LAS unsigned char* lds) { LND(ws); LND(lds); PH_IDS;
    const int NS = BATCH * GH, GA = G - NS; if (bid < NS || GA <= 0) return;
    const int k = bid - NS;
    if (G == 256) {
        for (int r = 0; r < 3; ++r) { int it;
            if (r == 0) it = k;
            else if (k < WIN_ND) break;
            else { const int j = k - WIN_ND; if (r == 1) it = 240 + (223 - j);
                   else { if (j < 176) break; it = 464 + (223 - j); } }
            const int qb = 31 - (it >> 4), bh = it & 15;
            attn_unit(bh >> 2, bh & 3, qb, ws, lds, tid, lane, wave); __syncthreads(); }
        return; }
    for (int r = 0; r * GA < 512; ++r) { const int it = r * GA + ((r & 1) ? GA - 1 - k : k); if (it >= 512) continue;
        const int qb = 31 - (it >> 4), bh = it & 15;
        attn_unit(bh >> 2, bh & 3, qb, ws, lds, tid, lane, wave); __syncthreads(); } }
PHASE_FN void ph_ssd_out(InP in, int L, unsigned char* ws, LAS unsigned char* lds) { LND(in); LND(ws); LND(lds); PH_IDS;
    const int NU = BATCH * SNC * SG * 2, NS = BATCH * GH;
    if (G == 256 && NU == 256 && NS == 16) {
        if (bid < NS) return;
        const int k = bid - NS;
        for (int r = 0; r < 2; ++r) { if (r == 1 && k >= WIN_ND) break;
            ssd_out_unit(r ? 240 + k : k, in, L, ws, lds, tid, lane, wave); __syncthreads(); }
        return; }
    for (int un = bid; un < NU; un += G) { ssd_out_unit(un, in, L, ws, lds, tid, lane, wave); __syncthreads(); } }
template <int WHICH> PHASE_FN void ph_gemm_resid(InP in, int L, float* hbuf, unsigned char* ws, LAS unsigned char* lds) { LND(in); LND(hbuf); LND(ws); LND(lds); PH_IDS;
    pg8::StaticOrder S; S.init(T, DM, G, bid);
    if constexpr (WHICH == 0) { const float* base = (L == 0) ? in->p[0] : hbuf;
        pg8::Gemm g{ws + WS_MIX, ws + WS_WOUT + L * SZ_WOUT, T, DM, DM, 0};
        pg8::EpiResid E{base, hbuf, nullptr, DM}; pg8::gemm_phase<pg8::EpiResid, pg8::StaticOrder, true, true>(lds, g, S, E);
    } else {
        pg8::Gemm g{ws + R_ACT, ws + WS_WDN, T, DM, FF0, 2 * FF0};
        pg8::EpiResid8 E{hbuf, hbuf, nullptr, DM, (const float*)(ws + WS_SA2), (const float*)(ws + WS_SDD)}; pg8::gemm_phase<pg8::EpiResid8, pg8::StaticOrder, true, true, 1>(lds, g, S, E); } }
PHASE_FN void ph_gemm_gu(unsigned char* ws, LAS unsigned char* lds) { LND(ws); LND(lds); PH_IDS;
    pg8::Gemm g{ws + WS_HN8, ws + WS_WGU, T, 2 * FF0, DM, 0}; pg8::StaticOrder S; S.init(T, 2 * FF0, G, bid);
    pg8::EpiSwiGLU8 E{(bf16*)(ws + R_ACT), FF0, (const float*)(ws + WS_SA), (const float*)(ws + WS_SWD)}; pg8::gemm_phase<pg8::EpiSwiGLU8, pg8::StaticOrder, true, true, 1>(lds, g, S, E); }
PHASE_FN void ph_moe_permute(unsigned char* ws, LAS unsigned char* lds) { LND(ws); LND(lds); PH_IDS; moe_permute_phase(ws, (unsigned*)(ws + WS_CTL), lds, bid, G, tid, lane, wave); }
PHASE_FN void ph_moe_gu(unsigned char* ws, LAS unsigned char* lds) { LND(ws); LND(lds); PH_IDS;
    int toff[9]; moe_tile_prefix((unsigned*)(ws + WS_CTL) + CW_CNT, toff);
    pg8::Gemm g{ws + R_XP, ws + WS_WMGU, MAXSLOTS, 2 * FFE, DM, 0}; pg8::GroupOrder S; S.init(toff, 2 * FFE / 256, G, bid);
    pg8::EpiSwiGLU8 E{(bf16*)(ws + R_ACTP), FFE, (const float*)(ws + WS_XSC), (const float*)(ws + WS_SWM)}; pg8::gemm_phase<pg8::EpiSwiGLU8, pg8::GroupOrder, true, true, 1>(lds, g, S, E); }
PHASE_FN void ph_moe_down(unsigned char* ws, LAS unsigned char* lds) { LND(ws); LND(lds); PH_IDS;
    int toff[9]; moe_tile_prefix((unsigned*)(ws + WS_CTL) + CW_CNT, toff);
    pg8::Gemm g{ws + R_ACTP, ws + WS_WMDN, MAXSLOTS, DM, FFE, 2 * FFE}; pg8::GroupOrder S; S.init(toff, DM / 256, G, bid);
    pg8::EpiBf16Plain8 E{(bf16*)(ws + R_XP), DM, (const float*)(ws + WS_SA2), (const float*)(ws + WS_SDM)}; pg8::gemm_phase<pg8::EpiBf16Plain8, pg8::GroupOrder, true, true, 1>(lds, g, S, E); }
PHASE_FN void ph_act_quant(int L, unsigned char* ws) { LND(ws); PH_IDS;
    if (L == 0) act_quant_phase<FF0>(ws + R_ACT, (float*)(ws + WS_SA2), T, gw, NGW, lane);
    else { int toff[9]; moe_tile_prefix((unsigned*)(ws + WS_CTL) + CW_CNT, toff); act_quant_phase<FFE>(ws + R_ACTP, (float*)(ws + WS_SA2), toff[8] * 256, gw, NGW, lane); } }
PHASE_FN void ph_moe_combine(unsigned char* ws, float* h) { LND(ws); LND(h); PH_IDS; moe_combine_phase(ws, h, (const float*)(ws + WS_SKG) + DM, gw, NGW, lane); }
PHASE_FN void ph_gemm_ple(int L, float* h, unsigned char* ws, LAS unsigned char* lds) { LND(h); LND(ws); LND(lds); PH_IDS;
    pg8::StaticOrder S; S.init(T, DM, G, bid);
    { pg8::Gemm g{ws + WS_HN8, ws + WS_WPG8 + (size_t)L * DM * DM, T, DM, DM, 0};
      pg8::EpiPle8 E{h, (const bf16*)(ws + WS_E), DM, (const float*)(ws + WS_SA), (const float*)(ws + WS_SPG) + L * DM, (const float*)(ws + WS_RSE) + L * T}; pg8::gemm_phase<pg8::EpiPle8, pg8::StaticOrder, true, true, 1>(lds, g, S, E); } }
PHASE_FN void ph_h_quant(float* h, unsigned char* ws) { LND(h); LND(ws); PH_IDS; h_quant_phase(h, (signed char*)(ws + WS_HN8), (float*)(ws + WS_SA), (const float*)(ws + WS_SKG), gw, NGW, lane); }

__device__ __forceinline__ bool in_range(int k, int lo, int hi) { LND(lo); LND(hi); return lo <= k && k < hi; }
#ifndef MK_DIS
#define MK_DIS 0u
#endif
#define ON(j) (!((MK_DIS >> (j)) & 1u))
#ifndef MK_DUP
#define MK_DUP 0u
#endif
#define DUP(j) ((MK_DUP >> (j)) & 1u)
#define IN(k) in_range((k), lo, hi)
#define SEAM(k) do { if (IN(k) && IN((k) + 1)) { XcdBarrier bb_ = bar; LND(bb_.bar); LND(bb_.x); xcd_barrier(bb_); } } while (0)
template <int L> __device__ __forceinline__ void layer_phases(InP in, float* hbuf, unsigned char* ws, LAS unsigned char* lds, const XcdBarrier& bar, const int lo, const int hi) {

        const int pb = 1 + PH_PER_LAYER * L;
        if (IN(pb + 0) && ON(0)) { ph_rms<0>(in, L, hbuf, ws, lds); if (DUP(0)) { __syncthreads(); ph_rms<0>(in, L, hbuf, ws, lds); } }
        SEAM(pb + 0);
        if (IN(pb + 1) && ON(1)) { ph_gemm_win(L, ws, lds); if (DUP(1)) { __syncthreads(); ph_gemm_win(L, ws, lds); }
            { const int Gs = gridDim.x, tail = ((T / 256) * (D_INP / 256)) % Gs;
              __syncthreads(); if (tail > 0 && tail < Gs) ph_gemm_pe(in, L, ws, lds, tail, Gs - tail); else ph_gemm_pe(in, L, ws, lds, -1, 0); } }
        SEAM(pb + 1);
        if (IN(pb + 2) && ON(2)) { ph_conv(in, L, ws); if (DUP(2)) ph_conv(in, L, ws); }
        SEAM(pb + 2);
        if (IN(pb + 3) && ON(3)) {
            ph_gemm_plain<0>(L, ws, lds); ph_gemm_plain<1>(L, ws, lds);
            __syncthreads();
            ph_gdn_prep(ws, lds);
            ph_ssd_state(in, L, ws, lds);
            if (DUP(3)) { ph_gemm_plain<0>(L, ws, lds); ph_gemm_plain<1>(L, ws, lds); __syncthreads(); }
            if (DUP(4)) { ph_gdn_prep(ws, lds); }
            if (DUP(14)) { ph_ssd_state(in, L, ws, lds); }
        }
        SEAM(pb + 3);
        if (IN(pb + 4) && ON(4)) ph_mlaprep(in, L, ws);
        SEAM(pb + 4);
        if (IN(pb + 5) && ON(5)) {
#ifndef NO_GSCAN
            ph_gdn_scan(in, L, ws, lds);
#endif
            const int fgrp = (int)(blockIdx.x % 3u); const bool fill_first = fgrp == 1, fill_mid = fgrp == 2;
#define PH5_FILL() do { __syncthreads(); if (L == 0) { ph_moe_gu_quant(in, ws, lds, NEXP * ST_EXP, NEXP * ST_EXP + 64); ph_down_quant(in, ws, lds); ph_moe_gu_quant(in, ws, lds, 0, MOE_GU_L0); } \
            else { ph_moe_gu_quant(in, ws, lds, NEXP * ST_EXP + 64, NEXP * ST_EXP + 128); ph_moe_gu_quant(in, ws, lds, MOE_GU_L0, NEXP * ST_EXP); } __syncthreads(); } while (0)
            if (fill_first) PH5_FILL();
#ifndef NO_ATTN
            ph_attn(ws, lds);
#endif
            if (fill_mid) PH5_FILL();
#ifndef NO_SSDOUT
            ph_ssd_out(in, L, ws, lds);
#endif
            if (!fill_first && !fill_mid) PH5_FILL();
#undef PH5_FILL
            if (DUP(5)) ph_gdn_scan(in, L, ws, lds);
            if (DUP(6)) ph_attn(ws, lds);
            if (DUP(7)) ph_ssd_out(in, L, ws, lds);
        }
        SEAM(pb + 5);
        if (IN(pb + 6) && ON(6)) ph_gemm_resid<0>(in, L, hbuf, ws, lds);
        SEAM(pb + 6);
        if (IN(pb + 7) && ON(7)) { if (L == 0) ph_rms<1>(in, L, hbuf, ws, lds); else ph_rms<2>(in, L, hbuf, ws, lds); }
        SEAM(pb + 7);
        if (IN(pb + 8) && ON(8)) { if (L == 0) { ph_gemm_gu(ws, lds); if (DUP(8)) { __syncthreads(); ph_gemm_gu(ws, lds); } } else ph_moe_permute(ws, lds); }
        SEAM(pb + 8);
        if (IN(pb + 9) && ON(9)) { if (L == 0) ph_act_quant(L, ws); else { ph_moe_gu(ws, lds); if (DUP(9)) { __syncthreads(); ph_moe_gu(ws, lds); } } }
        SEAM(pb + 9);
        if (IN(pb + 10) && ON(10)) { if (L == 0) ph_gemm_resid<1>(in, L, hbuf, ws, lds); else ph_act_quant(L, ws); }
        SEAM(pb + 10);
        if (IN(pb + 11) && ON(11)) { if (L == 1) { ph_moe_down(ws, lds); if (DUP(10)) { __syncthreads(); ph_moe_down(ws, lds); } } else ph_h_quant(hbuf, ws); }
        SEAM(pb + 11);
        if (IN(pb + 12) && ON(12)) { if (L == 1) ph_moe_combine(ws, hbuf); }
        if (L == 1) SEAM(pb + 12);
        if (IN(pb + 13) && ON(12)) ph_gemm_ple(L, hbuf, ws, lds);
        SEAM(pb + 13);
    }
__global__ void __launch_bounds__(NTHR, 2) mk_fwd(Args a) {
    extern __shared__ __attribute__((aligned(16))) unsigned char lds_raw[];
    LAS unsigned char* lds = (LAS unsigned char*)lds_raw;
    volatile LAS unsigned* MISC = (volatile LAS unsigned*)(lds + MISC_OFF);
    InP in = (InP)__builtin_amdgcn_kernarg_segment_ptr();
    const int tid = threadIdx.x;
    unsigned char* ws = a.ws; unsigned* ctl = (unsigned*)(ws + WS_CTL);
    if (tid < 64) MISC[tid] = 0u;
    __syncthreads();
    XcdBarrier bar = xcd_barrier_post(ctl + CW_BAR, MISC + 8);
    const int lo = a.ph_lo, hi = a.ph_hi;
    float* hbuf = a.out;

    if (IN(0) && ON(13)) { ph_prologue(in, ws, lds); if (DUP(13)) { __syncthreads(); ph_prologue(in, ws, lds); } }
    SEAM(0);
    layer_phases<0>(in, hbuf, ws, lds, bar, lo, hi);
    layer_phases<1>(in, hbuf, ws, lds, bar, lo, hi);
}

extern "C" void kernel_launch(void* const* d_in, const int* in_sizes, int n_in, void* d_out, int out_size, void* d_ws, size_t ws_size, hipStream_t stream) {
    static int grid = 0;
    if (grid == 0) {
        if (n_in != 33 || out_size != T * DM || ws_size < WS_END) { fprintf(stderr, "kernel_launch: unexpected shapes (n_in %d, out %d, ws %zu < %zu); nothing launched\n", n_in, out_size, ws_size, (size_t)WS_END); grid = -1; return; }
        int dev = 0, cus = 0, per_cu = 0;
        if (hipGetDevice(&dev) != hipSuccess || hipDeviceGetAttribute(&cus, hipDeviceAttributeMultiprocessorCount, dev) != hipSuccess) { grid = -1; return; }
        if (hipFuncSetAttribute((const void*)mk_fwd, hipFuncAttributeMaxDynamicSharedMemorySize, LDS_BYTES) != hipSuccess) { fprintf(stderr, "kernel_launch: hipFuncSetAttribute failed\n"); grid = -1; return; }
        if (hipOccupancyMaxActiveBlocksPerMultiprocessor(&per_cu, (const void*)mk_fwd, NTHR, LDS_BYTES) != hipSuccess || per_cu < 1) { fprintf(stderr, "kernel_launch: occupancy query says %d\n", per_cu); }
        (void)hipGetLastError();
        grid = cus;
    }
    if (grid < 0) return;
    (void)hipMemsetAsync((char*)d_ws + WS_CTL, 0, CTL_ZERO_BYTES, stream);
    Args a{};
    for (int i = 0; i < 33; ++i) a.in.p[i] = (const float*)d_in[i];
    a.out = (float*)d_out; a.ws = (unsigned char*)d_ws;
#if MK_PER_PHASE
#ifndef MK_MAXPH
#define MK_MAXPH N_PHASES
#endif
    for (int ph = 0; ph < MK_MAXPH; ++ph) {
        if (ph == 1 + 12) continue;
        a.ph_lo = ph; a.ph_hi = ph + 1;
        hipLaunchKernelGGL(mk_fwd, dim3(grid), dim3(NTHR), LDS_BYTES, stream, a);
    }
#else
    a.ph_lo = 0; a.ph_hi = N_PHASES;
    hipLaunchKernelGGL(mk_fwd, dim3(grid), dim3(NTHR), LDS_BYTES, stream, a);
#endif
}
```

```cpp
#include <hip/hip_runtime.h>
#include <cstdio>
#include <cstdint>

#define GAS __attribute__((address_space(1)))
#define LAS __attribute__((address_space(3)))
typedef unsigned short bf16;
typedef unsigned short bf16_t;
typedef unsigned v4u __attribute__((ext_vector_type(4)));
typedef unsigned v2u __attribute__((ext_vector_type(2)));
typedef float f32x4 __attribute__((ext_vector_type(4)));
typedef float f32x2 __attribute__((ext_vector_type(2)));
typedef short bf16x8 __attribute__((ext_vector_type(8)));
typedef short s16x4 __attribute__((ext_vector_type(4)));
typedef unsigned u32x4 __attribute__((ext_vector_type(4)));
typedef GAS unsigned gu32;
#define RLX_AGENT __ATOMIC_RELAXED, __HIP_MEMORY_SCOPE_AGENT
#define LDS_WAIT() asm volatile("s_waitcnt lgkmcnt(0)" ::: "memory")
#define VM_WAIT() asm volatile("s_waitcnt vmcnt(0)" ::: "memory")

typedef __bf16 bf16x2_t __attribute__((ext_vector_type(2)));
__device__ __forceinline__ unsigned cvt_pk_bf16(float lo, float hi) { unsigned r; asm volatile("v_cvt_pk_bf16_f32 %0, %1, %2" : "=v"(r) : "v"(lo), "v"(hi)); return r; }
__device__ __forceinline__ unsigned cvt_pk_bf16_cv(float lo, float hi) { f32x2 v = {lo, hi}; bf16x2_t b = __builtin_convertvector(v, bf16x2_t); return __builtin_bit_cast(unsigned, b); }
__device__ __forceinline__ float bf2f(unsigned short b) { return __uint_as_float(((unsigned)b) << 16); }
__device__ __forceinline__ float bflo(unsigned w) { return __uint_as_float(w << 16); }
__device__ __forceinline__ float bfhi(unsigned w) { return __uint_as_float(w & 0xffff0000u); }
__device__ __forceinline__ unsigned short f2bf(float f) { return (unsigned short)(cvt_pk_bf16(f, 0.f) & 0xffffu); }
__device__ __forceinline__ float sigmoidf_(float x) { return __builtin_amdgcn_rcpf(1.0f + __expf(-x)); }
__device__ __forceinline__ float siluf_(float x) { return x * __builtin_amdgcn_rcpf(1.0f + __expf(-x)); }
__device__ __forceinline__ float softplusf_(float x) { return x > 20.f ? x : log1pf(__expf(x)); }
template <int X> __device__ __forceinline__ float shx(float v) {
    return __int_as_float(__builtin_amdgcn_ds_swizzle(__float_as_int(v), (X << 10) | 0x1f)); }
__device__ __forceinline__ float sum32(float v) { auto r = __builtin_amdgcn_permlane32_swap(__float_as_uint(v), __float_as_uint(v), false, false); return __uint_as_float(r[0]) + __uint_as_float(r[1]); }
__device__ __forceinline__ float max32(float v) { auto r = __builtin_amdgcn_permlane32_swap(__float_as_uint(v), __float_as_uint(v), false, false); return fmaxf(__uint_as_float(r[0]), __uint_as_float(r[1])); }
__device__ __forceinline__ float other32(float v, int lane) { auto r = __builtin_amdgcn_permlane32_swap(__float_as_uint(v), __float_as_uint(v), false, false); return __uint_as_float(lane < 32 ? r[1] : r[0]); }
__device__ __forceinline__ float wave_sum(float v) {
    v += shx<1>(v); v += shx<2>(v); v += shx<4>(v); v += shx<8>(v); v += shx<16>(v); return sum32(v); }
__device__ __forceinline__ float wave_scan(float v, int lane) {
    asm volatile("" : "+v"(lane));
#pragma unroll
    for (int o = 1; o < 64; o <<= 1) { const float t = __int_as_float(__builtin_amdgcn_ds_bpermute(((lane - o) & 63) << 2, __float_as_int(v))); if (lane >= o) v += t; }
    return v; }

namespace pg8 {
#define PG8_LAS __attribute__((address_space(3)))
constexpr int BM = 256, BK = 64, HALF = 128, HTB = HALF * BK * 2  , STAGE_BYTES = 8 * HTB, NXCD = 8, WGM = 4;

__host__ __device__ __forceinline__ int lds_byte(int r, int c) { const int st = (r >> 4) * 2 + (c >> 5), rr = r & 15, cc = c & 31, ob = rr * 64 + cc * 2; return st * 1024 + (ob ^ (((ob >> 9) & 1) << 5)); }
__host__ __device__ __forceinline__ void stage_rc(int b, int& R, int& C) { const int st = b / 1024, sb = b % 1024, swz = sb ^ (((sb >> 9) & 1) << 5); R = (st >> 1) * 16 + swz / 64; C = (st & 1) * 32 + (swz % 64) / 2; }
__host__ __device__ __forceinline__ int perm32(int rho) { const int n = rho >> 4, i = rho & 15; return 8 * (i >> 2) + 4 * n + (i & 3); }

struct Unit { int pm, pn, pb; };
struct Gemm { const void* A; const void* Bt; int M, N, K; int ldaB; };
typedef int i32x4 __attribute__((ext_vector_type(4)));
template <int ES> __device__ __forceinline__ f32x4 mma16(bf16x8 a, bf16x8 b, f32x4 c) {
    if constexpr (ES == 2) return __builtin_amdgcn_mfma_f32_16x16x32_bf16(a, b, c, 0, 0, 0);
    else return __builtin_bit_cast(f32x4, __builtin_amdgcn_mfma_i32_16x16x64_i8(__builtin_bit_cast(i32x4, a), __builtin_bit_cast(i32x4, b), __builtin_bit_cast(i32x4, c), 0, 0, 0)); }

struct StaticOrder {
    int nM, nN, nwg, G, c;
    __host__ __device__ void init(int M, int N, int G_, int c_) { nM = M / BM; nN = N / BM; nwg = nM * nN; G = G_; c = c_; }
    __host__ __device__ bool next(int i, Unit& u) const {
        const long L = (long)i * G + c; if (L >= nwg) return false;
        int wgid = (int)L; { const int q = nwg / NXCD, r = nwg % NXCD, xcd = wgid % NXCD, off = wgid / NXCD; wgid = (xcd < r ? xcd * (q + 1) : r * (q + 1) + (xcd - r) * q) + off; }
        const int nig = WGM * nN, gid = wgid / nig, fm = gid * WGM, gsz = (nM - fm) < WGM ? (nM - fm) : WGM;
        u.pm = fm + ((wgid % nig) % gsz); u.pn = (wgid % nig) / gsz; u.pb = u.pn; return true;
    }
    __device__ __forceinline__ void a_ready(const Unit&) const {}
    __device__ __forceinline__ void done(const Unit&) const {}
};
struct GroupOrder {
    int t1, t2, t3, t4, t5, t6, t7, t8;
    int nN, nwg, G, c;
    __device__ void init(const int* toff, int nN_, int G_, int c_) {
        t1 = toff[1]; t2 = toff[2]; t3 = toff[3]; t4 = toff[4]; t5 = toff[5]; t6 = toff[6]; t7 = toff[7]; t8 = toff[8];
        nN = nN_; G = G_; c = c_; nwg = t8 * nN; }
    __device__ bool next(int i, Unit& u) const {
        int wgid = (i * G) + (c % NXCD) * (G / NXCD) + c / NXCD;
        if (wgid >= nwg) return false;
        const int tt = wgid / nN;
        int e = 0, b0 = 0, b1 = t1;
        if (wgid >= t1 * nN) { e = 1; b0 = t1; b1 = t2; }
        if (wgid >= t2 * nN) { e = 2; b0 = t2; b1 = t3; }
        if (wgid >= t3 * nN) { e = 3; b0 = t3; b1 = t4; }
        if (wgid >= t4 * nN) { e = 4; b0 = t4; b1 = t5; }
        if (wgid >= t5 * nN) { e = 5; b0 = t5; b1 = t6; }
        if (wgid >= t6 * nN) { e = 6; b0 = t6; b1 = t7; }
        if (wgid >= t7 * nN) { e = 7; b0 = t7; b1 = t8; }
        (void)tt;
        const int loc = wgid - b0 * nN, nMe = b1 - b0;
        const int nig = WGM * nN, gid = loc / nig, fm = gid * WGM, gsz = (nMe - fm) < WGM ? (nMe - fm) : WGM;
        u.pm = b0 + fm + ((loc % nig) % gsz); u.pn = (loc % nig) / gsz; u.pb = e * nN + u.pn; return true;
    }
    __device__ __forceinline__ void a_ready(const Unit&) const {}
    __device__ __forceinline__ void done(const Unit&) const {}
};

struct EpiBf16Plain {
    static constexpr bool PERM = true;
    bf16_t* O; int ldc;
    __device__ __forceinline__ void operator()(const f32x4 (&acc)[2][2][4][2], const Unit& u, int wr, int wc, int fr, int fq) const {
        const int row0 = u.pm * BM + wr * 64 + fr, col0 = u.pn * BM + wc * 32 + 8 * fq;
#pragma unroll
        for (int ai = 0; ai < 2; ++ai)
#pragma unroll
            for (int m = 0; m < 4; ++m) { bf16_t* rowp = O + (size_t)(row0 + ai * HALF + m * 16) * ldc + col0;
#pragma unroll
                for (int bj = 0; bj < 2; ++bj) { const f32x4 v0 = acc[ai][bj][m][0], v1 = acc[ai][bj][m][1];
                    u32x4 w; w.x = cvt_pk_bf16(v0[0], v0[1]); w.y = cvt_pk_bf16(v0[2], v0[3]); w.z = cvt_pk_bf16(v1[0], v1[1]); w.w = cvt_pk_bf16(v1[2], v1[3]);
                    *(u32x4*)(rowp + bj * HALF) = w; } }
    }
};
struct EpiBf16Plain8 {
    static constexpr bool PERM = true;
    bf16_t* O; int ldc; const float* sa; const float* sw;
    __device__ __forceinline__ void operator()(const f32x4 (&acc)[2][2][4][2], const Unit& u, int wr, int wc, int fr, int fq) const {
        const int row0 = u.pm * BM + wr * 64 + fr, col0 = u.pn * BM + wc * 32 + 8 * fq, wrow0 = u.pb * BM + wc * 32 + 8 * fq;
        f32x4 s0[2], s1[2];
#pragma unroll
        for (int bj = 0; bj < 2; ++bj) { s0[bj] = *(const f32x4*)(sw + wrow0 + bj * HALF); s1[bj] = *(const f32x4*)(sw + wrow0 + bj * HALF + 4); }
#pragma unroll
        for (int ai = 0; ai < 2; ++ai)
#pragma unroll
            for (int m = 0; m < 4; ++m) { const int row = row0 + ai * HALF + m * 16; bf16_t* rowp = O + (size_t)row * ldc + col0; const float s = sa[row];
#pragma unroll
                for (int bj = 0; bj < 2; ++bj) { const i32x4 a = __builtin_bit_cast(i32x4, acc[ai][bj][m][0]), b = __builtin_bit_cast(i32x4, acc[ai][bj][m][1]);
                    u32x4 w; w.x = cvt_pk_bf16((float)a[0] * s * s0[bj][0], (float)a[1] * s * s0[bj][1]); w.y = cvt_pk_bf16((float)a[2] * s * s0[bj][2], (float)a[3] * s * s0[bj][3]);
                    w.z = cvt_pk_bf16((float)b[0] * s * s1[bj][0], (float)b[1] * s * s1[bj][1]); w.w = cvt_pk_bf16((float)b[2] * s * s1[bj][2], (float)b[3] * s * s1[bj][3]);
                    *(u32x4*)(rowp + bj * HALF) = w; } }
    }
};
struct EpiSwiGLU {
    static constexpr bool PERM = true;
    bf16_t* O; int ldc;
    __device__ __forceinline__ void operator()(const f32x4 (&acc)[2][2][4][2], const Unit& u, int wr, int wc, int fr, int fq) const {
        const int row0 = u.pm * BM + wr * 64 + fr, col0 = u.pn * HALF + wc * 32 + 8 * fq;
#pragma unroll
        for (int ai = 0; ai < 2; ++ai)
#pragma unroll
            for (int m = 0; m < 4; ++m) { bf16_t* rowp = O + (size_t)(row0 + ai * HALF + m * 16) * ldc + col0;
                float r[8];
#pragma unroll
                for (int n = 0; n < 2; ++n)
#pragma unroll
                    for (int j = 0; j < 4; ++j) { const float g = acc[ai][0][m][n][j], up = acc[ai][1][m][n][j]; r[n * 4 + j] = siluf_(g) * up; }
                u32x4 w; w.x = cvt_pk_bf16(r[0], r[1]); w.y = cvt_pk_bf16(r[2], r[3]); w.z = cvt_pk_bf16(r[4], r[5]); w.w = cvt_pk_bf16(r[6], r[7]);
                *(u32x4*)rowp = w; }
    }
};
struct EpiSwiGLU8 {
    static constexpr bool PERM = true;
    bf16_t* O; int ldc; const float* sa; const float* sw;
    __device__ __forceinline__ void operator()(const f32x4 (&acc)[2][2][4][2], const Unit& u, int wr, int wc, int fr, int fq) const {
        const int row0 = u.pm * BM + wr * 64 + fr, col0 = u.pn * HALF + wc * 32 + 8 * fq, wrow0 = u.pb * BM + wc * 32 + 8 * fq;
        const f32x4 g0 = *(const f32x4*)(sw + wrow0), g1 = *(const f32x4*)(sw + wrow0 + 4), u0 = *(const f32x4*)(sw + wrow0 + HALF), u1 = *(const f32x4*)(sw + wrow0 + HALF + 4);
#pragma unroll
        for (int ai = 0; ai < 2; ++ai)
#pragma unroll
            for (int m = 0; m < 4; ++m) { const int row = row0 + ai * HALF + m * 16; bf16_t* rowp = O + (size_t)row * ldc + col0; const float s = sa[row];
                float r[8];
#pragma unroll
                for (int n = 0; n < 2; ++n)
#pragma unroll
                    for (int j = 0; j < 4; ++j) { const i32x4 gi = __builtin_bit_cast(i32x4, acc[ai][0][m][n]), ui = __builtin_bit_cast(i32x4, acc[ai][1][m][n]);
                        const float g = (float)gi[j] * s * (n ? g1[j] : g0[j]), up = (float)ui[j] * s * (n ? u1[j] : u0[j]); r[n * 4 + j] = siluf_(g) * up; }
                u32x4 w; w.x = cvt_pk_bf16(r[0], r[1]); w.y = cvt_pk_bf16(r[2], r[3]); w.z = cvt_pk_bf16(r[4], r[5]); w.w = cvt_pk_bf16(r[6], r[7]);
                *(u32x4*)rowp = w; }
    }
};
struct EpiResid {
    static constexpr bool PERM = false;
    const float* base; float* out; bf16_t* ob; int ldc;
    __device__ __forceinline__ void operator()(const f32x4 (&acc)[2][2][4][2], const Unit& u, int wr, int wc, int fr, int fq) const {
        const int row0 = u.pm * BM + wr * 64 + fr, col0 = u.pn * BM + wc * 32 + 4 * fq;
#pragma unroll
        for (int ai = 0; ai < 2; ++ai)
#pragma unroll
            for (int m = 0; m < 4; ++m) { const size_t off = (size_t)(row0 + ai * HALF + m * 16) * ldc + col0;
#pragma unroll
                for (int bj = 0; bj < 2; ++bj)
#pragma unroll
                    for (int n = 0; n < 2; ++n) { const size_t o2 = off + bj * HALF + n * 16; const f32x4 r = *(const f32x4*)(base + o2) + acc[ai][bj][m][n];
                        *(f32x4*)(out + o2) = r;
                        if (ob) { v2u w; w.x = cvt_pk_bf16(r[0], r[1]); w.y = cvt_pk_bf16(r[2], r[3]); *(v2u*)(ob + o2) = w; } } }
    }
};
struct EpiResid8 {
    static constexpr bool PERM = false;
    const float* base; float* out; bf16_t* ob; int ldc; const float* sa; const float* sw;
    __device__ __forceinline__ void operator()(const f32x4 (&acc)[2][2][4][2], const Unit& u, int wr, int wc, int fr, int fq) const {
        const int row0 = u.pm * BM + wr * 64 + fr, col0 = u.pn * BM + wc * 32 + 4 * fq;
        f32x4 sc[2][2];
#pragma unroll
        for (int bj = 0; bj < 2; ++bj)
#pragma unroll
            for (int n = 0; n < 2; ++n) sc[bj][n] = *(const f32x4*)(sw + col0 + bj * HALF + n * 16);
#pragma unroll
        for (int ai = 0; ai < 2; ++ai)
#pragma unroll
            for (int m = 0; m < 4; ++m) { const int row = row0 + ai * HALF + m * 16; const size_t off = (size_t)row * ldc + col0; const float s = sa[row];
#pragma unroll
                for (int bj = 0; bj < 2; ++bj)
#pragma unroll
                    for (int n = 0; n < 2; ++n) { const size_t o2 = off + bj * HALF + n * 16; const i32x4 a = __builtin_bit_cast(i32x4, acc[ai][bj][m][n]); f32x4 r = *(const f32x4*)(base + o2);
                        r[0] += (float)a[0] * s * sc[bj][n][0]; r[1] += (float)a[1] * s * sc[bj][n][1]; r[2] += (float)a[2] * s * sc[bj][n][2]; r[3] += (float)a[3] * s * sc[bj][n][3];
                        *(f32x4*)(out + o2) = r;
                        if (ob) { v2u w; w.x = cvt_pk_bf16(r[0], r[1]); w.y = cvt_pk_bf16(r[2], r[3]); *(v2u*)(ob + o2) = w; } } }
    }
};
struct EpiPeSS {
    static constexpr bool PERM = true;
    bf16_t* O; int ldc; const float* g; float* ss;
    __device__ __forceinline__ void operator()(const f32x4 (&acc)[2][2][4][2], const Unit& u, int wr, int wc, int fr, int fq) const {
        const int row0 = u.pm * BM + wr * 64 + fr, col0 = u.pn * BM + wc * 32 + 8 * fq;
#pragma unroll
        for (int ai = 0; ai < 2; ++ai)
#pragma unroll
            for (int m = 0; m < 4; ++m) { const int row = row0 + ai * HALF + m * 16; bf16_t* rowp = O + (size_t)row * ldc + col0; float q = 0.f;
#pragma unroll
                for (int bj = 0; bj < 2; ++bj) { const f32x4 v0 = acc[ai][bj][m][0], v1 = acc[ai][bj][m][1];
                    const f32x4 ga = *(const f32x4*)(g + col0 + bj * HALF), gb = *(const f32x4*)(g + col0 + bj * HALF + 4);
                    q += (v0[0] * v0[0] + v0[1] * v0[1]) + (v0[2] * v0[2] + v0[3] * v0[3]) + (v1[0] * v1[0] + v1[1] * v1[1]) + (v1[2] * v1[2] + v1[3] * v1[3]);
                    u32x4 w; w.x = cvt_pk_bf16(v0[0] * ga[0], v0[1] * ga[1]); w.y = cvt_pk_bf16(v0[2] * ga[2], v0[3] * ga[3]);
                    w.z = cvt_pk_bf16(v1[0] * gb[0], v1[1] * gb[1]); w.w = cvt_pk_bf16(v1[2] * gb[2], v1[3] * gb[3]);
                    *(u32x4*)(rowp + bj * HALF) = w; }
                q += shx<16>(q); q = sum32(q);
                if (fq == 0) ss[(size_t)row * 32 + u.pn * 4 + wc] = q;
                asm volatile("" ::: "memory"); }
    }
};
struct EpiPle8 {
    static constexpr bool PERM = false;
    float* h; const bf16_t* e; int ldc; const float* sa; const float* sw; const float* ss;
    __device__ __forceinline__ void operator()(const f32x4 (&acc)[2][2][4][2], const Unit& u, int wr, int wc, int fr, int fq) const {
        const int row0 = u.pm * BM + wr * 64 + fr, col0 = u.pn * BM + wc * 32 + 4 * fq;
        f32x4 sc[2][2];
#pragma unroll
        for (int bj = 0; bj < 2; ++bj)
#pragma unroll
            for (int n = 0; n < 2; ++n) sc[bj][n] = *(const f32x4*)(sw + col0 + bj * HALF + n * 16);
#pragma unroll
        for (int ai = 0; ai < 2; ++ai)
#pragma unroll
            for (int m = 0; m < 4; ++m) { const int row = row0 + ai * HALF + m * 16; const size_t off = (size_t)row * ldc + col0; const float s = sa[row]; const float rse = ss[row];
#pragma unroll
                for (int bj = 0; bj < 2; ++bj)
#pragma unroll
                    for (int n = 0; n < 2; ++n) { const size_t o2 = off + bj * HALF + n * 16; const i32x4 a = __builtin_bit_cast(i32x4, acc[ai][bj][m][n]); const v2u ew = *(const v2u*)(e + o2);
                        f32x4 r = *(const f32x4*)(h + o2);
                        r[0] += sigmoidf_((float)a[0] * s * sc[bj][n][0]) * (bflo(ew.x) * rse); r[1] += sigmoidf_((float)a[1] * s * sc[bj][n][1]) * (bfhi(ew.x) * rse);
                        r[2] += sigmoidf_((float)a[2] * s * sc[bj][n][2]) * (bflo(ew.y) * rse); r[3] += sigmoidf_((float)a[3] * s * sc[bj][n][3]) * (bfhi(ew.y) * rse);
                        *(f32x4*)(h + o2) = r; } }
    }
};
struct EpiPle {
    static constexpr bool PERM = false;
    float* h; const bf16_t* e; int ldc;
    __device__ __forceinline__ void operator()(const f32x4 (&acc)[2][2][4][2], const Unit& u, int wr, int wc, int fr, int fq) const {
        const int row0 = u.pm * BM + wr * 64 + fr, col0 = u.pn * BM + wc * 32 + 4 * fq;
#pragma unroll
        for (int ai = 0; ai < 2; ++ai)
#pragma unroll
            for (int m = 0; m < 4; ++m) { const size_t off = (size_t)(row0 + ai * HALF + m * 16) * ldc + col0;
#pragma unroll
                for (int bj = 0; bj < 2; ++bj)
#pragma unroll
                    for (int n = 0; n < 2; ++n) { const size_t o2 = off + bj * HALF + n * 16; const f32x4 a = acc[ai][bj][m][n]; const v2u ew = *(const v2u*)(e + o2);
                        f32x4 r = *(const f32x4*)(h + o2);
                        r[0] += sigmoidf_(a[0]) * bflo(ew.x); r[1] += sigmoidf_(a[1]) * bfhi(ew.x); r[2] += sigmoidf_(a[2]) * bflo(ew.y); r[3] += sigmoidf_(a[3]) * bfhi(ew.y);
                        *(f32x4*)(h + o2) = r; } }
    }
};

template <class Epi, class Sched, bool ALIGN_EPI = false, bool SP2 = false, int ES = 2  >
__device__ __forceinline__ void gemm_phase(PG8_LAS unsigned char* lds, const Gemm g, const Sched& S, const Epi& E) {
    int tid_ = threadIdx.x; asm volatile("" : "+v"(tid_));
    const int tid = tid_, wid = __builtin_amdgcn_readfirstlane(tid >> 6), lane = tid & 63, wr = wid >> 2, wc = wid & 3, fr = lane & 15, fq = lane >> 4;
    const int K = g.K, nt = (K * ES) / (BK * 2), ldaB = g.ldaB ? g.ldaB : K * ES;
    unsigned voffA[2], voffB[2];
#pragma unroll
    for (int i = 0; i < 2; ++i) { int R, C; stage_rc(tid * 16 + i * 8192, R, C); const int Rb = Epi::PERM ? ((R & ~31) + perm32(R & 31)) : R;
        voffA[i] = (unsigned)(R * ldaB + C * 2); voffB[i] = (unsigned)(Rb * K * ES + C * 2); }
    const size_t kstep = (size_t)(BK * 2);
    const size_t hstep = (size_t)HALF * K * ES;
    const size_t tstep = 2 * hstep;
    const size_t hstepA = (size_t)HALF * ldaB, tstepA = 2 * hstepA;
    const unsigned ldsw = (unsigned)wid * 1024u;
    const int aoff = lds_byte(wr * 64 + fr, fq * 8), boff = lds_byte(wc * 32 + fr, fq * 8);
#define PG8_SA(b, h) (((b) * 2 + (h)) * HTB)
#define PG8_SB(b, h) ((4 + (b) * 2 + (h)) * HTB)
#define PG8_STAGE(bufoff, gbase, voff) do { _Pragma("unroll") for (int _i = 0; _i < 2; ++_i) \
        __builtin_amdgcn_global_load_lds((const unsigned*)((const char*)(gbase) + (voff)[_i]), (PG8_LAS unsigned*)(lds + (bufoff) + ldsw + _i * 8192), 16, 0, 0); } while (0)
#define PG8_LDA(dst, b, h) do { _Pragma("unroll") for (int m = 0; m < 4; ++m) _Pragma("unroll") for (int k = 0; k < 2; ++k) dst[m][k] = *(const PG8_LAS bf16x8*)(lds + PG8_SA(b, h) + aoff + m * 2048 + k * 1024); } while (0)
#define PG8_LDB(dst, b, h) do { _Pragma("unroll") for (int n = 0; n < 2; ++n) _Pragma("unroll") for (int k = 0; k < 2; ++k) dst[n][k] = *(const PG8_LAS bf16x8*)(lds + PG8_SB(b, h) + boff + n * 2048 + k * 1024); } while (0)
#define PG8_MMA(ai, bj, At, Bt) do { __builtin_amdgcn_s_setprio(1); _Pragma("unroll") for (int m = 0; m < 4; ++m) _Pragma("unroll") for (int n = 0; n < 2; ++n) _Pragma("unroll") for (int k = 0; k < 2; ++k) \
        acc[ai][bj][m][n] = mma16<ES>(Bt[n][k], At[m][k], acc[ai][bj][m][n]); __builtin_amdgcn_s_setprio(0); } while (0)
#define PG8_WAIT_V(n) asm volatile("s_waitcnt vmcnt(" #n ")" ::: "memory")
#define PG8_WAIT_L(n) asm volatile("s_waitcnt lgkmcnt(" #n ")" ::: "memory")
#define PG8_BAR __builtin_amdgcn_s_barrier()
#define PG8_SCHED __builtin_amdgcn_sched_barrier(0)
    Unit cur, nxt; int ui = 0;
    if (!S.next(0, cur)) return;
    f32x4 acc[2][2][4][2];
#pragma unroll
    for (int a = 0; a < 2; ++a)
#pragma unroll
        for (int b = 0; b < 2; ++b)
#pragma unroll
            for (int m = 0; m < 4; ++m)
#pragma unroll
                for (int n = 0; n < 2; ++n) acc[a][b][m][n] = (f32x4){0.f, 0.f, 0.f, 0.f};
    bf16x8 At[4][2], B0[2][2], B1[2][2];
    const char* cA = (const char*)g.A + (size_t)cur.pm * tstepA; const char* cB = (const char*)g.Bt + (size_t)cur.pb * tstep;
    S.a_ready(cur);
    if constexpr (SP2) {
        PG8_STAGE(PG8_SB(0, 0), cB, voffB); PG8_STAGE(PG8_SB(0, 1), cB + hstep, voffB); PG8_STAGE(PG8_SA(0, 0), cA, voffA); PG8_STAGE(PG8_SA(0, 1), cA + hstepA, voffA);
        if (wr == 1) PG8_BAR;
        PG8_WAIT_V(2); PG8_BAR;
        PG8_STAGE(PG8_SB(1, 0), cB + kstep, voffB); PG8_STAGE(PG8_SA(1, 0), cA + kstep, voffA); PG8_STAGE(PG8_SB(1, 1), cB + hstep + kstep, voffB);
        PG8_WAIT_V(6); PG8_BAR;
    } else {
        PG8_STAGE(PG8_SB(0, 0), cB, voffB); PG8_STAGE(PG8_SA(0, 0), cA, voffA); PG8_STAGE(PG8_SB(0, 1), cB + hstep, voffB); PG8_STAGE(PG8_SA(0, 1), cA + hstepA, voffA);
        if (wr == 1) PG8_BAR;
        PG8_WAIT_V(4); PG8_BAR;
        PG8_STAGE(PG8_SB(1, 0), cB + kstep, voffB); PG8_STAGE(PG8_SA(1, 0), cA + kstep, voffA); PG8_STAGE(PG8_SB(1, 1), cB + hstep + kstep, voffB);
        PG8_WAIT_V(6); PG8_BAR;
    }
    for (;;) {
        const bool has_next = S.next(ui + 1, nxt);
        const char* nA = has_next ? (const char*)g.A + (size_t)nxt.pm * tstepA : cA; const char* nB = has_next ? (const char*)g.Bt + (size_t)nxt.pb * tstep : cB;
        for (int t = 0; t < nt; t += 2) {
            const bool last = (t == nt - 2);
            const char* a1 = cA + (size_t)(t + 1) * kstep;
            const char* a2 = last ? nA : cA + (size_t)(t + 2) * kstep; const char* b2 = last ? nB : cB + (size_t)(t + 2) * kstep;
            const char* a3 = a2 + kstep; const char* b3 = b2 + kstep;
            if (last && has_next) S.a_ready(nxt);
            if constexpr (SP2) {
            PG8_LDB(B0, 0, 0); PG8_LDB(B1, 0, 1); PG8_SCHED; PG8_LDA(At, 0, 0); PG8_STAGE(PG8_SA(1, 1), a1 + hstepA, voffA);
            PG8_WAIT_V(8); PG8_WAIT_L(0); PG8_BAR; PG8_MMA(0, 0, At, B0); PG8_MMA(0, 1, At, B1); PG8_BAR; PG8_SCHED;
            PG8_LDA(At, 0, 1); PG8_STAGE(PG8_SB(0, 0), b2, voffB); PG8_STAGE(PG8_SB(0, 1), b2 + hstep, voffB); PG8_STAGE(PG8_SA(0, 0), a2, voffA);
            PG8_WAIT_V(8); PG8_WAIT_L(0); PG8_BAR; PG8_MMA(1, 0, At, B0); PG8_MMA(1, 1, At, B1); PG8_BAR; PG8_SCHED;
            PG8_LDB(B0, 1, 0); PG8_LDB(B1, 1, 1); PG8_SCHED; PG8_LDA(At, 1, 0); PG8_STAGE(PG8_SA(0, 1), a2 + hstepA, voffA);
            PG8_WAIT_V(8); PG8_WAIT_L(0); PG8_BAR; PG8_MMA(0, 0, At, B0); PG8_MMA(0, 1, At, B1); PG8_BAR; PG8_SCHED;
            PG8_LDA(At, 1, 1); PG8_STAGE(PG8_SB(1, 0), b3, voffB); PG8_STAGE(PG8_SB(1, 1), b3 + hstep, voffB); PG8_STAGE(PG8_SA(1, 0), a3, voffA);
            PG8_WAIT_V(8); PG8_WAIT_L(0); PG8_BAR; PG8_MMA(1, 0, At, B0); PG8_MMA(1, 1, At, B1); PG8_BAR; PG8_SCHED;
            } else {
            PG8_LDB(B0, 0, 0); PG8_SCHED; PG8_LDA(At, 0, 0); PG8_STAGE(PG8_SA(1, 1), a1 + hstepA, voffA);
            PG8_WAIT_L(8); PG8_BAR; PG8_WAIT_L(0); PG8_MMA(0, 0, At, B0); PG8_BAR; PG8_SCHED;
            PG8_LDB(B1, 0, 1); PG8_STAGE(PG8_SB(0, 0), b2, voffB);
            PG8_BAR; PG8_WAIT_L(0); PG8_MMA(0, 1, At, B1); PG8_BAR;
            PG8_LDA(At, 0, 1); PG8_STAGE(PG8_SA(0, 0), a2, voffA);
            PG8_BAR; PG8_WAIT_L(0); PG8_MMA(1, 0, At, B0); PG8_BAR; PG8_SCHED;
            PG8_STAGE(PG8_SB(0, 1), b2 + hstep, voffB);
            PG8_WAIT_V(6); PG8_BAR; PG8_MMA(1, 1, At, B1); PG8_BAR;
            PG8_LDB(B0, 1, 0); PG8_SCHED; PG8_LDA(At, 1, 0); PG8_STAGE(PG8_SA(0, 1), a2 + hstepA, voffA);
            PG8_WAIT_L(8); PG8_BAR; PG8_WAIT_L(0); PG8_MMA(0, 0, At, B0); PG8_BAR; PG8_SCHED;
            PG8_LDB(B1, 1, 1); PG8_STAGE(PG8_SB(1, 0), b3, voffB);
            PG8_BAR; PG8_WAIT_L(0); PG8_MMA(0, 1, At, B1); PG8_BAR;
            PG8_LDA(At, 1, 1); PG8_STAGE(PG8_SA(1, 0), a3, voffA);
            PG8_BAR; PG8_WAIT_L(0); PG8_MMA(1, 0, At, B0); PG8_BAR; PG8_SCHED;
            PG8_STAGE(PG8_SB(1, 1), b3 + hstep, voffB);
            PG8_WAIT_V(6); PG8_BAR; PG8_MMA(1, 1, At, B1); PG8_BAR;
            }
        }
        if constexpr (ALIGN_EPI) { if (wr == 0) PG8_BAR; }
        E(acc, cur, wr, wc, fr, fq); S.done(cur);
#ifdef DBG_EPI2
        if (ES == 1) { asm volatile("" ::: "memory"); E(acc, cur, wr, wc, fr, fq); }
#endif
        if (!has_next) break;
#pragma unroll
        for (int a = 0; a < 2; ++a)
#pragma unroll
            for (int b = 0; b < 2; ++b)
#pragma unroll
                for (int m = 0; m < 4; ++m)
#pragma unroll
                    for (int n = 0; n < 2; ++n) acc[a][b][m][n] = (f32x4){0.f, 0.f, 0.f, 0.f};
        cur = nxt; cA = nA; cB = nB; ++ui;
        if constexpr (ALIGN_EPI) { if (wr == 1) PG8_BAR; }
    }
    PG8_WAIT_V(0);
    if constexpr (!ALIGN_EPI) { if (wr == 0) PG8_BAR; }
    PG8_BAR;
#undef PG8_SA
#undef PG8_SB
#undef PG8_STAGE
#undef PG8_LDA
#undef PG8_LDB
#undef PG8_MMA
#undef PG8_WAIT_V
#undef PG8_WAIT_L
#undef PG8_BAR
#undef PG8_SCHED
}
}

constexpr int NWAVES = 8, NTHR = 512;
constexpr int BATCH = 4, SEQ = 4096, T = BATCH * SEQ, DM = 2048, DEPTH = 2;
constexpr float EPS = 1e-6f;
constexpr int PLE_DIM = 256;
constexpr int GH = 4, GD = 128, GW = 512, GCH = 64, GNC = SEQ / GCH;
constexpr int SH = 16, SP = 64, SWD = 1024, SG = 2, SN = 128, SCH = 256, SNC = SEQ / SCH, SCONV = 1536;
constexpr int MH = 4, MQR = 384, MKVR = 256, MNOPE = 128, MROPE = 64, MQK = 192, MV = 128;
constexpr int D_IN = 5336, D_INP = 5376;
constexpr int FF0 = 5632, NEXP = 8, FFE = 7168;
constexpr int U_GQ = 0, U_GK = 512, U_GV = 1024, U_GZ = 1536, U_SZ = 2048, U_SX = 3072, U_MQ = 4608, U_MKV = 4992, U_MPE = 5248, U_GB = 5312, U_GA = 5316, U_SDT = 5320;
constexpr int S_GDN = 0, S_GBA = 2048, S_SZ = 2056, S_SX = 3080, S_SDT = 4616, S_MQ = 4632, S_MKV = 5016, S_MPE = 5272;
constexpr int MAXSLOT_TILES = 136, MAXSLOTS = MAXSLOT_TILES * 256;

constexpr size_t MiB = 1u << 20;
constexpr size_t al256(size_t x) { return (x + 255) & ~(size_t)255; }
constexpr size_t WS_CTL = 0, CTL_ZERO_BYTES = 1 * MiB;
constexpr size_t SZ_WIN = (size_t)D_INP * DM * 2, SZ_WOUT = (size_t)DM * DM * 2, SZ_WQB = (size_t)768 * MQR * 2, SZ_WKVB = (size_t)1024 * MKVR * 2;
constexpr size_t SZ_WGU = (size_t)2 * FF0 * DM * 2, SZ_WDN = (size_t)DM * FF0 * 2, SZ_WMGU = (size_t)NEXP * 2 * FFE * DM * 2, SZ_WMDN = (size_t)NEXP * DM * FFE * 2;
constexpr size_t SZ_WPP = (size_t)DM * PLE_DIM * 2, SZ_WPG = (size_t)DM * DM * 2;
constexpr size_t WS_WIN = 1 * MiB;
constexpr size_t WS_WOUT = WS_WIN + 2 * SZ_WIN;
constexpr size_t WS_WQB = WS_WOUT + 2 * SZ_WOUT;
constexpr size_t WS_WKVB = WS_WQB + 2 * SZ_WQB;
constexpr size_t WS_WGU = WS_WKVB + 2 * SZ_WKVB;
constexpr size_t WS_WDN = WS_WGU + SZ_WGU;
constexpr size_t WS_WMGU = WS_WDN + SZ_WDN;
constexpr size_t WS_WMDN = WS_WMGU + SZ_WMGU;
constexpr size_t WS_SWIN = WS_WIN + 2 * SZ_WIN - 1 * MiB;
constexpr size_t WS_SDD = WS_WDN + 12 * MiB;
constexpr size_t WS_SDM = WS_WMDN + 120 * MiB;
constexpr size_t WS_SA2 = WS_WMDN + 121 * MiB;
static_assert(SZ_WDN / 2 <= 12 * MiB && SZ_WMDN / 2 <= 120 * MiB && WS_SA2 + (size_t)MAXSLOTS * 4 <= WS_WMDN + SZ_WMDN, "int8 down map");
constexpr size_t WS_WPG8 = WS_WGU + 26 * MiB;
constexpr size_t WS_SPG = WS_WGU + 35 * MiB;
static_assert(WS_WPG8 + 2 * (size_t)DM * DM <= WS_SPG && WS_SPG + 16384 <= WS_WDN, "ple int8 map");
constexpr size_t WS_SWD = WS_WGU + 24 * MiB;
constexpr size_t WS_SWM = WS_WMGU + 236 * MiB;
constexpr size_t WS_HN8 = WS_WMGU + 240 * MiB;
constexpr size_t WS_SA = WS_WMGU + 280 * MiB;
constexpr size_t WS_SSP = WS_WMGU + 284 * MiB;
constexpr size_t WS_RSE = WS_WMGU + 290 * MiB;
constexpr size_t WS_XSC = WS_WMGU + 281 * MiB;
static_assert(SZ_WGU / 2 <= 24 * MiB && SZ_WMGU / 2 <= 236 * MiB && WS_XSC + (size_t)MAXSLOTS * 4 <= WS_WMDN && WS_HN8 + (size_t)T * DM <= WS_SA, "int8 map");
constexpr size_t WS_WPP = WS_WMDN + SZ_WMDN;
constexpr size_t WS_WPG = WS_WPP + 2 * SZ_WPP;
constexpr size_t WS_PB = WS_WPG + 2 * SZ_WPG;
constexpr size_t WS_ROPE = WS_PB + (size_t)2 * T * PLE_DIM * 2;
constexpr size_t WS_HN = WS_ROPE + (size_t)T * 64 * 4;
constexpr size_t WS_MIX = WS_HN + (size_t)T * DM * 2;
constexpr size_t WS_E = WS_MIX + (size_t)T * DM * 2;
constexpr size_t WS_ROUTE = WS_E + (size_t)T * DM * 2;
constexpr size_t WS_R = WS_ROUTE + (size_t)T * 2 * 4 * 3;
constexpr size_t R_U = WS_R;
constexpr size_t R_GQKV = R_U + (size_t)T * D_INP * 2;
constexpr size_t R_GBG = R_GQKV + (size_t)T * 1536 * 2;
constexpr size_t R_XC = R_GBG + (size_t)T * 8 * 4;
constexpr size_t R_DT = R_XC + (size_t)T * 1536 * 2;
constexpr size_t R_QLN = R_DT + (size_t)T * 16 * 4;
constexpr size_t R_KVLN = R_QLN + (size_t)T * MQR * 2;
constexpr size_t R_QRAW = R_KVLN + (size_t)T * MKVR * 2;
constexpr size_t R_KVRAW = R_QRAW + (size_t)T * 768 * 2;
constexpr size_t R_Q = R_KVRAW + (size_t)T * 1024 * 2;
constexpr size_t R_K = R_Q + (size_t)T * 768 * 2;
constexpr int GNU = BATCH * GH * GNC;
constexpr size_t R_GUT = R_K + (size_t)T * 768 * 2;
constexpr size_t R_GW = R_GUT + (size_t)GNU * 8192 * 2;
constexpr size_t R_GQD = R_GW + (size_t)GNU * 8192 * 2;
constexpr size_t R_GKDT = R_GQD + (size_t)GNU * 8192 * 2;
constexpr size_t R_GIN = R_GKDT + (size_t)GNU * 8192 * 2;
constexpr size_t R_GEND = R_GIN + (size_t)GNU * 4096 * 2;
constexpr size_t R_SST = R_GEND + 4096;
constexpr size_t R_SPV = R_SST + (size_t)BATCH * SNC * SH * SP * SN * 4;
constexpr size_t R_SDA = R_SPV + (size_t)BATCH * SNC * SH * SP * SN * 2;
constexpr size_t R_MIXEND = R_SDA + 4096;
constexpr size_t R_ACT = WS_R;
constexpr size_t R_XP = WS_R;
constexpr size_t R_ACTP = R_XP + (size_t)MAXSLOTS * DM * 2;
constexpr size_t R_FFNEND = R_ACTP + (size_t)MAXSLOTS * FFE * 2;
constexpr size_t WS_END = (R_MIXEND > R_FFNEND ? R_MIXEND : R_FFNEND);
static_assert(WS_END < (size_t)1850 * MiB * 1ull && (WS_R % 256) == 0, "d_ws map");

constexpr int CW_TMO = 0;
constexpr int CW_CNT = 64;
constexpr int CW_CUR = 128;
constexpr int CW_TOFF = 192;
constexpr int CW_CMAX = 65536;

constexpr int CW_BAR = 4096;

constexpr int RING_BYTES = 131072;
constexpr int MISC_OFF = RING_BYTES;
constexpr int LDS_BYTES = 147456;

#define XB_TMO      128
#define XB_XCNT(j)  (256  + 64 * (j))
#define XB_XSUB(j)  (1280 + 64 * (j))
#define XB_XGEN(j)  (2304 + 64 * (j))
#define XB_TOP      3328
#define XB_TOPGEN   3392
#define XCD_BAR_WORDS 3456
#define XB_SPIN_CAP (1u << 18)

__device__ __forceinline__ unsigned xb_ld(unsigned* p)              { return __hip_atomic_load(p, __ATOMIC_RELAXED, __HIP_MEMORY_SCOPE_AGENT); }
__device__ __forceinline__ unsigned xb_add(unsigned* p, unsigned v) { return __hip_atomic_fetch_add(p, v, __ATOMIC_RELAXED, __HIP_MEMORY_SCOPE_AGENT); }
__device__ __forceinline__ unsigned xb_xcc_id() { return (unsigned)__builtin_amdgcn_s_getreg((3 << 11) | 20) & 0xFu; }
#define XB_SPIN(cond, bar) do { unsigned _sp = 0; while (cond) { __builtin_amdgcn_s_sleep(1); \
    if ((++_sp & 255u) == 0u) { if (xb_ld(&(bar)[XB_TMO])) break; if (_sp > XB_SPIN_CAP) { atomicAdd(&(bar)[XB_TMO], 1u); break; } } } } while (0)

struct XcdBarrier {
    unsigned* bar; unsigned x;
    volatile LAS unsigned* st;
};
__device__ __forceinline__ XcdBarrier xcd_barrier_post(unsigned* bar, volatile LAS unsigned* st) {
    XcdBarrier b; b.bar = bar; b.x = xb_xcc_id(); b.st = st;
    if (threadIdx.x == 0) (void)xb_add(&bar[XB_XCNT(b.x)], 1u);
    return b;
}
__device__ __forceinline__ void xcd_barrier_complete(unsigned* bar, unsigned x, unsigned& nloc, unsigned& nx) {
    const unsigned G = gridDim.x * gridDim.y * gridDim.z;
    unsigned sum, cnt, mine, sp = 0u;
    for (;;) {
        sum = 0u; cnt = 0u; mine = 0u;
#pragma unroll
        for (unsigned j = 0; j < 16; ++j) { const unsigned c = xb_ld(&bar[XB_XCNT(j)]); sum += c; cnt += (c > 0u) ? 1u : 0u; mine = (j == x) ? c : mine; }
        if (sum == G) break;
        __builtin_amdgcn_s_sleep(1);
        if ((++sp & 255u) == 0u) { if (xb_ld(&bar[XB_TMO])) break; if (sp > XB_SPIN_CAP) { atomicAdd(&bar[XB_TMO], 1u); break; } }
    }
    nloc = mine > 0u ? mine : 1u; nx = cnt > 0u ? cnt : 1u;
}
__device__ __forceinline__ void xcd_barrier(const XcdBarrier& b) {
    asm volatile("s_waitcnt vmcnt(0)" ::: "memory");
    __syncthreads();
    if (threadIdx.x == 0) {
        unsigned* bar = b.bar;
        __builtin_amdgcn_s_waitcnt(0);
        unsigned nloc = b.st[0], nx = b.st[1];
        if (nloc == 0u) { xcd_barrier_complete(bar, b.x, nloc, nx); b.st[0] = nloc; b.st[1] = nx; }
        const unsigned old = xb_add(&bar[XB_XSUB(b.x)], 1u);
        const unsigned gen = old / nloc;
        if (old + 1u == (gen + 1u) * nloc) {
            __builtin_amdgcn_fence(__ATOMIC_RELEASE, "agent");
            asm volatile("s_waitcnt vmcnt(0)" ::: "memory");
            const unsigned og = xb_add(&bar[XB_TOP], 1u);
            const unsigned tg = og / nx;
            if (og + 1u == (tg + 1u) * nx) xb_add(&bar[XB_TOPGEN], 1u);
            else XB_SPIN(xb_ld(&bar[XB_TOPGEN]) == tg, bar);
            __builtin_amdgcn_fence(__ATOMIC_ACQUIRE, "agent");
            xb_add(&bar[XB_XGEN(b.x)], 1u);
            asm volatile("s_waitcnt vmcnt(0)" ::: "memory");
        } else {
            XB_SPIN(xb_ld(&bar[XB_XGEN(b.x)]) == gen, bar);
            __builtin_amdgcn_fence(__ATOMIC_ACQUIRE, "agent");
            asm volatile("s_waitcnt vmcnt(0)" ::: "memory");
        }
    }
    __syncthreads();
}

#define MFMA16(a, b, c) __builtin_amdgcn_mfma_f32_16x16x32_bf16((a), (b), (c), 0, 0, 0)
__device__ __forceinline__ bf16x8 lds_frag(const LAS unsigned char* base, int ldb, int row0, int k0, int lane) {
    return *(const LAS bf16x8*)(base + (row0 + (lane & 15)) * ldb + (k0 + 8 * (lane >> 4)) * 2);
}
__device__ __forceinline__ bf16x8 glb_frag(const bf16* base, int ld, int row0, int k0, int lane) {
    return *(const bf16x8*)(base + (size_t)(row0 + (lane & 15)) * ld + k0 + 8 * (lane >> 4));
}
__device__ __forceinline__ s16x4 tr_rd(const LAS unsigned char* p) { return __builtin_amdgcn_ds_read_tr16_b64_v4i16((LAS s16x4*)p); }
__device__ __forceinline__ bf16x8 lds_frag_tr(const LAS unsigned char* base, int ldb, int k0, int n0, int lane) {
    const int g = lane >> 4, q = (lane & 15) >> 2, p = lane & 3;
    const LAS unsigned char* a = base + (k0 + 8 * g + q) * ldb + (n0 + 4 * p) * 2;
    const s16x4 lo = tr_rd(a), hi = tr_rd(a + 4 * ldb);
    return (bf16x8){lo[0], lo[1], lo[2], lo[3], hi[0], hi[1], hi[2], hi[3]};
}
__device__ __forceinline__ bf16x8 lds_frag_trp(const LAS unsigned char* base, int ldb, int k0, int n0, int lane) {
    const int g = lane >> 4, q = (lane & 15) >> 2, p = lane & 3;
    const LAS unsigned char* a = base + (k0 + 4 * g + q) * ldb + (n0 + 4 * p) * 2;
    const s16x4 lo = tr_rd(a), hi = tr_rd(a + 16 * ldb);
    return (bf16x8){lo[0], lo[1], lo[2], lo[3], hi[0], hi[1], hi[2], hi[3]};
}
__device__ __forceinline__ bf16x8 pack_frag(const f32x4 a, const f32x4 b) {
    u32x4 w; w.x = cvt_pk_bf16(a[0], a[1]); w.y = cvt_pk_bf16(a[2], a[3]); w.z = cvt_pk_bf16(b[0], b[1]); w.w = cvt_pk_bf16(b[2], b[3]);
    return __builtin_bit_cast(bf16x8, w);
}
__device__ __forceinline__ v2u pack4(const f32x4 a) { v2u w; w.x = cvt_pk_bf16(a[0], a[1]); w.y = cvt_pk_bf16(a[2], a[3]); return w; }
__device__ __forceinline__ v2u pack4_mfma(const f32x4 a) { v2u w; w.x = cvt_pk_bf16_cv(a[0], a[1]); w.y = cvt_pk_bf16_cv(a[2], a[3]); return w; }

__device__ __forceinline__ void tr_item(const float* __restrict__ W, int ld, int sc, int k0, bf16* __restrict__ WT, int K, int drow0, LAS float* scr, int lane) {
#pragma unroll 8
    for (int i = 0; i < 32; ++i) { const int kk = 2 * i + (lane >> 5); scr[kk * 33 + (lane & 31)] = sc >= 0 ? W[(size_t)(k0 + kk) * ld + sc] : 0.f; }
    LDS_WAIT(); asm volatile("" ::: "memory");
    const int c = lane & 7;
#pragma unroll
    for (int j = 0; j < 4; ++j) { const int n = (lane >> 3) + 8 * j; const LAS float* s = scr + (8 * c) * 33 + n;
        v4u o; o.x = cvt_pk_bf16(s[0 * 33], s[1 * 33]); o.y = cvt_pk_bf16(s[2 * 33], s[3 * 33]); o.z = cvt_pk_bf16(s[4 * 33], s[5 * 33]); o.w = cvt_pk_bf16(s[6 * 33], s[7 * 33]);
        *(v4u*)(WT + (size_t)(drow0 + n) * K + k0 + 8 * c) = o; }
    LDS_WAIT(); asm volatile("" ::: "memory");
}
__device__ __forceinline__ int win_src(int d) {
    if (d < 2048) return d;
    if (d < 4608) return d + 8;
    if (d < 5312) return d + 24;
    if (d < 5320) return S_GBA + (d - 5312);
    if (d < 5336) return S_SDT + (d - 5320);
    return -1;
}
__device__ __forceinline__ void conv_plain(const float* W, int ld, int K, int ncb, bf16* WT, int it, LAS float* scr, int lane) {
    const int kb = it / ncb, nb = it % ncb; tr_item(W, ld, 32 * nb + (lane & 31), 64 * kb, WT, K, 32 * nb, scr, lane);
}
__device__ __forceinline__ void conv_gu(const float* W, int ld, int K, int ncb, bf16* WT, int s, int it, LAS float* scr, int lane) {
    const int kb = it / ncb, nb = it % ncb; tr_item(W, ld, 32 * nb + (lane & 31), 64 * kb, WT, K, 256 * (nb >> 2) + 128 * s + 32 * (nb & 3), scr, lane);
}
__device__ __forceinline__ void q8_strip(const float* __restrict__ W, int ld, int sc  , signed char* __restrict__ W8, float* __restrict__ sw, int drow0, LAS unsigned char* lds, int lane, int wave) {
    const float* wp = W + (size_t)(256 * wave + (lane >> 5)) * ld + (sc < 0 ? 0 : sc);
    LAS float* scr = (LAS float*)(lds + wave * 16384); LAS float* cm = (LAS float*)(lds + 8448);
    float v[128];
#pragma unroll
    for (int i = 0; i < 128; ++i) v[i] = sc < 0 ? 0.f : wp[(size_t)(2 * i) * ld];
    float mx = 0.f;
#pragma unroll
    for (int i = 0; i < 128; ++i) mx = fmaxf(mx, fabsf(v[i]));
    mx = max32(mx);
    if (lane < 32) cm[wave * 32 + lane] = mx;
    __syncthreads();
#pragma unroll
    for (int w = 0; w < 8; ++w) mx = fmaxf(mx, cm[w * 32 + (lane & 31)]);
    const float inv = mx > 0.f ? 127.0f / mx : 0.f;
    if (wave == 0 && lane < 32) sw[drow0 + lane] = mx > 0.f ? mx * (1.0f / 127.0f) : 1.0f;
#pragma unroll
    for (int c = 0; c < 4; ++c) {
#pragma unroll
        for (int i = 0; i < 32; ++i) scr[(2 * i + (lane >> 5)) * 33 + (lane & 31)] = v[32 * c + i] * inv;
        LDS_WAIT(); asm volatile("" ::: "memory");
        const int n = lane & 31, kh = lane >> 5; unsigned w[8];
#pragma unroll
        for (int q = 0; q < 8; ++q) { unsigned pk = 0u;
#pragma unroll
            for (int b = 0; b < 4; ++b) { int x = (int)rintf(scr[(32 * kh + 4 * q + b) * 33 + n]); x = x > 127 ? 127 : (x < -127 ? -127 : x); pk |= ((unsigned)x & 0xffu) << (8 * b); }
            w[q] = pk; }
        v4u* dst = (v4u*)(W8 + (size_t)(drow0 + n) * DM + 256 * wave + 64 * c + 32 * kh);
        dst[0] = (v4u){w[0], w[1], w[2], w[3]}; dst[1] = (v4u){w[4], w[5], w[6], w[7]};
        LDS_WAIT(); asm volatile("" ::: "memory");
    }
    __syncthreads();
}
__device__ __forceinline__ void down_colmax_item(const float* __restrict__ W, int r0, int c0, unsigned* __restrict__ cmax, int lane) {
    const f32x4* wp = (const f32x4*)(W + (size_t)r0 * DM + c0) + lane;
    f32x4 mx = {0.f, 0.f, 0.f, 0.f};
#pragma unroll 16
    for (int i = 0; i < 256; ++i) { const f32x4 v = wp[(size_t)i * (DM / 4)]; mx[0] = fmaxf(mx[0], fabsf(v[0])); mx[1] = fmaxf(mx[1], fabsf(v[1])); mx[2] = fmaxf(mx[2], fabsf(v[2])); mx[3] = fmaxf(mx[3], fabsf(v[3])); }
#pragma unroll
    for (int i = 0; i < 4; ++i) __hip_atomic_fetch_max(cmax + c0 + 4 * lane + i, __float_as_uint(mx[i]), RLX_AGENT);
}
__device__ __forceinline__ void down_quant_item(const float* __restrict__ W, int K, int ch, int n0, const unsigned* __restrict__ cmax, signed char* __restrict__ W8, float* __restrict__ sw, int drow0,
                                                LAS unsigned char* lds, int lane, int wave) {
    const int r0 = 2048 * ch + 256 * wave;
    LAS float* scr = (LAS float*)(lds + wave * 16384);
    const float mx = __uint_as_float(__hip_atomic_load(cmax + n0 + (lane & 31), RLX_AGENT));
    const float inv = mx > 0.f ? 127.0f / mx : 0.f;
    if (ch == 0 && wave == 0 && lane < 32) sw[drow0 + lane] = mx > 0.f ? mx * (1.0f / 127.0f) : 1.0f;
    if (r0 < K) {
        const float* wp = W + (size_t)(r0 + (lane >> 5)) * DM + n0 + (lane & 31);
        float v[128];
#pragma unroll
        for (int i = 0; i < 128; ++i) v[i] = wp[(size_t)(2 * i) * DM];
#pragma unroll
        for (int c = 0; c < 4; ++c) {
#pragma unroll
            for (int i = 0; i < 32; ++i) scr[(2 * i + (lane >> 5)) * 33 + (lane & 31)] = v[32 * c + i] * inv;
            LDS_WAIT(); asm volatile("" ::: "memory");
            const int n = lane & 31, kh = lane >> 5; unsigned w[8];
#pragma unroll
            for (int q = 0; q < 8; ++q) { unsigned pk = 0u;
#pragma unroll
                for (int b = 0; b < 4; ++b) { int x = (int)rintf(scr[(32 * kh + 4 * q + b) * 33 + n]); x = x > 127 ? 127 : (x < -127 ? -127 : x); pk |= ((unsigned)x & 0xffu) << (8 * b); }
                w[q] = pk; }
            v4u* dst = (v4u*)(W8 + (size_t)(drow0 + n) * K + r0 + 64 * c + 32 * kh);
            dst[0] = (v4u){w[0], w[1], w[2], w[3]}; dst[1] = (v4u){w[4], w[5], w[6], w[7]};
            LDS_WAIT(); asm volatile("" ::: "memory");
        }
    }
}
__device__ __forceinline__ void down_rowq_item(const float* __restrict__ W, int K, int k0, signed char* __restrict__ W8, float* __restrict__ sk, LAS unsigned char* lds, int tid, int lane, int wave) {
    const float MG = 12582912.0f;
#pragma unroll 1
    for (int grp = 0; grp < 2; ++grp) {
        const int r0 = 8 * wave + 4 * grp;
        f32x4 x[4][8];
#pragma unroll
        for (int r = 0; r < 4; ++r)
#pragma unroll
            for (int j = 0; j < 8; ++j) x[r][j] = *(const f32x4*)(W + (size_t)(k0 + r0 + r) * DM + 4 * (lane + 64 * j));
#pragma unroll
        for (int r = 0; r < 4; ++r) { float mx = 0.f;
#pragma unroll
            for (int j = 0; j < 8; ++j) mx = fmaxf(fmaxf(mx, fmaxf(fabsf(x[r][j][0]), fabsf(x[r][j][1]))), fmaxf(fabsf(x[r][j][2]), fabsf(x[r][j][3])));
            mx = fmaxf(mx, shx<1>(mx)); mx = fmaxf(mx, shx<2>(mx)); mx = fmaxf(mx, shx<4>(mx)); mx = fmaxf(mx, shx<8>(mx)); mx = fmaxf(mx, shx<16>(mx)); mx = max32(mx);
            const float inv = mx > 0.f ? 127.0f / mx : 0.f;
            if (lane == 0) sk[k0 + r0 + r] = mx > 0.f ? mx * (1.0f / 127.0f) : 1.0f;
            LAS unsigned* row = (LAS unsigned*)(lds + (r0 + r) * 2048) + lane;
#pragma unroll
            for (int j = 0; j < 8; ++j) {
                const unsigned y0 = __float_as_uint(fmaf(x[r][j][0], inv, MG)), y1 = __float_as_uint(fmaf(x[r][j][1], inv, MG)), y2 = __float_as_uint(fmaf(x[r][j][2], inv, MG)), y3 = __float_as_uint(fmaf(x[r][j][3], inv, MG));
                const unsigned lo = __builtin_amdgcn_perm(y1, y0, 0x0c0c0400u), hi = __builtin_amdgcn_perm(y3, y2, 0x0c0c0400u);
                row[64 * j] = __builtin_amdgcn_perm(hi, lo, 0x05040100u); } }
    }
    __syncthreads();
    const LAS unsigned* col = (const LAS unsigned*)lds + tid;
    signed char* o = W8 + (size_t)(4 * tid) * K + k0;
#pragma unroll
    for (int kq = 0; kq < 4; ++kq) { unsigned oc[4][4];
#pragma unroll
        for (int b = 0; b < 4; ++b) { const int kr = 16 * kq + 4 * b;
            const unsigned d0 = col[(kr + 0) * 512], d1 = col[(kr + 1) * 512], d2 = col[(kr + 2) * 512], d3 = col[(kr + 3) * 512];
            const unsigned t01l = __builtin_amdgcn_perm(d1, d0, 0x05010400u), t01h = __builtin_amdgcn_perm(d1, d0, 0x07030602u);
            const unsigned t23l = __builtin_amdgcn_perm(d3, d2, 0x05010400u), t23h = __builtin_amdgcn_perm(d3, d2, 0x07030602u);
            oc[0][b] = __builtin_amdgcn_perm(t23l, t01l, 0x05040100u); oc[1][b] = __builtin_amdgcn_perm(t23l, t01l, 0x07060302u);
            oc[2][b] = __builtin_amdgcn_perm(t23h, t01h, 0x05040100u); oc[3][b] = __builtin_amdgcn_perm(t23h, t01h, 0x07060302u); }
#pragma unroll
        for (int c = 0; c < 4; ++c) *(v4u*)(o + (size_t)c * K + 16 * kq) = (v4u){oc[c][0], oc[c][1], oc[c][2], oc[c][3]}; }
    __syncthreads();
}
constexpr size_t WS_SKG = WS_WGU + 36 * MiB;
constexpr size_t WS_SKD = WS_WDN + 13 * MiB;
constexpr size_t WS_SKM = WS_WMDN + 122 * MiB;
constexpr int DQ_DENSE = FF0 / 64, DQ_EXP = FFE / 64, DQ_TOTAL = DQ_DENSE + NEXP * DQ_EXP;
__device__ __forceinline__ void down_quant_phase(const float* wd, const float* wmd, unsigned char* ws, LAS unsigned char* lds, int first, int stride, int lane, int wave) {
    const int tid = wave * 64 + lane;
    for (int it = first; it < DQ_TOTAL; it += stride) {
        if (it < DQ_DENSE) down_rowq_item(wd, FF0, 64 * it, (signed char*)(ws + WS_WDN), (float*)(ws + WS_SKD), lds, tid, lane, wave);
        else { const int r = it - DQ_DENSE, e = r / DQ_EXP, q = r % DQ_EXP;
            down_rowq_item(wmd + (size_t)e * FFE * DM, FFE, 64 * q, (signed char*)(ws + WS_WMDN) + (size_t)e * DM * FFE, (float*)(ws + WS_SKM) + (size_t)e * FFE, lds, tid, lane, wave); }
    }
}
__device__ __forceinline__ void scale_fold(int L, unsigned char* ws, int gtid, int NGT) {
    if (L == 0) { float* sw = (float*)(ws + WS_SWD); const float* sk = (const float*)(ws + WS_SKD); float* sd = (float*)(ws + WS_SDD);
        for (int k = gtid; k < FF0; k += NGT) sw[256 * (k >> 7) + 128 + (k & 127)] *= sk[k];
        for (int n = gtid; n < DM; n += NGT) { sd[n] = 1.0f; ((float*)(ws + WS_SPG))[n] = 1.0f; } }
    else { float* swm = (float*)(ws + WS_SWM); const float* sk = (const float*)(ws + WS_SKM); float* sd = (float*)(ws + WS_SDM);
        for (int i = gtid; i < NEXP * FFE; i += NGT) { const int e = i / FFE, k = i - e * FFE; swm[(size_t)e * 2 * FFE + 256 * (k >> 7) + 128 + (k & 127)] *= sk[i]; }
        for (int n = gtid; n < NEXP * DM; n += NGT) sd[n] = 1.0f;
        for (int n = gtid; n < DM; n += NGT) ((float*)(ws + WS_SPG))[DM + n] = 1.0f; }
}
struct In { const float* p[33]; };
typedef const In __attribute__((address_space(4)))* InP;
constexpr int IT_WIN = 0, IT_WOUT = 32 * 64, IT_WQB = 6 * 24, IT_WKVB = 4 * 32, IT_WPP = 4 * 64, IT_WPG = 32 * 64;
constexpr int IT_LAYER = IT_WIN + IT_WOUT + IT_WQB + IT_WKVB + IT_WPP + IT_WPG;
constexpr int IT_FD = 0, IT_DENSE = 0;
constexpr int IT_MD = 0, IT_EXP = 0;
constexpr int ST_WIN = 2 * 168, ST_DENSE = 2 * 176, ST_EXP = 2 * 224, ST_TOTAL = ST_WIN + ST_DENSE + NEXP * ST_EXP;
constexpr int IT_TOTAL = 2 * IT_LAYER + IT_DENSE + NEXP * IT_EXP;
__device__ __forceinline__ void moe_gu_quant_phase(InP in, unsigned char* ws, LAS unsigned char* lds, int lo, int hi, int first, int stride, int lane, int wave) {
    for (int st = lo + first; st < hi; st += stride) { int r = st;
        if (r >= NEXP * ST_EXP) { const int q = r - NEXP * ST_EXP, Lg = q >> 6, nb = q & 63;
            if (nb < 32) down_rowq_item(in->p[31] + (size_t)Lg * DM * DM, DM, 64 * nb, (signed char*)(ws + WS_WPG8) + (size_t)Lg * DM * DM, (float*)(ws + WS_SKG) + Lg * DM, lds, wave * 64 + lane, lane, wave);
            continue; }
        { const int e = r / ST_EXP; r -= e * ST_EXP; const int s = r / 224, nb = r % 224;
          q8_strip(in->p[27 + s] + (size_t)e * DM * FFE, FFE, 32 * nb + (lane & 31), (signed char*)(ws + WS_WMGU) + (size_t)e * 2 * FFE * DM, (float*)(ws + WS_SWM) + (size_t)e * 2 * FFE,
                   256 * (nb >> 2) + 128 * s + 32 * (nb & 3), lds, lane, wave); }
    }
}
__device__ __forceinline__ void prologue_phase(InP in, unsigned char* ws, LAS unsigned char* lds, int gw, int NGW, int wave, int lane, int gtid, int NGT, int bid, int G) {
    LAS float* scr = (LAS float*)(lds + wave * 16384);
    for (int it = gw; it < IT_TOTAL; it += NGW) {
        int r = it;
        if (r < 2 * IT_LAYER) {
            const int L = r / IT_LAYER; r -= L * IT_LAYER;
            if (r < IT_WOUT) { conv_plain(in->p[5] + (size_t)L * DM * DM, DM, DM, 64, (bf16*)(ws + WS_WOUT + L * SZ_WOUT), r, scr, lane); continue; }
            r -= IT_WOUT;
            if (r < IT_WQB) { conv_plain(in->p[17] + (size_t)L * MQR * 768, 768, MQR, 24, (bf16*)(ws + WS_WQB + L * SZ_WQB), r, scr, lane); continue; }
            r -= IT_WQB;
            if (r < IT_WKVB) { conv_plain(in->p[19] + (size_t)L * MKVR * 1024, 1024, MKVR, 32, (bf16*)(ws + WS_WKVB + L * SZ_WKVB), r, scr, lane); continue; }
            r -= IT_WKVB;
            if (r < IT_WPP) { conv_plain(in->p[30] + (size_t)L * PLE_DIM * DM, DM, PLE_DIM, 64, (bf16*)(ws + WS_WPP + L * SZ_WPP), r, scr, lane); continue; }
            r -= IT_WPP;
            continue;
        }
        r -= 2 * IT_LAYER;
        if (r < IT_DENSE) {
            continue;
        }
        r -= IT_DENSE;
        { }
    }
    for (int st = bid; st < ST_WIN + ST_DENSE; st += G) {
        int r = st;
        if (r < ST_WIN) { const int L = r / 168, nb = r % 168;
            q8_strip(in->p[4] + (size_t)L * DM * D_IN, D_IN, win_src(32 * nb + (lane & 31)), (signed char*)(ws + WS_WIN) + (size_t)L * (SZ_WIN / 2), (float*)(ws + WS_SWIN) + L * D_INP, 32 * nb, lds, lane, wave); continue; }
        r -= ST_WIN;
        if (r < ST_DENSE) { const int s = r / 176, nb = r % 176;
            q8_strip(in->p[23 + s], FF0, 32 * nb + (lane & 31), (signed char*)(ws + WS_WGU), (float*)(ws + WS_SWD), 256 * (nb >> 2) + 128 * s + 32 * (nb & 3), lds, lane, wave); continue; }
    }
    { const float* p = in->p[1]; bf16* pb = (bf16*)(ws + WS_PB);
      for (size_t i = (size_t)gtid * 8; i < (size_t)2 * T * PLE_DIM; i += (size_t)NGT * 8) {
          const f32x4 a = *(const f32x4*)(p + i), b = *(const f32x4*)(p + i + 4);
          v4u o; o.x = cvt_pk_bf16(a[0], a[1]); o.y = cvt_pk_bf16(a[2], a[3]); o.z = cvt_pk_bf16(b[0], b[1]); o.w = cvt_pk_bf16(b[2], b[3]);
          *(v4u*)(pb + i) = o; } }
    { const int* pos = (const int*)in->p[2]; float* rt = (float*)(ws + WS_ROPE);
      for (int i = gtid; i < T * 32; i += NGT) { const int m = i >> 5, k = i & 31;
          const float inv = 1.0f / powf(10000.0f, (float)k * (1.0f / 32.0f)); const float ang = (float)pos[m] * inv;
          float s, c; sincosf(ang, &s, &c); rt[m * 64 + k] = c; rt[m * 64 + 32 + k] = s; } }
}

template <bool ROUTE, bool OUT8>
__device__ __forceinline__ void rms_phase(const float* __restrict__ h, const float* __restrict__ g, bf16* __restrict__ hn, signed char* __restrict__ hn8, float* __restrict__ sa, const float* __restrict__ Wr,
                                          int* tok_e, float* tok_w, unsigned* cnt, LAS unsigned char* lds, int gw, int NGW, int lane, int tid) {
    LAS float* wr = (LAS float*)lds;
    LAS unsigned* lcnt = (LAS unsigned*)(lds + 65536);
    if (ROUTE) {
        for (int i = tid; i < DM * 8 / 4; i += NTHR) ((LAS f32x4*)wr)[i] = ((const f32x4*)Wr)[i];
        if (tid < 8) lcnt[tid] = 0u;
        __syncthreads();
    }
    f32x4 gv[8];
#pragma unroll
    for (int j = 0; j < 8; ++j) gv[j] = ((const f32x4*)g)[lane + 64 * j];
    for (int m = gw; m < T; m += NGW) {
        const f32x4* xr = (const f32x4*)(h + (size_t)m * DM) + lane;
        f32x4 v[8]; float s = 0.f;
#pragma unroll
        for (int j = 0; j < 8; ++j) { v[j] = xr[64 * j]; s += (v[j].x * v[j].x + v[j].y * v[j].y) + (v[j].z * v[j].z + v[j].w * v[j].w); }
        const float rs = rsqrtf(wave_sum(s) * (1.0f / DM) + EPS);
#pragma unroll
        for (int j = 0; j < 8; ++j) v[j] = v[j] * rs * gv[j];
        if (OUT8) {
            float mx = 0.f;
#pragma unroll
            for (int j = 0; j < 8; ++j) mx = fmaxf(fmaxf(mx, fmaxf(fabsf(v[j].x), fabsf(v[j].y))), fmaxf(fabsf(v[j].z), fabsf(v[j].w)));
            mx = fmaxf(mx, shx<1>(mx)); mx = fmaxf(mx, shx<2>(mx)); mx = fmaxf(mx, shx<4>(mx)); mx = fmaxf(mx, shx<8>(mx)); mx = fmaxf(mx, shx<16>(mx)); mx = max32(mx);
            const float inv = mx > 0.f ? 127.0f / mx : 0.f;
            unsigned* o4 = (unsigned*)(hn8 + (size_t)m * DM) + lane;
#pragma unroll
            for (int j = 0; j < 8; ++j) { const int a = (int)rintf(v[j].x * inv), b = (int)rintf(v[j].y * inv), c = (int)rintf(v[j].z * inv), d = (int)rintf(v[j].w * inv);
                o4[64 * j] = ((unsigned)a & 0xffu) | (((unsigned)b & 0xffu) << 8) | (((unsigned)c & 0xffu) << 16) | (((unsigned)d & 0xffu) << 24); }
            if (lane == 0) sa[m] = mx > 0.f ? mx * (1.0f / 127.0f) : 1.0f;
        } else {
            v2u* o8 = (v2u*)(hn + (size_t)m * DM) + lane;
#pragma unroll
            for (int j = 0; j < 8; ++j) o8[64 * j] = pack4(v[j]);
        }
        if (ROUTE) {
            float lg[8];
#pragma unroll
            for (int e = 0; e < 8; ++e) lg[e] = 0.f;
#pragma unroll
            for (int j = 0; j < 8; ++j)
#pragma unroll
                for (int i = 0; i < 4; ++i) { const int k = 256 * j + 4 * lane + i; const f32x4 w0 = *(const LAS f32x4*)(wr + k * 8), w1 = *(const LAS f32x4*)(wr + k * 8 + 4); const float x = v[j][i];
                    lg[0] += x * w0[0]; lg[1] += x * w0[1]; lg[2] += x * w0[2]; lg[3] += x * w0[3]; lg[4] += x * w1[0]; lg[5] += x * w1[1]; lg[6] += x * w1[2]; lg[7] += x * w1[3]; }
#pragma unroll
            for (int e = 0; e < 8; ++e) lg[e] = wave_sum(lg[e]);
            if (lane == 0) {
                int e1 = 0; float v1 = lg[0];
#pragma unroll
                for (int e = 1; e < 8; ++e) if (lg[e] > v1) { v1 = lg[e]; e1 = e; }
                int e2 = -1; float v2 = -3.0e38f;
#pragma unroll
                for (int e = 0; e < 8; ++e) if (e != e1 && lg[e] > v2) { v2 = lg[e]; e2 = e; }
                const float w1 = 1.0f / (1.0f + __expf(v2 - v1));
                tok_e[2 * m] = e1; tok_e[2 * m + 1] = e2; tok_w[2 * m] = w1; tok_w[2 * m + 1] = 1.0f - w1;
                __hip_atomic_fetch_add(&lcnt[e1], 1u, __ATOMIC_RELAXED, __HIP_MEMORY_SCOPE_WORKGROUP); __hip_atomic_fetch_add(&lcnt[e2], 1u, __ATOMIC_RELAXED, __HIP_MEMORY_SCOPE_WORKGROUP);
            }
        }
    }
    if (ROUTE) { __syncthreads(); if (tid < 8) { const unsigned c = lcnt[tid]; if (c) __hip_atomic_fetch_add(cnt + tid, c, RLX_AGENT); } }
}

__device__ __forceinline__ void conv_phase(InP in, int L, unsigned char* ws, int gw, int NGW, int lane) {
    const bf16* u = (const bf16*)(ws + R_U);
    bf16* gqkv = (bf16*)(ws + R_GQKV); float* gbg = (float*)(ws + R_GBG); bf16* xc = (bf16*)(ws + R_XC); float* dtb = (float*)(ws + R_DT);
    bf16* qln = (bf16*)(ws + R_QLN); bf16* kvln = (bf16*)(ws + R_KVLN);
    const int per = (T + NGW - 1) / NGW, ma = gw * per, mb = (ma + per < T) ? ma + per : T;
    if (ma >= T) return;
    const float* cw = in->p[6] + (size_t)L * 1536 * 4;
    for (int hd = 0; hd < GH; ++hd) {
        f32x4 w[3][2];
#pragma unroll
        for (int t3 = 0; t3 < 3; ++t3)
#pragma unroll
            for (int i = 0; i < 2; ++i) w[t3][i] = *(const f32x4*)(cw + (size_t)(t3 * 512 + hd * 128 + 2 * lane + i) * 4);
        unsigned x0[3], x1[3], x2[3];
#pragma unroll
        for (int t3 = 0; t3 < 3; ++t3) {
            const int col = t3 * 512 + hd * 128 + 2 * lane;
            const int s0 = (ma % SEQ);
            x0[t3] = (s0 >= 3) ? *(const unsigned*)(u + (size_t)(ma - 3) * D_INP + col) : 0u;
            x1[t3] = (s0 >= 2) ? *(const unsigned*)(u + (size_t)(ma - 2) * D_INP + col) : 0u;
            x2[t3] = (s0 >= 1) ? *(const unsigned*)(u + (size_t)(ma - 1) * D_INP + col) : 0u;
        }
        for (int m = ma; m < mb; ++m) {
            if ((m % SEQ) == 0) {
#pragma unroll
                for (int t3 = 0; t3 < 3; ++t3) { x0[t3] = 0u; x1[t3] = 0u; x2[t3] = 0u; }
            }
            float y[3][2];
#pragma unroll
            for (int t3 = 0; t3 < 3; ++t3) {
                const unsigned x3 = *(const unsigned*)(u + (size_t)m * D_INP + t3 * 512 + hd * 128 + 2 * lane);
                const float a = w[t3][0][0] * bflo(x0[t3]) + w[t3][0][1] * bflo(x1[t3]) + w[t3][0][2] * bflo(x2[t3]) + w[t3][0][3] * bflo(x3);
                const float b = w[t3][1][0] * bfhi(x0[t3]) + w[t3][1][1] * bfhi(x1[t3]) + w[t3][1][2] * bfhi(x2[t3]) + w[t3][1][3] * bfhi(x3);
                y[t3][0] = siluf_(a); y[t3][1] = siluf_(b);
                x0[t3] = x1[t3]; x1[t3] = x2[t3]; x2[t3] = x3;
            }
            const float sq = wave_sum(y[0][0] * y[0][0] + y[0][1] * y[0][1]), sk = wave_sum(y[1][0] * y[1][0] + y[1][1] * y[1][1]);
            const float rq = rsqrtf(sq + EPS) * 0.08838834764831845f, rk = rsqrtf(sk + EPS);
            bf16* o = gqkv + (size_t)m * 1536 + hd * 128 + 2 * lane;
            *(unsigned*)(o) = cvt_pk_bf16(y[0][0] * rq, y[0][1] * rq);
            *(unsigned*)(o + 512) = cvt_pk_bf16(y[1][0] * rk, y[1][1] * rk);
            *(unsigned*)(o + 1024) = cvt_pk_bf16(y[2][0], y[2][1]);
        }
    }
    {
        const float alog = (lane < 4) ? in->p[7][L * GH + lane] : 0.f, dtbias = (lane < 4) ? in->p[8][L * GH + lane] : 0.f;
        const float sdtb = (lane < 16) ? in->p[13][L * SH + lane] : 0.f;
        for (int m = ma; m < mb; ++m) {
            if (lane < 4) {
                const float bb = bf2f(u[(size_t)m * D_INP + U_GB + lane]), aa = bf2f(u[(size_t)m * D_INP + U_GA + lane]);
                gbg[(size_t)m * 8 + lane] = sigmoidf_(bb);
                gbg[(size_t)m * 8 + 4 + lane] = -__expf(alog) * softplusf_(aa + dtbias);
            }
            if (lane < 16) dtb[(size_t)m * 16 + lane] = softplusf_(bf2f(u[(size_t)m * D_INP + U_SDT + lane]) + sdtb);
        }
    }
    {
        const float* sw = in->p[10] + (size_t)L * SCONV * 4; const float* sb = in->p[11] + (size_t)L * SCONV;
        for (int ch = 0; ch < 3; ++ch) {
            const int c0 = ch * 512 + 8 * lane;
            f32x4 w[8]; float bias[8];
#pragma unroll
            for (int i = 0; i < 8; ++i) { w[i] = *(const f32x4*)(sw + (size_t)(c0 + i) * 4); bias[i] = sb[c0 + i]; }
            v4u x0, x1, x2; const v4u z4 = {0u, 0u, 0u, 0u};
            { const int s0 = (ma % SEQ);
              x0 = (s0 >= 3) ? *(const v4u*)(u + (size_t)(ma - 3) * D_INP + U_SX + c0) : z4;
              x1 = (s0 >= 2) ? *(const v4u*)(u + (size_t)(ma - 2) * D_INP + U_SX + c0) : z4;
              x2 = (s0 >= 1) ? *(const v4u*)(u + (size_t)(ma - 1) * D_INP + U_SX + c0) : z4; }
            for (int m = ma; m < mb; ++m) {
                if ((m % SEQ) == 0) { x0 = z4; x1 = z4; x2 = z4; }
                const v4u x3 = *(const v4u*)(u + (size_t)m * D_INP + U_SX + c0);
                float y[8];
#pragma unroll
                for (int i = 0; i < 4; ++i) {
                    const float a = w[2 * i][0] * bflo(x0[i]) + w[2 * i][1] * bflo(x1[i]) + w[2 * i][2] * bflo(x2[i]) + w[2 * i][3] * bflo(x3[i]) + bias[2 * i];
                    const float b = w[2 * i + 1][0] * bfhi(x0[i]) + w[2 * i + 1][1] * bfhi(x1[i]) + w[2 * i + 1][2] * bfhi(x2[i]) + w[2 * i + 1][3] * bfhi(x3[i]) + bias[2 * i + 1];
                    y[2 * i] = siluf_(a); y[2 * i + 1] = siluf_(b);
                }
                v4u o; o.x = cvt_pk_bf16(y[0], y[1]); o.y = cvt_pk_bf16(y[2], y[3]); o.z = cvt_pk_bf16(y[4], y[5]); o.w = cvt_pk_bf16(y[6], y[7]);
                *(v4u*)(xc + (size_t)m * SCONV + c0) = o;
                x0 = x1; x1 = x2; x2 = x3;
            }
        }
    }
    {
        const float* qg = in->p[16] + (size_t)L * MQR; const float* kg = in->p[18] + (size_t)L * MKVR;
        float gq[8], gk[4];
#pragma unroll
        for (int i = 0; i < 8; ++i) gq[i] = (lane < 48) ? qg[8 * lane + i] : 0.f;
#pragma unroll
        for (int i = 0; i < 4; ++i) gk[i] = kg[4 * lane + i];
        const v4u z4 = {0u, 0u, 0u, 0u};
        for (int m = ma; m < mb; ++m) {
            const v4u qv = (lane < 48) ? *(const v4u*)(u + (size_t)m * D_INP + U_MQ + 8 * lane) : z4;
            const v2u kv = *(const v2u*)(u + (size_t)m * D_INP + U_MKV + 4 * lane);
            float q[8], k[4];
#pragma unroll
            for (int i = 0; i < 4; ++i) { q[2 * i] = bflo(qv[i]); q[2 * i + 1] = bfhi(qv[i]); }
            k[0] = bflo(kv.x); k[1] = bfhi(kv.x); k[2] = bflo(kv.y); k[3] = bfhi(kv.y);
            float sq = 0.f, sk = 0.f;
#pragma unroll
            for (int i = 0; i < 8; ++i) sq += q[i] * q[i];
#pragma unroll
            for (int i = 0; i < 4; ++i) sk += k[i] * k[i];
            const float rq = rsqrtf(wave_sum(sq) * (1.0f / MQR) + EPS), rk = rsqrtf(wave_sum(sk) * (1.0f / MKVR) + EPS);
            if (lane < 48) { v4u o; o.x = cvt_pk_bf16(q[0] * rq * gq[0], q[1] * rq * gq[1]); o.y = cvt_pk_bf16(q[2] * rq * gq[2], q[3] * rq * gq[3]);
                o.z = cvt_pk_bf16(q[4] * rq * gq[4], q[5] * rq * gq[5]); o.w = cvt_pk_bf16(q[6] * rq * gq[6], q[7] * rq * gq[7]);
                *(v4u*)(qln + (size_t)m * MQR + 8 * lane) = o; }
            { v2u o; o.x = cvt_pk_bf16(k[0] * rk * gk[0], k[1] * rk * gk[1]); o.y = cvt_pk_bf16(k[2] * rk * gk[2], k[3] * rk * gk[3]);
              *(v2u*)(kvln + (size_t)m * MKVR + 4 * lane) = o; }
        }
    }
}

__device__ __forceinline__ void mlaprep_phase(InP in, int L, unsigned char* ws, int gw, int NGW, int lane) {
    const bf16* qraw = (const bf16*)(ws + R_QRAW); const bf16* kvraw = (const bf16*)(ws + R_KVRAW); const bf16* u = (const bf16*)(ws + R_U);
    bf16* Q = (bf16*)(ws + R_Q); bf16* K = (bf16*)(ws + R_K); const float* rope = (const float*)(ws + WS_ROPE);
    const float* qg = in->p[20] + (size_t)L * MQK; const float* kg = in->p[21] + (size_t)L * MQK;
    const float qg0 = qg[lane], qg1 = qg[64 + lane], qg2 = qg[128 + lane], kg0 = kg[lane], kg1 = kg[64 + lane], kg2 = kg[128 + lane];
    constexpr float QS = 0.07216878364870323f * 1.4426950408889634f;
    for (int m = gw; m < T; m += NGW) {
        const float cs = rope[(size_t)m * 64 + (lane & 31)], sn = rope[(size_t)m * 64 + 32 + (lane & 31)];
        const float kpe = bf2f(u[(size_t)m * D_INP + U_MPE + lane]);
        for (int hd = 0; hd < MH; ++hd) {
            {   const bf16* qr = qraw + (size_t)m * 768 + hd * MQK;
                float a = bf2f(qr[lane]), b = bf2f(qr[64 + lane]), c = bf2f(qr[128 + lane]);
                const float rs = rsqrtf(wave_sum(a * a + b * b + c * c) * (1.0f / MQK) + EPS);
                a *= rs * qg0; b *= rs * qg1; c *= rs * qg2;
                const float pc = other32(c, lane);
                const float cr = (lane < 32) ? (c * cs - pc * sn) : (c * cs + pc * sn);
                bf16* o = Q + (size_t)m * 768 + hd * MQK;
                o[lane] = f2bf(a * QS); o[64 + lane] = f2bf(b * QS); o[128 + lane] = f2bf(cr * QS); }
            {   const bf16* kr = kvraw + (size_t)m * 1024 + hd * 256;
                float a = bf2f(kr[lane]), b = bf2f(kr[64 + lane]), c = kpe;
                const float rs = rsqrtf(wave_sum(a * a + b * b + c * c) * (1.0f / MQK) + EPS);
                a *= rs * kg0; b *= rs * kg1; c *= rs * kg2;
                const float pc = other32(c, lane);
                const float cr = (lane < 32) ? (c * cs - pc * sn) : (c * cs + pc * sn);
                bf16* o = K + (size_t)m * 768 + hd * MQK;
                o[lane] = f2bf(a); o[64 + lane] = f2bf(b); o[128 + lane] = f2bf(cr); }
        }
    }
}

__device__ __forceinline__ void moe_tile_prefix(const unsigned* cnt, int (&toff)[9]) {
    int acc = 0; toff[0] = 0;
#pragma unroll
    for (int e = 0; e < 8; ++e) { const int c = __builtin_amdgcn_readfirstlane((int)__hip_atomic_load(cnt + e, RLX_AGENT)); acc += (c + 255) >> 8; toff[e + 1] = acc; }
}
__device__ __forceinline__ void moe_permute_phase(unsigned char* ws, unsigned* ctl, LAS unsigned char* lds, int bid, int G, int tid, int lane, int wave) {
    const int* tok_e = (const int*)(ws + WS_ROUTE); int* slot = (int*)(ws + WS_ROUTE + (size_t)T * 16);
    const signed char* hn8 = (const signed char*)(ws + WS_HN8); signed char* xp8 = (signed char*)(ws + R_XP); const float* sa = (const float*)(ws + WS_SA); float* xsc = (float*)(ws + WS_XSC);
    LAS int* sl = (LAS int*)lds;
    int toff[9]; moe_tile_prefix(ctl + CW_CNT, toff);
    for (int blk = bid; blk < T / 64; blk += G) {
        if (wave == 0) {
            const int t = 64 * blk + lane; const int e1 = tok_e[2 * t], e2 = tok_e[2 * t + 1]; int s1 = 0, s2 = 0;
#pragma unroll
            for (int e = 0; e < 8; ++e) {
                const bool is1 = (e1 == e), is2 = (e2 == e);
                const unsigned long long mask = __ballot(is1 || is2);
                const int n = __popcll(mask);
                unsigned base = 0u;
                if (lane == 0 && n) base = __hip_atomic_fetch_add(ctl + CW_CUR + e, (unsigned)n, RLX_AGENT);
                base = (unsigned)__builtin_amdgcn_readfirstlane((int)base);
                const int rank = __popcll(mask & ((1ull << lane) - 1ull));
                const int s = toff[e] * 256 + (int)base + rank;
                if (is1) s1 = s; if (is2) s2 = s;
            }
            slot[2 * t] = s1; slot[2 * t + 1] = s2; sl[2 * lane] = s1; sl[2 * lane + 1] = s2;
        }
        __syncthreads();
#pragma unroll 4
        for (int i = 0; i < 16; ++i) { const int r = wave * 16 + i; const int t = 64 * blk + (r >> 1); const int s = sl[r];
            const v4u* src = (const v4u*)(hn8 + (size_t)t * DM) + lane; v4u* dst = (v4u*)(xp8 + (size_t)s * DM) + lane;
#pragma unroll
            for (int j = 0; j < 2; ++j) dst[64 * j] = src[64 * j];
            if (lane == 0) xsc[s] = sa[t]; }
        __syncthreads();
    }
}
__device__ __forceinline__ void moe_combine_phase(unsigned char* ws, float* h, const float* __restrict__ sk, int gw, int NGW, int lane) {
    f32x4 kk[8];
#pragma unroll
    for (int j = 0; j < 8; ++j) kk[j] = ((const f32x4*)sk)[lane + 64 * j];
    const float* tok_w = (const float*)(ws + WS_ROUTE + (size_t)T * 8); const int* slot = (const int*)(ws + WS_ROUTE + (size_t)T * 16);
    const bf16* yp = (const bf16*)(ws + R_XP); signed char* h8 = (signed char*)(ws + WS_HN8); float* sa8 = (float*)(ws + WS_SA);
    for (int m = gw; m < T; m += NGW) {
        const int s0 = __hip_atomic_load(slot + 2 * m, RLX_AGENT), s1 = __hip_atomic_load(slot + 2 * m + 1, RLX_AGENT);
        const float w0 = __hip_atomic_load(tok_w + 2 * m, RLX_AGENT), w1 = __hip_atomic_load(tok_w + 2 * m + 1, RLX_AGENT);
        f32x4* hr = (f32x4*)(h + (size_t)m * DM) + lane; const v2u* y0 = (const v2u*)(yp + (size_t)s0 * DM) + lane; const v2u* y1 = (const v2u*)(yp + (size_t)s1 * DM) + lane;
        f32x4 v[8]; float mx = 0.f;
#pragma unroll
        for (int j = 0; j < 8; ++j) { v[j] = hr[64 * j]; const v2u a = y0[64 * j], b = y1[64 * j];
            v[j][0] += w0 * bflo(a.x) + w1 * bflo(b.x); v[j][1] += w0 * bfhi(a.x) + w1 * bfhi(b.x); v[j][2] += w0 * bflo(a.y) + w1 * bflo(b.y); v[j][3] += w0 * bfhi(a.y) + w1 * bfhi(b.y);
            hr[64 * j] = v[j]; v[j] = v[j] * kk[j]; mx = fmaxf(fmaxf(mx, fmaxf(fabsf(v[j][0]), fabsf(v[j][1]))), fmaxf(fabsf(v[j][2]), fabsf(v[j][3]))); }
        mx = fmaxf(mx, shx<1>(mx)); mx = fmaxf(mx, shx<2>(mx)); mx = fmaxf(mx, shx<4>(mx)); mx = fmaxf(mx, shx<8>(mx)); mx = fmaxf(mx, shx<16>(mx)); mx = max32(mx);
        const float inv = mx > 0.f ? 127.0f / mx : 0.f;
        unsigned* o4 = (unsigned*)(h8 + (size_t)m * DM) + lane;
#pragma unroll
        for (int j = 0; j < 8; ++j) { const int a = (int)rintf(v[j][0] * inv), b = (int)rintf(v[j][1] * inv), c = (int)rintf(v[j][2] * inv), d = (int)rintf(v[j][3] * inv);
            o4[64 * j] = ((unsigned)a & 0xffu) | (((unsigned)b & 0xffu) << 8) | (((unsigned)c & 0xffu) << 16) | (((unsigned)d & 0xffu) << 24); }
        if (lane == 0) sa8[m] = mx > 0.f ? mx * (1.0f / 127.0f) : 1.0f;
    }
}
__device__ __forceinline__ void ssd_scan_phase(unsigned char* ws, int gtid, int NGT) {
    const float* st = (const float*)(ws + R_SST); bf16* pv = (bf16*)(ws + R_SPV); const float* dA = (const float*)(ws + R_SDA);
    for (int i = gtid; i < BATCH * SH * SP * SN; i += NGT) {
        const int pn = i % (SP * SN), bh = i / (SP * SN), hd = bh % SH, b = bh / SH;
        float hs = 0.f;
#pragma unroll 4
        for (int c = 0; c < SNC; ++c) { const size_t idx = ((size_t)((b * SNC + c) * SH + hd)) * (SP * SN) + pn;
            pv[idx] = f2bf(hs); hs = hs * dA[(b * SNC + c) * SH + hd] + st[idx]; }
    }
}

template <int F> __device__ __forceinline__ void act_quant_phase(unsigned char* act, float* sa, int nrows, int gw, int NGW, int lane) {
    constexpr int NV = F / 8 / 64;
    static_assert(F % 512 == 0, "row chunks");
    for (int r = gw; r < nrows; r += NGW) {
        v4u* row = (v4u*)(act + (size_t)r * F * 2);
        v4u x[NV]; float mx = 0.f;
#pragma unroll
        for (int j = 0; j < NV; ++j) { x[j] = row[lane + 64 * j];
#pragma unroll
            for (int i = 0; i < 4; ++i) mx = fmaxf(mx, fmaxf(fabsf(bflo(x[j][i])), fabsf(bfhi(x[j][i])))); }
        mx = fmaxf(mx, shx<1>(mx)); mx = fmaxf(mx, shx<2>(mx)); mx = fmaxf(mx, shx<4>(mx)); mx = fmaxf(mx, shx<8>(mx)); mx = fmaxf(mx, shx<16>(mx)); mx = max32(mx);
        const float inv = (mx > 0.f && mx < 3.0e38f) ? 127.0f / mx : 0.f;
        asm volatile("s_waitcnt vmcnt(0)" ::: "memory");
        v2u* orow = (v2u*)(act + (size_t)r * F * 2);
#pragma unroll
        for (int j = 0; j < NV; ++j) { unsigned w0 = 0u, w1 = 0u;
#pragma unroll
            for (int i = 0; i < 2; ++i) { const int a = (int)rintf(bflo(x[j][i]) * inv), b = (int)rintf(bfhi(x[j][i]) * inv); w0 |= (((unsigned)a & 0xffu) | (((unsigned)b & 0xffu) << 8)) << (16 * i); }
#pragma unroll
            for (int i = 0; i < 2; ++i) { const int a = (int)rintf(bflo(x[j][2 + i]) * inv), b = (int)rintf(bfhi(x[j][2 + i]) * inv); w1 |= (((unsigned)a & 0xffu) | (((unsigned)b & 0xffu) << 8)) << (16 * i); }
            orow[lane + 64 * j] = (v2u){w0, w1}; }
        if (lane == 0) sa[r] = (mx > 0.f && mx < 3.0e38f) ? mx * (1.0f / 127.0f) : 1.0f;
    }
}

__device__ __forceinline__ void h_quant_phase(const float* __restrict__ h, signed char* __restrict__ h8, float* __restrict__ sa8, const float* __restrict__ sk  , int gw, int NGW, int lane) {
    f32x4 kk[8];
#pragma unroll
    for (int j = 0; j < 8; ++j) kk[j] = ((const f32x4*)sk)[lane + 64 * j];
    for (int m = gw; m < T; m += NGW) {
        const f32x4* hr = (const f32x4*)(h + (size_t)m * DM) + lane; f32x4 v[8]; float mx = 0.f;
#pragma unroll
        for (int j = 0; j < 8; ++j) { v[j] = hr[64 * j] * kk[j]; mx = fmaxf(fmaxf(mx, fmaxf(fabsf(v[j][0]), fabsf(v[j][1]))), fmaxf(fabsf(v[j][2]), fabsf(v[j][3]))); }
        mx = fmaxf(mx, shx<1>(mx)); mx = fmaxf(mx, shx<2>(mx)); mx = fmaxf(mx, shx<4>(mx)); mx = fmaxf(mx, shx<8>(mx)); mx = fmaxf(mx, shx<16>(mx)); mx = max32(mx);
        const float inv = mx > 0.f ? 127.0f / mx : 0.f;
        unsigned* o4 = (unsigned*)(h8 + (size_t)m * DM) + lane;
#pragma unroll
        for (int j = 0; j < 8; ++j) { const int a = (int)rintf(v[j][0] * inv), b = (int)rintf(v[j][1] * inv), c = (int)rintf(v[j][2] * inv), d = (int)rintf(v[j][3] * inv);
            o4[64 * j] = ((unsigned)a & 0xffu) | (((unsigned)b & 0xffu) << 8) | (((unsigned)c & 0xffu) << 16) | (((unsigned)d & 0xffu) << 24); }
        if (lane == 0) sa8[m] = mx > 0.f ? mx * (1.0f / 127.0f) : 1.0f;
    }
}

struct GdnPre { v4u pf[6]; float g, be; };
__device__ __forceinline__ void gdn_prep_fetch(int unit, GdnPre& P, unsigned char* ws, int tid, int lane, int wave) {
    const int n = unit % GNC, bh = unit / GNC, hd = bh % GH, b = bh / GH; const int m0 = b * SEQ + n * GCH;
    const bf16* gqkv = (const bf16*)(ws + R_GQKV); const float* gbg = (const float*)(ws + R_GBG);
#pragma unroll
    for (int i = 0; i < 6; ++i) { const int idx = tid + NTHR * i, tn = idx >> 10, r = (idx & 1023) >> 4, ch = idx & 15;
        P.pf[i] = *(const GAS v4u*)(gqkv + (size_t)(m0 + r) * 1536 + tn * 512 + hd * 128 + ch * 8); }
    if (wave == 0) { P.g = gbg[(size_t)(m0 + lane) * 8 + 4 + hd]; P.be = gbg[(size_t)(m0 + lane) * 8 + hd]; }
}
__device__ __forceinline__ void gdn_prep_unit(int unit, int next_unit, GdnPre& P, unsigned char* ws, LAS unsigned char* lds, int tid, int lane, int wave) {
    const int n = unit % GNC, bh = unit / GNC, hd = bh % GH, b = bh / GH; const int m0 = b * SEQ + n * GCH; (void)m0; (void)hd;
    bf16* UT = (bf16*)(ws + R_GUT) + (size_t)unit * 8192; bf16* Wc = (bf16*)(ws + R_GW) + (size_t)unit * 8192; bf16* Qd = (bf16*)(ws + R_GQD) + (size_t)unit * 8192;
    bf16* KdT = (bf16*)(ws + R_GKDT) + (size_t)unit * 8192; bf16* Intra = (bf16*)(ws + R_GIN) + (size_t)unit * 4096; float* Gend = (float*)(ws + R_GEND);
    constexpr int LDB = 272;
    LAS unsigned char* Ks = lds; LAS unsigned char* Qs = lds + 17408; LAS unsigned char* Vs = lds + 34816;
    LAS float* MT = (LAS float*)(lds + 52224);
    LAS float* gcs = (LAS float*)(lds + 69632); LAS float* rsc = (LAS float*)(lds + 69888);
    LAS float* Xl = (LAS float*)(lds + 70400);
#pragma unroll
    for (int i = 0; i < 6; ++i) { const int idx = tid + NTHR * i, tn = idx >> 10, r = (idx & 1023) >> 4, ch = idx & 15;
        LAS unsigned char* dst = (tn == 0 ? Qs : (tn == 1 ? Ks : Vs)) + r * LDB + ch * 16;
        *(LAS v4u*)dst = P.pf[i]; }
    if (wave == 0) { float g = P.g; const float be = P.be;
        g = wave_scan(g, lane);
        gcs[lane] = g; rsc[lane] = be; rsc[64 + lane] = be * __expf(g); }
    __syncthreads();
    if (next_unit >= 0) gdn_prep_fetch(next_unit, P, ws, tid, lane, wave);
    {
        const int ct = wave >> 1, st0 = 2 * (wave & 1), g4 = lane >> 4, r16 = lane & 15;
        f32x4 ak[2] = {{0.f, 0.f, 0.f, 0.f}, {0.f, 0.f, 0.f, 0.f}}, aq[2] = {{0.f, 0.f, 0.f, 0.f}, {0.f, 0.f, 0.f, 0.f}};
#pragma unroll
        for (int ks = 0; ks < 4; ++ks) { const bf16x8 fk = lds_frag(Ks, LDB, 16 * ct, 32 * ks, lane), fq = lds_frag(Qs, LDB, 16 * ct, 32 * ks, lane);
#pragma unroll
            for (int j = 0; j < 2; ++j) { const bf16x8 fb = lds_frag(Ks, LDB, 16 * (st0 + j), 32 * ks, lane); ak[j] = MFMA16(fk, fb, ak[j]); aq[j] = MFMA16(fq, fb, aq[j]); } }
#pragma unroll
        for (int j = 0; j < 2; ++j) { const int s = 16 * (st0 + j) + r16; const float gs = gcs[s]; f32x4 mv;
#pragma unroll
            for (int i = 0; i < 4; ++i) { const int c = 16 * ct + 4 * g4 + i; const float dec = __expf(fminf(gcs[c] - gs, 0.f));
                mv[i] = (s < c) ? rsc[c] * ak[j][i] * dec : 0.f;
                Intra[c * 64 + s] = f2bf((s <= c) ? aq[j][i] * dec : 0.f); }
            *(LAS f32x4*)(MT + s * 68 + 16 * ct + 4 * g4) = mv; }
    }
    __syncthreads();
    {
#pragma unroll
        for (int i = 0; i < 2; ++i) { const int id = tid + NTHR * i, c = id >> 4, ch = id & 15; const float eg = __expf(gcs[c]);
            const v4u v = *(const LAS v4u*)(Qs + c * LDB + ch * 16);
            v4u o; o.x = cvt_pk_bf16(bflo(v.x) * eg, bfhi(v.x) * eg); o.y = cvt_pk_bf16(bflo(v.y) * eg, bfhi(v.y) * eg); o.z = cvt_pk_bf16(bflo(v.z) * eg, bfhi(v.z) * eg); o.w = cvt_pk_bf16(bflo(v.w) * eg, bfhi(v.w) * eg);
            *(v4u*)(Qd + c * 128 + ch * 8) = o; }
        const float gl = gcs[63];
#pragma unroll
        for (int i = 0; i < 2; ++i) { const int id = tid + NTHR * i, d = id >> 3, cb = id & 7; float y[8];
#pragma unroll
            for (int j = 0; j < 8; ++j) { const int c = 8 * cb + j; y[j] = bf2f(((const LAS unsigned short*)Ks)[c * 136 + d]) * __expf(gl - gcs[c]); }
            v4u o; o.x = cvt_pk_bf16(y[0], y[1]); o.y = cvt_pk_bf16(y[2], y[3]); o.z = cvt_pk_bf16(y[4], y[5]); o.w = cvt_pk_bf16(y[6], y[7]);
            *(v4u*)(KdT + d * 64 + 8 * cb) = o; }
        if (tid == 0) Gend[unit] = __expf(gl);
    }
    if (tid < 256) {
        const int col = tid, sec = __builtin_amdgcn_readfirstlane(tid >> 7);
        const LAS unsigned short* sp = (const LAS unsigned short*)(sec ? Ks : Vs) + (col & 127);
        const LAS float* rs = rsc + sec * 64;
        LAS float* Xc = Xl + col;
#pragma unroll
        for (int blk = 0; blk < 4; ++blk) {
            float acc[16];
#pragma unroll
            for (int i = 0; i < 16; ++i) acc[i] = bf2f(sp[(16 * blk + i) * 136]) * rs[16 * blk + i];
            for (int s = 0; s < 16 * blk; ++s) {
                const float xs = Xc[s * 256];
                const LAS f32x4* mt = (const LAS f32x4*)(MT + s * 68 + 16 * blk);
#pragma unroll
                for (int q = 0; q < 4; ++q) { const f32x4 m4 = mt[q]; acc[4 * q] -= m4[0] * xs; acc[4 * q + 1] -= m4[1] * xs; acc[4 * q + 2] -= m4[2] * xs; acc[4 * q + 3] -= m4[3] * xs; }
            }
#pragma unroll
            for (int j = 0; j < 16; ++j) { const float xj = acc[j]; const LAS float* mt = MT + (16 * blk + j) * 68 + 16 * blk;
#pragma unroll
                for (int i = j + 1; i < 16; ++i) acc[i] -= mt[i] * xj; }
            if (blk < 3) {
#pragma unroll
                for (int i = 0; i < 16; ++i) Xc[(16 * blk + i) * 256] = acc[i]; }
            if (!sec) { v4u o0, o1;
                o0.x = cvt_pk_bf16(acc[0], acc[1]); o0.y = cvt_pk_bf16(acc[2], acc[3]); o0.z = cvt_pk_bf16(acc[4], acc[5]); o0.w = cvt_pk_bf16(acc[6], acc[7]);
                o1.x = cvt_pk_bf16(acc[8], acc[9]); o1.y = cvt_pk_bf16(acc[10], acc[11]); o1.z = cvt_pk_bf16(acc[12], acc[13]); o1.w = cvt_pk_bf16(acc[14], acc[15]);
                *(v4u*)(UT + col * 64 + 16 * blk) = o0; *(v4u*)(UT + col * 64 + 16 * blk + 8) = o1;
            } else {
#pragma unroll
                for (int i = 0; i < 16; ++i) Wc[(16 * blk + i) * 128 + (col - 128)] = f2bf(acc[i]); }
        }
    }
    __syncthreads();
}

__device__ __forceinline__ bf16x8 gfrag(const bf16* base, int ld, int row0, int k0, int lane) {
    return *(const GAS bf16x8*)(base + (size_t)(row0 + (lane & 15)) * ld + k0 + 8 * (lane >> 4));
}
__device__ __forceinline__ void gdn_scan_unit(int bh, const float* __restrict__ norm_g, unsigned char* ws, LAS unsigned char* lds, int tid, int lane, int wave) {
    const int hd = bh % GH, b = bh / GH;
    const bf16* UTb = (const bf16*)(ws + R_GUT); const bf16* Wb = (const bf16*)(ws + R_GW); const bf16* Qdb = (const bf16*)(ws + R_GQD);
    const bf16* KdTb = (const bf16*)(ws + R_GKDT); const bf16* Inb = (const bf16*)(ws + R_GIN); const float* Gend = (const float*)(ws + R_GEND);
    const bf16* u = (const bf16*)(ws + R_U); bf16* mix = (bf16*)(ws + WS_MIX);
    constexpr int STB = 272, VTB = 144;
    LAS unsigned char* ST0 = lds; LAS unsigned char* VT = lds + 69632; LAS float* ssq = (LAS float*)(lds + 88064); LAS float* NG = (LAS float*)(lds + 88576);
    LAS unsigned char* OT = lds + 89088; constexpr int OTB = 528;
    const int ct = wave & 3, eh = wave >> 2, g4 = lane >> 4, r16 = lane & 15;
    f32x4 S[8];
#pragma unroll
    for (int i = 0; i < 8; ++i) S[i] = (f32x4){0.f, 0.f, 0.f, 0.f};
    for (int i = tid; i < 2 * 34816 / 16; i += NTHR) ((LAS v4u*)ST0)[i] = (v4u){0u, 0u, 0u, 0u};
    if (tid < GD) NG[tid] = norm_g[tid];
    bf16x8 aW[4], aQ[4], aI[2], aK[2]; v2u ut[4]; v4u zz[2];
    const float gall = *(const GAS float*)(Gend + (size_t)bh * GNC + lane);
    const size_t u0 = (size_t)bh * GNC;
#define GS_EARLY(W_, Q_, U_, un) do { _Pragma("unroll") for (int ks = 0; ks < 4; ++ks) { W_[ks] = gfrag(Wb + (un) * 8192, 128, 16 * ct, 32 * ks, lane); Q_[ks] = gfrag(Qdb + (un) * 8192, 128, 16 * ct, 32 * ks, lane); } \
        _Pragma("unroll") for (int j = 0; j < 4; ++j) U_[j] = *(const GAS v2u*)(UTb + (un) * 8192 + (16 * (4 * eh + j) + r16) * 64 + 16 * ct + 4 * g4); } while (0)
#define GS_LATE(un) do { _Pragma("unroll") for (int ks = 0; ks < 2; ++ks) { aI[ks] = gfrag(Inb + (un) * 4096, 64, 16 * ct, 32 * ks, lane); aK[ks] = gfrag(KdTb + (un) * 8192, 64, 16 * wave, 32 * ks, lane); } \
        } while (0)
#define GS_Z(n_) do { _Pragma("unroll") for (int p = 0; p < 2; ++p) zz[p] = *(const GAS v4u*)(u + (size_t)(b * SEQ + (n_) * GCH + 8 * wave + 4 * p + g4) * D_INP + U_GZ + hd * 128 + 8 * r16); } while (0)
    GS_EARLY(aW, aQ, ut, u0); GS_LATE(u0);
    __syncthreads();
    for (int n = 0; n < GNC; ++n) {
        const int cur = n & 1;
        LAS unsigned char* STc = ST0 + cur * 34816; LAS unsigned char* STn = ST0 + (cur ^ 1) * 34816;
        GS_Z(n);
        f32x4 o[4];
        {
            bf16x8 stf[4][4];
#pragma unroll
            for (int j = 0; j < 4; ++j)
#pragma unroll
                for (int ks = 0; ks < 4; ++ks) stf[j][ks] = lds_frag(STc, STB, 16 * (4 * eh + j), 32 * ks, lane);
            __builtin_amdgcn_sched_barrier(0);
#pragma unroll
            for (int j = 0; j < 4; ++j) { f32x4 av = {0.f, 0.f, 0.f, 0.f}, ao = {0.f, 0.f, 0.f, 0.f};
#pragma unroll
                for (int ks = 0; ks < 4; ++ks) { av = MFMA16(aW[ks], stf[j][ks], av); ao = MFMA16(stf[j][ks], aQ[ks], ao); }
                o[j] = ao;
                f32x4 vn; vn[0] = bflo(ut[j].x) - av[0]; vn[1] = bfhi(ut[j].x) - av[1]; vn[2] = bflo(ut[j].y) - av[2]; vn[3] = bfhi(ut[j].y) - av[3];
                *(LAS v2u*)(VT + (16 * (4 * eh + j) + r16) * VTB + (16 * ct + 4 * g4) * 2) = pack4(vn); }
        }
        __builtin_amdgcn_sched_barrier(0);
        if (n + 1 < GNC) GS_EARLY(aW, aQ, ut, u0 + n + 1);
        __syncthreads();
        float ss = 0.f;
        {
            bf16x8 vtf[8][2];
#pragma unroll
            for (int et = 0; et < 8; ++et)
#pragma unroll
                for (int ks = 0; ks < 2; ++ks) vtf[et][ks] = lds_frag(VT, VTB, 16 * et, 32 * ks, lane);
            __builtin_amdgcn_sched_barrier(0);
            if (eh == 0) {
#pragma unroll
                for (int j = 0; j < 4; ++j) { o[j] = MFMA16(vtf[j][0], aI[0], o[j]); o[j] = MFMA16(vtf[j][1], aI[1], o[j]); }
            } else {
#pragma unroll
                for (int j = 0; j < 4; ++j) { o[j] = MFMA16(vtf[4 + j][0], aI[0], o[j]); o[j] = MFMA16(vtf[4 + j][1], aI[1], o[j]); }
            }
            const float ge = __builtin_bit_cast(float, __builtin_amdgcn_readlane(__builtin_bit_cast(int, gall), n));
#pragma unroll
            for (int et = 0; et < 8; ++et) { f32x4 acc = S[et] * ge;
                acc = MFMA16(aK[0], vtf[et][0], acc); acc = MFMA16(aK[1], vtf[et][1], acc);
                S[et] = acc;
                *(LAS v2u*)(STn + (16 * et + r16) * STB + (16 * wave + 4 * g4) * 2) = pack4_mfma(acc); }
        }
        __builtin_amdgcn_sched_barrier(0);
        if (n + 1 < GNC) GS_LATE(u0 + n + 1);
#pragma unroll
        for (int j = 0; j < 4; ++j) { ss += (o[j][0] * o[j][0] + o[j][1] * o[j][1]) + (o[j][2] * o[j][2] + o[j][3] * o[j][3]);
            *(LAS f32x4*)(OT + (16 * ct + r16) * OTB + (16 * (4 * eh + j) + 4 * g4) * 4) = o[j]; }
        ss += shx<16>(ss); ss = sum32(ss);
        if (g4 == 0) ssq[eh * 64 + 16 * ct + r16] = ss;
        __syncthreads();
#pragma unroll
        for (int p = 0; p < 2; ++p) { const int row = 8 * wave + 4 * p + g4, e0 = 8 * r16;
            const float tot = ssq[row] + ssq[64 + row]; const float rs = rsqrtf(tot * (1.0f / GD) + EPS);
            const f32x4 oa = *(const LAS f32x4*)(OT + row * OTB + e0 * 4), ob = *(const LAS f32x4*)(OT + row * OTB + e0 * 4 + 16);
            const f32x4 na = *(const LAS f32x4*)(NG + e0), nb = *(const LAS f32x4*)(NG + e0 + 4); const v4u zv = zz[p];
            u32x4 w;
            w.x = cvt_pk_bf16(oa[0] * rs * na[0] * siluf_(bflo(zv.x)), oa[1] * rs * na[1] * siluf_(bfhi(zv.x))); w.y = cvt_pk_bf16(oa[2] * rs * na[2] * siluf_(bflo(zv.y)), oa[3] * rs * na[3] * siluf_(bfhi(zv.y)));
            w.z = cvt_pk_bf16(ob[0] * rs * nb[0] * siluf_(bflo(zv.z)), ob[1] * rs * nb[1] * siluf_(bfhi(zv.z))); w.w = cvt_pk_bf16(ob[2] * rs * nb[2] * siluf_(bflo(zv.w)), ob[3] * rs * nb[3] * siluf_(bfhi(zv.w)));
            *(GAS u32x4*)(mix + (size_t)(b * SEQ + n * GCH + row) * DM + hd * 128 + e0) = w; }
    }
#undef GS_EARLY
#undef GS_LATE
#undef GS_Z
    __syncthreads();
}

__device__ __forceinline__ void attn_unit(int b, int hd, int qb, unsigned char* ws, LAS unsigned char* lds, int tid, int lane, int wave) {
    const bf16* Q = (const bf16*)(ws + R_Q); const bf16* K = (const bf16*)(ws + R_K); const bf16* KV = (const bf16*)(ws + R_KVRAW); bf16* mix = (bf16*)(ws + WS_MIX);
    constexpr int VLB = 288, KBUF = 64 * 384, VBUF = 64 * VLB;
    LAS unsigned char* Ks0 = lds; LAS unsigned char* Vs0 = lds + 2 * KBUF;
    const int g4 = lane >> 4, r16 = lane & 15;
    const size_t mb = (size_t)b * SEQ;
    bf16x8 qf[6];
#pragma unroll
    for (int ks = 0; ks < 6; ++ks) qf[ks] = glb_frag(Q + mb * 768 + hd * MQK, 768, 128 * qb + 16 * wave, 32 * ks, lane);
    const int nkt = 2 * (qb + 1);
    v4u kst[3], vst[2];
#define ATT_KMAP const int id = tid + NTHR * i, rest = id >> 3, r = 2 * (rest / 6) + ((id >> 2) & 1), ch = (rest % 6) * 4 + (id & 3)
#define ATT_LOAD(kt) do { _Pragma("unroll") for (int i = 0; i < 3; ++i) { ATT_KMAP; \
            kst[i] = *(const v4u*)(K + (mb + 64 * (kt) + r) * 768 + hd * MQK + 8 * ch); } \
        _Pragma("unroll") for (int i = 0; i < 2; ++i) { const int id = tid + NTHR * i, r = id >> 4, ch = id & 15; \
            vst[i] = *(const v4u*)(KV + (mb + 64 * (kt) + r) * 1024 + hd * 256 + 128 + 8 * ch); } } while (0)
#define ATT_STORE(buf) do { _Pragma("unroll") for (int i = 0; i < 3; ++i) { ATT_KMAP; \
            *(LAS v4u*)(Ks0 + (buf) * KBUF + ((r >> 4) * 6 + (ch >> 2)) * 1024 + ((((r & 15) * 64) + (ch & 3) * 16) ^ (((r >> 3) & 1) << 5))) = kst[i]; } \
        _Pragma("unroll") for (int i = 0; i < 2; ++i) { const int id = tid + NTHR * i, r = id >> 4, ch = id & 15; \
            *(LAS v4u*)(Vs0 + (buf) * VBUF + r * VLB + ch * 16) = vst[i]; } } while (0)
    ATT_LOAD(0); ATT_STORE(0); ATT_LOAD(1);
    __syncthreads();
    const int klane = ((r16 * 64) + g4 * 16) ^ ((r16 >> 3) << 5);
    f32x4 O[8];
#pragma unroll
    for (int i = 0; i < 8; ++i) O[i] = (f32x4){0.f, 0.f, 0.f, 0.f};
    float mrun = -1.0e30f, lrun = 0.f;
    const int qpos = 128 * qb + 16 * wave + r16;
    for (int kt = 0; kt < nkt; ++kt) {
        const int cur = kt & 1;
        if (kt + 1 < nkt) ATT_STORE(cur ^ 1);
        if (kt + 2 < nkt) ATT_LOAD(kt + 2);
        const LAS unsigned char* Kc = Ks0 + cur * KBUF + klane; const LAS unsigned char* Vc = Vs0 + cur * VBUF;
        f32x4 s[4];
#pragma unroll
        for (int nt = 0; nt < 4; ++nt) { f32x4 acc = {0.f, 0.f, 0.f, 0.f};
#pragma unroll
            for (int ks = 0; ks < 6; ++ks) acc = MFMA16(*(const LAS bf16x8*)(Kc + (nt * 6 + ks) * 1024), qf[ks], acc);
            s[nt] = acc; }
        if (kt >= 2 * qb) {
#pragma unroll
            for (int nt = 0; nt < 4; ++nt)
#pragma unroll
                for (int i = 0; i < 4; ++i) { const int key = 64 * kt + 16 * nt + 4 * g4 + i; if (key > qpos) s[nt][i] = -__builtin_inff(); }
        }
        float mx = s[0][0];
#pragma unroll
        for (int nt = 0; nt < 4; ++nt)
#pragma unroll
            for (int i = 0; i < 4; ++i) mx = fmaxf(mx, s[nt][i]);
        mx = fmaxf(mx, shx<16>(mx)); mx = max32(mx);
        const float mnew = fmaxf(mrun, mx), alpha = __builtin_amdgcn_exp2f(mrun - mnew); mrun = mnew;
        float ps = 0.f;
#pragma unroll
        for (int nt = 0; nt < 4; ++nt)
#pragma unroll
            for (int i = 0; i < 4; ++i) { const float p = __builtin_amdgcn_exp2f(s[nt][i] - mnew); s[nt][i] = p; ps += p; }
        lrun = lrun * alpha + ps;
        const bf16x8 pf0 = pack_frag(s[0], s[1]), pf1 = pack_frag(s[2], s[3]);
        if (!__all(alpha == 1.0f)) {
#pragma unroll
            for (int dt = 0; dt < 8; ++dt) O[dt] = O[dt] * alpha; }
#pragma unroll
        for (int dt = 0; dt < 8; ++dt) { f32x4 acc = O[dt];
            acc = MFMA16(lds_frag_trp(Vc, VLB, 0, 16 * dt, lane), pf0, acc);
            acc = MFMA16(lds_frag_trp(Vc, VLB, 32, 16 * dt, lane), pf1, acc);
            O[dt] = acc; }
        __syncthreads();
    }
#undef ATT_KMAP
#undef ATT_LOAD
#undef ATT_STORE
    lrun += shx<16>(lrun); lrun = sum32(lrun);
    const float inv = 1.0f / lrun;
    bf16* orow = mix + (mb + qpos) * DM + 1536 + hd * MV;
#pragma unroll
    for (int dt = 0; dt < 8; ++dt) *(v2u*)(orow + 16 * dt + 4 * g4) = pack4(O[dt] * inv);
}

__device__ __forceinline__ void ssd_state_unit(int unit, const float* __restrict__ a_log, unsigned char* ws, LAS unsigned char* lds, int tid, int lane, int wave) {
    const int hd = unit % SH, bc = unit / SH; const int m0 = bc * SCH;
    const bf16* xc = (const bf16*)(ws + R_XC); const float* dtb = (const float*)(ws + R_DT);
    float* st = (float*)(ws + R_SST) + (size_t)unit * (SP * SN); float* dA = (float*)(ws + R_SDA);
    constexpr int XLB = 144, BLB = 272;
    LAS unsigned char* Xs = lds; LAS unsigned char* Bs = lds + 36864; LAS float* acs = (LAS float*)(lds + 106496);
    const int grp = hd >> 3;
#pragma unroll
    for (int i = 0; i < 8; ++i) { const int id = tid + NTHR * i, r = id >> 4, ch = id & 15;
        *(LAS v4u*)(Bs + r * BLB + ch * 16) = *(const v4u*)(xc + (size_t)(m0 + r) * SCONV + 1024 + grp * 128 + 8 * ch); }
    if (wave == 0) { const float A = -__expf(a_log[hd]); float d[4]; float run = 0.f;
#pragma unroll
        for (int i = 0; i < 4; ++i) { run += dtb[(size_t)(m0 + 4 * lane + i) * 16 + hd] * A; d[i] = run; }
        const float ex = wave_scan(run, lane) - run;
#pragma unroll
        for (int i = 0; i < 4; ++i) acs[4 * lane + i] = d[i] + ex; }
    __syncthreads();
    const float alast = acs[255];
#pragma unroll
    for (int i = 0; i < 4; ++i) { const int id = tid + NTHR * i, r = id >> 3, ch = id & 7;
        const v4u v = *(const v4u*)(xc + (size_t)(m0 + r) * SCONV + hd * 64 + 8 * ch);
        const float sc = dtb[(size_t)(m0 + r) * 16 + hd] * __expf(alast - acs[r]);
        v4u o; o.x = cvt_pk_bf16(bflo(v.x) * sc, bfhi(v.x) * sc); o.y = cvt_pk_bf16(bflo(v.y) * sc, bfhi(v.y) * sc); o.z = cvt_pk_bf16(bflo(v.z) * sc, bfhi(v.z) * sc); o.w = cvt_pk_bf16(bflo(v.w) * sc, bfhi(v.w) * sc);
        *(LAS v4u*)(Xs + r * XLB + ch * 16) = o; }
    if (tid == 0) dA[unit] = __expf(alast);
    __syncthreads();
    { const int pt = wave & 3, nh = wave >> 2, g4 = lane >> 4, r16 = lane & 15;
      f32x4 acc[4] = {{0.f, 0.f, 0.f, 0.f}, {0.f, 0.f, 0.f, 0.f}, {0.f, 0.f, 0.f, 0.f}, {0.f, 0.f, 0.f, 0.f}};
#pragma unroll
      for (int ks = 0; ks < 8; ++ks) { const bf16x8 a = lds_frag_tr(Xs, XLB, 32 * ks, 16 * pt, lane);
#pragma unroll
          for (int j = 0; j < 4; ++j) acc[j] = MFMA16(a, lds_frag_tr(Bs, BLB, 32 * ks, 16 * (4 * nh + j), lane), acc[j]); }
#pragma unroll
      for (int j = 0; j < 4; ++j)
#pragma unroll
          for (int i = 0; i < 4; ++i) st[(16 * pt + 4 * g4 + i) * SN + 16 * (4 * nh + j) + r16] = acc[j][i]; }
    __syncthreads();
}

__device__ __forceinline__ void ssd_out_unit(int unit, InP in, int L, unsigned char* ws, LAS unsigned char* lds, int tid, int lane, int wave) {
    asm volatile("" : "+v"(tid), "+v"(lane));
    const int hf = unit & 1, grp = (unit >> 1) & 1, bc = unit >> 2; const int m0 = bc * SCH;
    const bf16* xc = (const bf16*)(ws + R_XC); const float* dtb = (const float*)(ws + R_DT); const bf16* pv = (const bf16*)(ws + R_SPV);
    const bf16* u = (const bf16*)(ws + R_U); bf16* mix = (bf16*)(ws + WS_MIX);
    const float* a_log = in->p[12] + L * SH; const float* dsk = in->p[14] + L * SH; const float* ng = in->p[15] + (size_t)L * SWD;
    constexpr int CLB = 272, XLB = 144;
    LAS unsigned char* Cs = lds; LAS unsigned char* Bs = lds + 34816;
    LAS float* acs8 = (LAS float*)(lds + 104448); LAS float* dt8 = (LAS float*)(lds + 112640);
    const int nS = 128 * (hf + 1);
    const int g4 = lane >> 4, r16 = lane & 15;
#pragma unroll
    for (int i = 0; i < 4; ++i) { const int id = tid + NTHR * i, r = id >> 4, ch = id & 15;
        *(LAS v4u*)(Cs + r * CLB + ch * 16) = *(const v4u*)(xc + (size_t)(m0 + 128 * hf + r) * SCONV + 1280 + grp * 128 + 8 * ch); }
    for (int i = 0; i < 4 * (hf + 1); ++i) { const int id = tid + NTHR * i, r = id >> 4, ch = id & 15;
        *(LAS v4u*)(Bs + r * CLB + ch * 16) = *(const v4u*)(xc + (size_t)(m0 + r) * SCONV + 1024 + grp * 128 + 8 * ch); }
    { const int hd = 8 * grp + wave; const float A = -__expf(a_log[hd]); float d[4], dv[4]; float run = 0.f;
#pragma unroll
      for (int i = 0; i < 4; ++i) { dv[i] = dtb[(size_t)(m0 + 4 * lane + i) * 16 + hd]; run += dv[i] * A; d[i] = run; }
      const float ex = wave_scan(run, lane) - run;
#pragma unroll
      for (int i = 0; i < 4; ++i) { acs8[wave * 256 + 4 * lane + i] = d[i] + ex; dt8[wave * 256 + 4 * lane + i] = dv[i]; } }
    __syncthreads();
    const int lim = 8 * hf + wave;
    const int lloc = 128 * hf + 16 * wave + r16;
    bf16x8 bC[4];
#pragma unroll
    for (int ks = 0; ks < 4; ++ks) bC[ks] = lds_frag(Cs, CLB, 16 * wave, 32 * ks, lane);
    v2u cb[16];
#pragma unroll
    for (int stt = 0; stt < 16; ++stt) { f32x4 acc = {0.f, 0.f, 0.f, 0.f};
        if (stt <= lim) {
#pragma unroll
            for (int ks = 0; ks < 4; ++ks) acc = MFMA16(lds_frag(Bs, CLB, 16 * stt, 32 * ks, lane), bC[ks], acc); }
        cb[stt] = pack4_mfma(acc); }
    __syncthreads();
    float ssq = 0.f;
    constexpr int XB2 = 136;
    LAS unsigned char* Xb0 = lds + 34816; LAS unsigned char* Xb1 = lds + 69632;
    LAS unsigned char* Pb0 = lds; LAS unsigned char* Pb1 = lds + 17408;
    v4u xr[4], pr[2];
#define SO_PLOAD(hd_) do { const bf16* ph_ = pv + ((size_t)bc * SH + (hd_)) * (SP * SN); _Pragma("unroll") for (int i = 0; i < 2; ++i) { const int id = tid + NTHR * i; pr[i] = *(const GAS v4u*)(ph_ + (size_t)id * 8); } } while (0)
#define SO_PSTORE(buf) do { _Pragma("unroll") for (int i = 0; i < 2; ++i) { const int id = tid + NTHR * i, r = id >> 4, ch = id & 15; *(LAS v4u*)((buf) + r * CLB + ch * 16) = pr[i]; } } while (0)
#define SO_XLOAD(hd_) do { _Pragma("unroll") for (int i = 0; i < 4; ++i) if (i < 2 * (hf + 1)) { const int id = tid + NTHR * i, r = id >> 3, ch = id & 7; \
            xr[i] = *(const GAS v4u*)(xc + (size_t)(m0 + r) * SCONV + (hd_) * 64 + 8 * ch); } } while (0)
#define SO_XSTORE(buf) do { _Pragma("unroll") for (int i = 0; i < 4; ++i) if (i < 2 * (hf + 1)) { const int id = tid + NTHR * i, r = id >> 3, ch = id & 7; \
            LAS v2u* d_ = (LAS v2u*)((buf) + r * XB2 + ch * 16); d_[0] = (v2u){xr[i].x, xr[i].y}; d_[1] = (v2u){xr[i].z, xr[i].w}; } } while (0)
    SO_XLOAD(8 * grp); SO_PLOAD(8 * grp); SO_XSTORE(Xb0); SO_PSTORE(Pb0);
    __syncthreads();
    for (int e = 0; e < 8; ++e) {
        const int hd = 8 * grp + e;
        LAS unsigned char* Xs = (e & 1) ? Xb1 : Xb0; LAS unsigned char* Xn = (e & 1) ? Xb0 : Xb1;
        LAS unsigned char* Ps = (e & 1) ? Pb1 : Pb0; LAS unsigned char* Pn = (e & 1) ? Pb0 : Pb1;
        if (e + 1 < 8) { SO_XLOAD(hd + 1); SO_PLOAD(hd + 1); }

        const LAS float* ac = acs8 + e * 256; const LAS float* dd = dt8 + e * 256;
        const float al = ac[lloc];
        f32x4 y[4] = {{0.f, 0.f, 0.f, 0.f}, {0.f, 0.f, 0.f, 0.f}, {0.f, 0.f, 0.f, 0.f}, {0.f, 0.f, 0.f, 0.f}};
#pragma unroll
        for (int kb = 0; kb < 8; ++kb) {
            if (2 * kb <= lim) {
                f32x4 m0v, m1v;
                const f32x4 c0 = {bflo(cb[2 * kb].x), bfhi(cb[2 * kb].x), bflo(cb[2 * kb].y), bfhi(cb[2 * kb].y)}, c1 = {bflo(cb[2 * kb + 1].x), bfhi(cb[2 * kb + 1].x), bflo(cb[2 * kb + 1].y), bfhi(cb[2 * kb + 1].y)};
#pragma unroll
                for (int i = 0; i < 4; ++i) { const int s0 = 32 * kb + 4 * g4 + i, s1 = s0 + 16;
                    m0v[i] = (s0 <= lloc) ? c0[i] * __expf(al - ac[s0]) * dd[s0] : 0.f;
                    m1v[i] = (s1 <= lloc) ? c1[i] * __expf(al - ac[s1]) * dd[s1] : 0.f; }
                const bf16x8 mf = pack_frag(m0v, m1v);
#pragma unroll
                for (int pt = 0; pt < 4; ++pt) y[pt] = MFMA16(lds_frag_trp(Xs, XB2, 32 * kb, 16 * pt, lane), mf, y[pt]);
            }
            __builtin_amdgcn_sched_barrier(0);
        }
        const float eal = __expf(al), dk = dsk[hd];
#pragma unroll
        for (int pt = 0; pt < 4; ++pt) { f32x4 acc = {0.f, 0.f, 0.f, 0.f};
#pragma unroll
            for (int ks = 0; ks < 4; ++ks) acc = MFMA16(lds_frag(Ps, CLB, 16 * pt, 32 * ks, lane), bC[ks], acc);
            const v2u xv = *(const LAS v2u*)(Xs + lloc * XB2 + (16 * pt + 4 * g4) * 2);
            const v2u zq = *(const GAS v2u*)(u + (size_t)(m0 + lloc) * D_INP + U_SZ + hd * 64 + 16 * pt + 4 * g4);
            f32x4 r;
            r[0] = (y[pt][0] + eal * acc[0] + dk * bflo(xv.x)) * siluf_(bflo(zq.x)); r[1] = (y[pt][1] + eal * acc[1] + dk * bfhi(xv.x)) * siluf_(bfhi(zq.x));
            r[2] = (y[pt][2] + eal * acc[2] + dk * bflo(xv.y)) * siluf_(bflo(zq.y)); r[3] = (y[pt][3] + eal * acc[3] + dk * bfhi(xv.y)) * siluf_(bfhi(zq.y));
            const v2u pk = pack4(r);
            const float q0 = bflo(pk.x), q1 = bfhi(pk.x), q2 = bflo(pk.y), q3 = bfhi(pk.y);
            ssq += (q0 * q0 + q1 * q1) + (q2 * q2 + q3 * q3);
            *(v2u*)(mix + (size_t)(m0 + lloc) * DM + 512 + hd * 64 + 16 * pt + 4 * g4) = pk; }
        if (e + 1 < 8) { SO_XSTORE(Xn); SO_PSTORE(Pn); }
        __syncthreads();
    }
#undef SO_XLOAD
#undef SO_XSTORE
#undef SO_PLOAD
#undef SO_PSTORE
    ssq += shx<16>(ssq); ssq = sum32(ssq);
    const float rs = rsqrtf(ssq * (1.0f / 512.0f) + EPS);
    VM_WAIT();
    for (int e = 0; e < 8; ++e) { const int hd = 8 * grp + e;
#pragma unroll
        for (int pt = 0; pt < 4; ++pt) { bf16* p = mix + (size_t)(m0 + lloc) * DM + 512 + hd * 64 + 16 * pt + 4 * g4; const v2u pk = *(const v2u*)p;
            const f32x4 gg = *(const f32x4*)(ng + hd * 64 + 16 * pt + 4 * g4);
            f32x4 r; r[0] = bflo(pk.x) * rs * gg[0]; r[1] = bfhi(pk.x) * rs * gg[1]; r[2] = bflo(pk.y) * rs * gg[2]; r[3] = bfhi(pk.y) * rs * gg[3];
            *(v2u*)p = pack4(r); } }
}

#ifndef MK_PER_PHASE
#define MK_PER_PHASE 0
#endif
#define PHASE_FN __device__ __forceinline__
#define LND(p) asm volatile("" : "+s"(p))
#define PH_IDS int tid_ = threadIdx.x; asm volatile("" : "+v"(tid_)); int G_ = gridDim.x, bid_ = blockIdx.x; LND(G_); LND(bid_); const int tid = tid_, G = G_, bid = bid_; const int lane = tid & 63, wave = __builtin_amdgcn_readfirstlane(tid >> 6); \
    const int gw = bid * NWAVES + wave, NGW = G * NWAVES, gtid = bid * NTHR + tid, NGT = G * NTHR; (void)lane; (void)gw; (void)NGW; (void)gtid; (void)NGT
constexpr int PH_PER_LAYER = 14, N_PHASES = 1 + 2 * PH_PER_LAYER;
struct Args { In in; float* out; unsigned char* ws; int ph_lo, ph_hi; };

PHASE_FN void ph_prologue(InP in, unsigned char* ws, LAS unsigned char* lds) { LND(in); LND(ws); LND(lds); PH_IDS; prologue_phase(in, ws, lds, gw, NGW, wave, lane, gtid, NGT, bid, G); }
template <int WHICH> PHASE_FN void ph_rms(InP in, int L, float* hbuf, unsigned char* ws, LAS unsigned char* lds) { LND(in); LND(hbuf); LND(ws); LND(lds); PH_IDS;
    const float* h = (WHICH == 0 && L == 0) ? in->p[0] : hbuf; const float* g = (WHICH == 0 ? in->p[3] : in->p[22]) + (size_t)L * DM;
    if (WHICH == 2) rms_phase<true, true>(h, g, nullptr, (signed char*)(ws + WS_HN8), (float*)(ws + WS_SA), in->p[26], (int*)(ws + WS_ROUTE), (float*)(ws + WS_ROUTE + (size_t)T * 8), (unsigned*)(ws + WS_CTL) + CW_CNT, lds, gw, NGW, lane, tid);
    else rms_phase<false, true>(h, g, nullptr, (signed char*)(ws + WS_HN8), (float*)(ws + WS_SA), nullptr, nullptr, nullptr, nullptr, lds, gw, NGW, lane, tid);
    if (WHICH == 1) scale_fold(0, ws, gtid, NGT);
    if (WHICH == 2) scale_fold(1, ws, gtid, NGT); }
PHASE_FN void ph_gemm_win(int L, unsigned char* ws, LAS unsigned char* lds) { LND(ws); LND(lds); PH_IDS;
    pg8::Gemm g{ws + WS_HN8, ws + WS_WIN + (size_t)L * (SZ_WIN / 2), T, D_INP, DM, 0}; pg8::StaticOrder S; S.init(T, D_INP, G, bid);
    pg8::EpiBf16Plain8 E{(bf16*)(ws + R_U), D_INP, (const float*)(ws + WS_SA), (const float*)(ws + WS_SWIN) + L * D_INP}; pg8::gemm_phase<pg8::EpiBf16Plain8, pg8::StaticOrder, true, true, 1>(lds, g, S, E); }
PHASE_FN void ph_conv(InP in, int L, unsigned char* ws) { LND(in); LND(ws); PH_IDS; conv_phase(in, L, ws, gw, NGW, lane); }
template <int WHICH> PHASE_FN void ph_gemm_plain(int L, unsigned char* ws, LAS unsigned char* lds, int first = -1, int nblk = 0) { LND(ws); LND(lds); PH_IDS;
    const bf16* A = WHICH == 0 ? (const bf16*)(ws + R_QLN) : WHICH == 1 ? (const bf16*)(ws + R_KVLN) : (const bf16*)(ws + WS_PB) + (size_t)L * T * PLE_DIM;
    const bf16* Bt = WHICH == 0 ? (const bf16*)(ws + WS_WQB + L * SZ_WQB) : WHICH == 1 ? (const bf16*)(ws + WS_WKVB + L * SZ_WKVB) : (const bf16*)(ws + WS_WPP + L * SZ_WPP);
    bf16* O = WHICH == 0 ? (bf16*)(ws + R_QRAW) : WHICH == 1 ? (bf16*)(ws + R_KVRAW) : (bf16*)(ws + WS_E);
    constexpr int N = WHICH == 0 ? 768 : WHICH == 1 ? 1024 : DM, K = WHICH == 0 ? MQR : WHICH == 1 ? MKVR : PLE_DIM;
    pg8::Gemm g{A, Bt, T, N, K, 0}; pg8::StaticOrder S;
    if (first < 0) S.init(T, N, G, bid); else { if (bid < first) return; S.init(T, N, nblk, bid - first); }
    pg8::EpiBf16Plain E{O, N}; pg8::gemm_phase<pg8::EpiBf16Plain, pg8::StaticOrder, true, true>(lds, g, S, E); }
constexpr int WIN_ND = 16;
PHASE_FN void ph_down_quant(InP in, unsigned char* ws, LAS unsigned char* lds, int off) { LND(in); LND(ws); LND(lds); PH_IDS;
    const int NS = BATCH * GH + (G == 256 ? WIN_ND : 0); if (G > 2 * NS) { if (bid < NS) return; const int st = G - NS; down_quant_phase(in->p[25], in->p[29], ws, lds, (bid - NS - off % st + st) % st, st, lane, wave); }
    else down_quant_phase(in->p[25], in->p[29], ws, lds, bid, G, lane, wave); }
constexpr int MOE_GU_L0 = 768;
PHASE_FN void ph_moe_gu_quant(InP in, unsigned char* ws, LAS unsigned char* lds, int lo, int hi, int off) { LND(in); LND(ws); LND(lds); PH_IDS;
    const int NS = BATCH * GH + (G == 256 ? WIN_ND : 0); if (G > 2 * NS) { if (bid < NS) return; const int st = G - NS; moe_gu_quant_phase(in, ws, lds, lo, hi, (bid - NS - off % st + st) % st, st, lane, wave); }
    else moe_gu_quant_phase(in, ws, lds, lo, hi, bid, G, lane, wave); }
PHASE_FN void ph_gemm_pe(InP in, int L, unsigned char* ws, LAS unsigned char* lds, int first, int nblk) { LND(in); LND(ws); LND(lds); PH_IDS;
    pg8::Gemm g{(const bf16*)(ws + WS_PB) + (size_t)L * T * PLE_DIM, ws + WS_WPP + L * SZ_WPP, T, DM, PLE_DIM, 0}; pg8::StaticOrder S;
    if (first < 0) S.init(T, DM, G, bid); else { if (bid < first) return; S.init(T, DM, nblk, bid - first); }
    pg8::EpiPeSS E{(bf16*)(ws + WS_E), DM, in->p[32] + (size_t)L * DM, (float*)(ws + WS_SSP) + (size_t)L * T * 32}; pg8::gemm_phase<pg8::EpiPeSS, pg8::StaticOrder, true, true>(lds, g, S, E); }
PHASE_FN void ph_gdn_prep(unsigned char* ws, LAS unsigned char* lds) { LND(ws); LND(lds); PH_IDS; GdnPre P; if (bid < GNU) gdn_prep_fetch(bid, P, ws, tid, lane, wave);
    for (int un = bid; un < GNU; un += G) gdn_prep_unit(un, un + G < GNU ? un + G : -1, P, ws, lds, tid, lane, wave); }
PHASE_FN void ph_ssd_state(InP in, int L, unsigned char* ws, LAS unsigned char* lds) { LND(in); LND(ws); LND(lds); PH_IDS; const float* a_log = in->p[12] + L * SH; for (int un = bid; un < BATCH * SNC * SH; un += G) ssd_state_unit(un, a_log, ws, lds, tid, lane, wave); }
PHASE_FN void ph_mlaprep(InP in, int L, unsigned char* ws) { LND(in); LND(ws); PH_IDS; mlaprep_phase(in, L, ws, gw, NGW, lane); ssd_scan_phase(ws, gtid, NGT);
    { const f32x4* sp = (const f32x4*)((const float*)(ws + WS_SSP) + (size_t)L * T * 32); float* rs = (float*)(ws + WS_RSE) + (size_t)L * T;
      for (int r = gtid; r < T; r += NGT) { float q = 0.f;
#pragma unroll
          for (int j = 0; j < 8; ++j) { const f32x4 x = sp[(size_t)r * 8 + j]; q += (x[0] + x[1]) + (x[2] + x[3]); }
          rs[r] = rsqrtf(q * (1.0f / DM) + EPS); } }
#ifdef MK_ZERO_MIX
    for (size_t i = gtid; i < (size_t)T * DM / 8; i += NGT) ((v4u*)(ws + WS_MIX))[i] = (v4u){0u, 0u, 0u, 0u};
#endif
}
PHASE_FN void ph_gdn_scan(InP in, int L, unsigned char* ws, LAS unsigned char* lds) { LND(in); LND(ws); LND(lds); PH_IDS; if (bid < BATCH * GH) gdn_scan_unit(bid, in->p[9] + L * GD, ws, lds, tid, lane, wave); }
PHASE_FN void ph_attn(unsigned char* ws, LAS unsigned char* lds) { LND(ws); LND(lds); PH_IDS;
    const int NS = BATCH * GH, GA = G - NS; if (bid < NS || GA <= 0) return;
    const int k = bid - NS;
    if (G == 256) {
        for (int r = 0; r < 3; ++r) { int it;
            if (r == 0) it = k;
            else if (k < WIN_ND) break;
            else { const int j = k - WIN_ND; if (r == 1) it = 240 + (223 - j);
                   else { if (j < 176) break; it = 464 + (223 - j); } }
            const int qb = 31 - (it >> 4), bh = it & 15;
            attn_unit(bh >> 2, bh & 3, qb, ws, lds, tid, lane, wave); __syncthreads(); }
        return; }
    for (int r = 0; r * GA < 512; ++r) { const int it = r * GA + ((r & 1) ? GA - 1 - k : k); if (it >= 512) continue;
        const int qb = 31 - (it >> 4), bh = it & 15;
        attn_unit(bh >> 2, bh & 3, qb, ws, lds, tid, lane, wave); __syncthreads(); } }
PHASE_FN void ph_ssd_out(InP in, int L, unsigned char* ws, LAS unsigned char* lds) { LND(in); LND(ws); LND(lds); PH_IDS;
    const int NU = BATCH * SNC * SG * 2, NS = BATCH * GH;
    if (G == 256 && NU == 256 && NS == 16) {
        if (bid < NS) return;
        const int k = bid - NS;
        for (int r = 0; r < 2; ++r) { if (r == 1 && k >= WIN_ND) break;
            ssd_out_unit(r ? 240 + k : k, in, L, ws, lds, tid, lane, wave); __syncthreads(); }
        return; }
    for (int un = bid; un < NU; un += G) { ssd_out_unit(un, in, L, ws, lds, tid, lane, wave); __syncthreads(); } }
template <int WHICH> PHASE_FN void ph_gemm_resid(InP in, int L, float* hbuf, unsigned char* ws, LAS unsigned char* lds) { LND(in); LND(hbuf); LND(ws); LND(lds); PH_IDS;
    pg8::StaticOrder S; S.init(T, DM, G, bid);
    if constexpr (WHICH == 0) { const float* base = (L == 0) ? in->p[0] : hbuf;
        pg8::Gemm g{ws + WS_MIX, ws + WS_WOUT + L * SZ_WOUT, T, DM, DM, 0};
        pg8::EpiResid E{base, hbuf, nullptr, DM}; pg8::gemm_phase<pg8::EpiResid, pg8::StaticOrder, true, true>(lds, g, S, E);
    } else {
        pg8::Gemm g{ws + R_ACT, ws + WS_WDN, T, DM, FF0, 2 * FF0};
        pg8::EpiResid8 E{hbuf, hbuf, nullptr, DM, (const float*)(ws + WS_SA2), (const float*)(ws + WS_SDD)}; pg8::gemm_phase<pg8::EpiResid8, pg8::StaticOrder, true, true, 1>(lds, g, S, E); } }
PHASE_FN void ph_gemm_gu(unsigned char* ws, LAS unsigned char* lds) { LND(ws); LND(lds); PH_IDS;
    pg8::Gemm g{ws + WS_HN8, ws + WS_WGU, T, 2 * FF0, DM, 0}; pg8::StaticOrder S; S.init(T, 2 * FF0, G, bid);
    pg8::EpiSwiGLU8 E{(bf16*)(ws + R_ACT), FF0, (const float*)(ws + WS_SA), (const float*)(ws + WS_SWD)}; pg8::gemm_phase<pg8::EpiSwiGLU8, pg8::StaticOrder, true, true, 1>(lds, g, S, E); }
PHASE_FN void ph_moe_permute(unsigned char* ws, LAS unsigned char* lds) { LND(ws); LND(lds); PH_IDS; moe_permute_phase(ws, (unsigned*)(ws + WS_CTL), lds, bid, G, tid, lane, wave); }
PHASE_FN void ph_moe_gu(unsigned char* ws, LAS unsigned char* lds) { LND(ws); LND(lds); PH_IDS;
    int toff[9]; moe_tile_prefix((unsigned*)(ws + WS_CTL) + CW_CNT, toff);
    pg8::Gemm g{ws + R_XP, ws + WS_WMGU, MAXSLOTS, 2 * FFE, DM, 0}; pg8::GroupOrder S; S.init(toff, 2 * FFE / 256, G, bid);
    pg8::EpiSwiGLU8 E{(bf16*)(ws + R_ACTP), FFE, (const float*)(ws + WS_XSC), (const float*)(ws + WS_SWM)}; pg8::gemm_phase<pg8::EpiSwiGLU8, pg8::GroupOrder, true, true, 1>(lds, g, S, E); }
PHASE_FN void ph_moe_down(unsigned char* ws, LAS unsigned char* lds) { LND(ws); LND(lds); PH_IDS;
    int toff[9]; moe_tile_prefix((unsigned*)(ws + WS_CTL) + CW_CNT, toff);
    pg8::Gemm g{ws + R_ACTP, ws + WS_WMDN, MAXSLOTS, DM, FFE, 2 * FFE}; pg8::GroupOrder S; S.init(toff, DM / 256, G, bid);
    pg8::EpiBf16Plain8 E{(bf16*)(ws + R_XP), DM, (const float*)(ws + WS_SA2), (const float*)(ws + WS_SDM)}; pg8::gemm_phase<pg8::EpiBf16Plain8, pg8::GroupOrder, true, true, 1>(lds, g, S, E); }
PHASE_FN void ph_act_quant(int L, unsigned char* ws) { LND(ws); PH_IDS;
    if (L == 0) act_quant_phase<FF0>(ws + R_ACT, (float*)(ws + WS_SA2), T, gw, NGW, lane);
    else { int toff[9]; moe_tile_prefix((unsigned*)(ws + WS_CTL) + CW_CNT, toff); act_quant_phase<FFE>(ws + R_ACTP, (float*)(ws + WS_SA2), toff[8] * 256, gw, NGW, lane); } }
PHASE_FN void ph_moe_combine(unsigned char* ws, float* h) { LND(ws); LND(h); PH_IDS; moe_combine_phase(ws, h, (const float*)(ws + WS_SKG) + DM, gw, NGW, lane); }
PHASE_FN void ph_gemm_ple(int L, float* h, unsigned char* ws, LAS unsigned char* lds) { LND(h); LND(ws); LND(lds); PH_IDS;
    pg8::StaticOrder S; S.init(T, DM, G, bid);
    { pg8::Gemm g{ws + WS_HN8, ws + WS_WPG8 + (size_t)L * DM * DM, T, DM, DM, 0};
      pg8::EpiPle8 E{h, (const bf16*)(ws + WS_E), DM, (const float*)(ws + WS_SA), (const float*)(ws + WS_SPG) + L * DM, (const float*)(ws + WS_RSE) + L * T}; pg8::gemm_phase<pg8::EpiPle8, pg8::StaticOrder, true, true, 1>(lds, g, S, E); } }
PHASE_FN void ph_h_quant(float* h, unsigned char* ws) { LND(h); LND(ws); PH_IDS; h_quant_phase(h, (signed char*)(ws + WS_HN8), (float*)(ws + WS_SA), (const float*)(ws + WS_SKG), gw, NGW, lane); }

__device__ __forceinline__ bool in_range(int k, int lo, int hi) { LND(lo); LND(hi); return lo <= k && k < hi; }
#ifndef MK_DIS
#define MK_DIS 0u
#endif
#define ON(j) (!((MK_DIS >> (j)) & 1u))
#ifndef MK_DUP
#define MK_DUP 0u
#endif
#define DUP(j) ((MK_DUP >> (j)) & 1u)
#define IN(k) in_range((k), lo, hi)
#define SEAM(k) do { if (IN(k) && IN((k) + 1)) { XcdBarrier bb_ = bar; LND(bb_.bar); LND(bb_.x); xcd_barrier(bb_); } } while (0)
template <int L> __device__ __forceinline__ void layer_phases(InP in, float* hbuf, unsigned char* ws, LAS unsigned char* lds, const XcdBarrier& bar, const int lo, const int hi) {

        const int pb = 1 + PH_PER_LAYER * L;
        if (IN(pb + 0) && ON(0)) { ph_rms<0>(in, L, hbuf, ws, lds); if (DUP(0)) { __syncthreads(); ph_rms<0>(in, L, hbuf, ws, lds); } }
        SEAM(pb + 0);
        if (IN(pb + 1) && ON(1)) { ph_gemm_win(L, ws, lds); if (DUP(1)) { __syncthreads(); ph_gemm_win(L, ws, lds); }
            { const int Gs = gridDim.x, tail = ((T / 256) * (D_INP / 256)) % Gs;
              __syncthreads(); if (tail > 0 && tail < Gs) ph_gemm_pe(in, L, ws, lds, tail, Gs - tail); else ph_gemm_pe(in, L, ws, lds, -1, 0); } }
        SEAM(pb + 1);
        if (IN(pb + 2) && ON(2)) { ph_conv(in, L, ws); if (DUP(2)) ph_conv(in, L, ws); }
        SEAM(pb + 2);
        if (IN(pb + 3) && ON(3)) {
            ph_gemm_plain<0>(L, ws, lds); ph_gemm_plain<1>(L, ws, lds);
            __syncthreads();
            ph_gdn_prep(ws, lds);
            ph_ssd_state(in, L, ws, lds);
            if (DUP(3)) { ph_gemm_plain<0>(L, ws, lds); ph_gemm_plain<1>(L, ws, lds); __syncthreads(); }
            if (DUP(4)) { ph_gdn_prep(ws, lds); }
            if (DUP(14)) { ph_ssd_state(in, L, ws, lds); }
        }
        SEAM(pb + 3);
        if (IN(pb + 4) && ON(4)) ph_mlaprep(in, L, ws);
        SEAM(pb + 4);
        if (IN(pb + 5) && ON(5)) {
#ifndef NO_GSCAN
            ph_gdn_scan(in, L, ws, lds);
#endif
            const int fgrp = (int)(blockIdx.x % 3u); const bool fill_first = fgrp == 1, fill_mid = fgrp == 2;
#define PH5_FILL() do { __syncthreads(); if (L == 0) { ph_moe_gu_quant(in, ws, lds, NEXP * ST_EXP, NEXP * ST_EXP + 32, 0); ph_down_quant(in, ws, lds, 32); ph_moe_gu_quant(in, ws, lds, 0, MOE_GU_L0, 120); } \
            else { ph_moe_gu_quant(in, ws, lds, NEXP * ST_EXP + 64, NEXP * ST_EXP + 96, 128); ph_moe_gu_quant(in, ws, lds, MOE_GU_L0, NEXP * ST_EXP, 0); } __syncthreads(); } while (0)
            if (fill_first) PH5_FILL();
#ifndef NO_ATTN
            ph_attn(ws, lds);
#endif
            if (fill_mid) PH5_FILL();
#ifndef NO_SSDOUT
            ph_ssd_out(in, L, ws, lds);
#endif
            if (!fill_first && !fill_mid) PH5_FILL();
#undef PH5_FILL
            if (DUP(5)) ph_gdn_scan(in, L, ws, lds);
            if (DUP(6)) ph_attn(ws, lds);
            if (DUP(7)) ph_ssd_out(in, L, ws, lds);
        }
        SEAM(pb + 5);
        if (IN(pb + 6) && ON(6)) ph_gemm_resid<0>(in, L, hbuf, ws, lds);
        SEAM(pb + 6);
        if (IN(pb + 7) && ON(7)) { if (L == 0) ph_rms<1>(in, L, hbuf, ws, lds); else ph_rms<2>(in, L, hbuf, ws, lds); }
        SEAM(pb + 7);
        if (IN(pb + 8) && ON(8)) { if (L == 0) { ph_gemm_gu(ws, lds); if (DUP(8)) { __syncthreads(); ph_gemm_gu(ws, lds); } } else ph_moe_permute(ws, lds); }
        SEAM(pb + 8);
        if (IN(pb + 9) && ON(9)) { if (L == 0) ph_act_quant(L, ws); else { ph_moe_gu(ws, lds); if (DUP(9)) { __syncthreads(); ph_moe_gu(ws, lds); } } }
        SEAM(pb + 9);
        if (IN(pb + 10) && ON(10)) { if (L == 0) ph_gemm_resid<1>(in, L, hbuf, ws, lds); else ph_act_quant(L, ws); }
        SEAM(pb + 10);
        if (IN(pb + 11) && ON(11)) { if (L == 1) { ph_moe_down(ws, lds); if (DUP(10)) { __syncthreads(); ph_moe_down(ws, lds); } } else ph_h_quant(hbuf, ws); }
        SEAM(pb + 11);
        if (IN(pb + 12) && ON(12)) { if (L == 1) ph_moe_combine(ws, hbuf); }
        if (L == 1) SEAM(pb + 12);
        if (IN(pb + 13) && ON(12)) ph_gemm_ple(L, hbuf, ws, lds);
        SEAM(pb + 13);
    }
__global__ void __launch_bounds__(NTHR, 2) mk_fwd(Args a) {
    extern __shared__ __attribute__((aligned(16))) unsigned char lds_raw[];
    LAS unsigned char* lds = (LAS unsigned char*)lds_raw;
    volatile LAS unsigned* MISC = (volatile LAS unsigned*)(lds + MISC_OFF);
    InP in = (InP)__builtin_amdgcn_kernarg_segment_ptr();
    const int tid = threadIdx.x;
    unsigned char* ws = a.ws; unsigned* ctl = (unsigned*)(ws + WS_CTL);
    if (tid < 64) MISC[tid] = 0u;
    __syncthreads();
    XcdBarrier bar = xcd_barrier_post(ctl + CW_BAR, MISC + 8);
    const int lo = a.ph_lo, hi = a.ph_hi;
    float* hbuf = a.out;

    if (IN(0) && ON(13)) { ph_prologue(in, ws, lds); if (DUP(13)) { __syncthreads(); ph_prologue(in, ws, lds); } }
    SEAM(0);
    layer_phases<0>(in, hbuf, ws, lds, bar, lo, hi);
    layer_phases<1>(in, hbuf, ws, lds, bar, lo, hi);
}

extern "C" void kernel_launch(void* const* d_in, const int* in_sizes, int n_in, void* d_out, int out_size, void* d_ws, size_t ws_size, hipStream_t stream) {
    static int grid = 0;
    if (grid == 0) {
        if (n_in != 33 || out_size != T * DM || ws_size < WS_END) { fprintf(stderr, "kernel_launch: unexpected shapes (n_in %d, out %d, ws %zu < %zu); nothing launched\n", n_in, out_size, ws_size, (size_t)WS_END); grid = -1; return; }
        int dev = 0, cus = 0, per_cu = 0;
        if (hipGetDevice(&dev) != hipSuccess || hipDeviceGetAttribute(&cus, hipDeviceAttributeMultiprocessorCount, dev) != hipSuccess) { grid = -1; return; }
        if (hipFuncSetAttribute((const void*)mk_fwd, hipFuncAttributeMaxDynamicSharedMemorySize, LDS_BYTES) != hipSuccess) { fprintf(stderr, "kernel_launch: hipFuncSetAttribute failed\n"); grid = -1; return; }
        if (hipOccupancyMaxActiveBlocksPerMultiprocessor(&per_cu, (const void*)mk_fwd, NTHR, LDS_BYTES) != hipSuccess || per_cu < 1) { fprintf(stderr, "kernel_launch: occupancy query says %d\n", per_cu); }
        (void)hipGetLastError();
        grid = cus;
    }
    if (grid < 0) return;
    (void)hipMemsetAsync((char*)d_ws + WS_CTL, 0, CTL_ZERO_BYTES, stream);
    Args a{};
    for (int i = 0; i < 33; ++i) a.in.p[i] = (const float*)d_in[i];
    a.out = (float*)d_out; a.ws = (unsigned char*)d_ws;
#if MK_PER_PHASE
#ifndef MK_MAXPH
#define MK_MAXPH N_PHASES
#endif
    for (int ph = 0; ph < MK_MAXPH; ++ph) {
        if (ph == 1 + 12) continue;
        a.ph_lo = ph; a.ph_hi = ph + 1;
        hipLaunchKernelGGL(mk_fwd, dim3(grid), dim3(NTHR), LDS_BYTES, stream, a);
    }
#else
    a.ph_lo = 0; a.ph_hi = N_PHASES;
    hipLaunchKernelGGL(mk_fwd, dim3(grid), dim3(NTHR), LDS_BYTES, stream, a);
#endif
}
```
